# Optimizing an MI355X kernel written in HIP

```python
import jax, jax.numpy as jnp
from jax import lax
import numpy as np

D_MODEL = 2048
BATCH = 2
SEQ = 4096
DEPTH = 1

SWA_Q_HEADS = 32
SWA_KV_HEADS = 4
SWA_HEAD_DIM = 64
SWA_WINDOW = 128
SWA_BLOCK = 128
ROPE_THETA = 500000.0
ROPE_DIM = SWA_HEAD_DIM // 4
DN_K_HEADS = 16
DN_V_HEADS = 32
DN_HEAD_K = 128
DN_HEAD_V = 128
DN_CONV = 4
DN_CHUNK = 64
EPS = 1e-6

SWA_Q = SWA_Q_HEADS * SWA_HEAD_DIM
SWA_KV = SWA_KV_HEADS * SWA_HEAD_DIM
DN_KEY = DN_K_HEADS * DN_HEAD_K
DN_VAL = DN_V_HEADS * DN_HEAD_V
DN_CONV_CH = 2 * DN_KEY + DN_VAL
IN_SIZES = (SWA_Q, SWA_KV, SWA_KV, SWA_Q, DN_CONV_CH, DN_VAL, DN_V_HEADS, DN_V_HEADS, D_MODEL, D_MODEL)
IN_WIDTH = sum(IN_SIZES)

kernel_name = "hybrid_swa_sink_gated_deltanet_adaln"


def _split_points():
    pts, acc = [], 0
    for s in IN_SIZES[:-1]:
        acc += s
        pts.append(acc)
    return pts


def rms_norm(x, w):
    xf = x.astype(jnp.float32)
    y = xf * lax.rsqrt(jnp.mean(xf * xf, axis=-1, keepdims=True) + EPS)
    return (y * w.astype(jnp.float32)).astype(x.dtype)


def l2_norm(x):
    xf = x.astype(jnp.float32)
    return xf * lax.rsqrt(jnp.sum(xf * xf, axis=-1, keepdims=True) + EPS)


def partial_rope(x, positions):
    half = ROPE_DIM // 2
    inv_freq = ROPE_THETA ** (-jnp.arange(half, dtype=jnp.float32) * (2.0 / ROPE_DIM))
    ang = positions.astype(jnp.float32)[..., None] * inv_freq
    cos = jnp.cos(ang)[:, :, None, :]
    sin = jnp.sin(ang)[:, :, None, :]
    xr = x[..., :ROPE_DIM].astype(jnp.float32)
    x1, x2 = xr[..., :half], xr[..., half:]
    rot = jnp.concatenate([x1 * cos - x2 * sin, x2 * cos + x1 * sin], axis=-1).astype(x.dtype)
    return jnp.concatenate([rot, x[..., ROPE_DIM:]], axis=-1)


def swa_attention(q, k, v, sinks):
    B, T = q.shape[0], q.shape[1]
    nb = T // SWA_BLOCK
    G = SWA_Q_HEADS // SWA_KV_HEADS
    f32 = jnp.float32
    qb = q.astype(f32).reshape(B, nb, SWA_BLOCK, SWA_KV_HEADS, G, SWA_HEAD_DIM)

    def band(t):
        tb = t.astype(f32).reshape(B, nb, SWA_BLOCK, SWA_KV_HEADS, SWA_HEAD_DIM)
        prev = jnp.concatenate([jnp.zeros_like(tb[:, :1]), tb[:, :-1]], axis=1)
        return jnp.concatenate([prev, tb], axis=2)

    kb, vb = band(k), band(v)
    s = jnp.einsum('bnqhgd,bnkhd->bnhgqk', qb, kb) * (SWA_HEAD_DIM ** -0.5)
    qi = jnp.arange(SWA_BLOCK)[:, None]
    kj = jnp.arange(2 * SWA_BLOCK)[None, :]
    rel = qi + SWA_BLOCK - kj
    in_window = (rel >= 0) & (rel < SWA_WINDOW)
    first = (jnp.arange(nb) == 0)[:, None, None]
    pad_key = (kj < SWA_BLOCK)[None]
    valid = in_window[None] & ~(first & pad_key)
    s = jnp.where(valid[None, :, None, None], s, -jnp.inf)
    sink = sinks.astype(f32).reshape(SWA_KV_HEADS, G)[None, None, :, :, None, None]
    m = jnp.maximum(jnp.max(s, axis=-1, keepdims=True), sink)
    p = jnp.exp(s - m)
    denom = jnp.sum(p, axis=-1, keepdims=True) + jnp.exp(sink - m)
    o = jnp.einsum('bnhgqk,bnkhd->bnqhgd', p / denom, vb)
    return o.reshape(B, T, SWA_Q)


def causal_conv_silu(x, w):
    T = x.shape[1]
    xp = jnp.pad(x, ((0, 0), (DN_CONV - 1, 0), (0, 0)))
    y = xp[:, 0:T] * w[0]
    for j in range(1, DN_CONV):
        y = y + xp[:, j:j + T] * w[j]
    return jax.nn.silu(y)


def gated_delta_rule(q, k, v, g, beta):
    B, T, H, dk = q.shape
    dv = v.shape[-1]
    C = DN_CHUNK
    N = T // C
    f32 = jnp.float32

    def chunks(t):
        t = t.astype(f32).reshape((B, N, C, H) + t.shape[3:])
        return jnp.moveaxis(t, 3, 1)

    q = chunks(q) * (dk ** -0.5)
    k, v, beta, g = chunks(k), chunks(v), chunks(beta), chunks(g)
    g = jnp.cumsum(g, axis=-1)
    tril = jnp.tril(jnp.ones((C, C), dtype=bool))
    strict = jnp.tril(jnp.ones((C, C), dtype=bool), -1)
    decay = jnp.exp(jnp.where(tril, g[..., :, None] - g[..., None, :], -jnp.inf))
    k_beta = k * beta[..., None]
    v_beta = v * beta[..., None]
    L = jnp.where(strict, jnp.einsum('bhncd,bhnsd->bhncs', k_beta, k) * decay, 0.0)
    eye = jnp.eye(C, dtype=f32)
    t_inv = lax.linalg.triangular_solve(eye + L, jnp.broadcast_to(eye, L.shape),
                                        left_side=True, lower=True, unit_diagonal=True)
    u = t_inv @ v_beta
    w = t_inv @ (k_beta * jnp.exp(g)[..., None])
    qk = jnp.where(tril, jnp.einsum('bhncd,bhnsd->bhncs', q, k) * decay, 0.0)
    q_dec = q * jnp.exp(g)[..., None]
    k_dec = k * jnp.exp(g[..., -1:] - g)[..., None]
    g_last = jnp.exp(g[..., -1])

    def step(S, xs):
        u_c, w_c, qk_c, qd_c, kd_c, gl_c = xs
        v_new = u_c - w_c @ S
        o = qd_c @ S + qk_c @ v_new
        S = S * gl_c[..., None, None] + jnp.swapaxes(kd_c, -1, -2) @ v_new
        return S, o

    xs = tuple(jnp.moveaxis(t, 2, 0) for t in (u, w, qk, q_dec, k_dec, g_last))
    S0 = jnp.zeros((B, H, dk, dv), f32)
    _, o = lax.scan(step, S0, xs)
    return jnp.transpose(o, (1, 0, 3, 2, 4)).reshape(B, T, H, dv)


def hybrid_layer(x, c, positions, w_ada, b_ada, norm_w, w_in, q_norm_w, k_norm_w, sinks,
                 conv_w, a_log, dt_bias, dn_norm_w, w_o_swa, w_o_dn, w_out):
    B, T, _ = x.shape
    f32 = jnp.float32
    mod = jax.nn.silu(c) @ w_ada + b_ada
    shift, scale, gate = jnp.split(mod[:, None, :], 3, axis=-1)
    h = rms_norm(x, norm_w) * (1.0 + scale) + shift
    proj = h @ w_in
    aq, ak, av, ag, d_qkv, dz, db, da, mg_a, mg_b = jnp.split(proj, _split_points(), axis=-1)

    aq = rms_norm(aq.reshape(B, T, SWA_Q_HEADS, SWA_HEAD_DIM), q_norm_w)
    ak = rms_norm(ak.reshape(B, T, SWA_KV_HEADS, SWA_HEAD_DIM), k_norm_w)
    aq = partial_rope(aq, positions)
    ak = partial_rope(ak, positions)
    av = av.reshape(B, T, SWA_KV_HEADS, SWA_HEAD_DIM)
    a_out = swa_attention(aq, ak, av, sinks).astype(x.dtype) * jax.nn.silu(ag)
    y_a = a_out @ w_o_swa

    d_qkv = causal_conv_silu(d_qkv, conv_w)
    dq, dk, dv = jnp.split(d_qkv, [DN_KEY, 2 * DN_KEY], axis=-1)
    rep = DN_V_HEADS // DN_K_HEADS
    dq = jnp.repeat(l2_norm(dq.reshape(B, T, DN_K_HEADS, DN_HEAD_K)), rep, axis=2)
    dk = jnp.repeat(l2_norm(dk.reshape(B, T, DN_K_HEADS, DN_HEAD_K)), rep, axis=2)
    dv = dv.reshape(B, T, DN_V_HEADS, DN_HEAD_V)
    beta = jax.nn.sigmoid(db.astype(f32))
    g = -jnp.exp(a_log.astype(f32)) * jax.nn.softplus(da.astype(f32) + dt_bias.astype(f32))
    o = gated_delta_rule(dq, dk, dv, g, beta)
    o = rms_norm(o, dn_norm_w) * jax.nn.silu(dz.reshape(B, T, DN_V_HEADS, DN_HEAD_V).astype(f32))
    y_b = o.reshape(B, T, DN_VAL).astype(x.dtype) @ w_o_dn

    y = jax.nn.sigmoid(mg_a) * y_a + jax.nn.sigmoid(mg_b) * y_b
    return x + gate * (y @ w_out)


def setup_inputs(seed: int = 0) -> dict:
    key = jax.random.key(seed)
    ks = jax.random.split(key, 20)
    D = D_MODEL
    nrm = jax.random.normal
    x = nrm(ks[0], (BATCH, SEQ, D), jnp.float32)
    c = nrm(ks[1], (BATCH, D), jnp.float32)
    offs = jax.random.randint(ks[2], (BATCH, 1), 0, 4096, dtype=jnp.int32)
    positions = (jnp.arange(SEQ, dtype=jnp.int32)[None, :] + offs).astype(jnp.int32)
    w_ada = nrm(ks[3], (DEPTH, D, 3 * D), jnp.float32) * (0.5 * D ** -0.5)
    b_ada = nrm(ks[4], (DEPTH, 3 * D), jnp.float32) * 0.01
    norm_w = 1.0 + 0.02 * nrm(ks[5], (DEPTH, D), jnp.float32)
    w_in = nrm(ks[6], (DEPTH, D, IN_WIDTH), jnp.float32) * (D ** -0.5)
    q_norm_w = 1.0 + 0.02 * nrm(ks[7], (DEPTH, SWA_HEAD_DIM), jnp.float32)
    k_norm_w = 1.0 + 0.02 * nrm(ks[8], (DEPTH, SWA_HEAD_DIM), jnp.float32)
    sinks = nrm(ks[9], (DEPTH, SWA_Q_HEADS), jnp.float32)
    conv_w = nrm(ks[10], (DEPTH, DN_CONV, DN_CONV_CH), jnp.float32) * 0.5
    a_log = jnp.log(jax.random.uniform(ks[11], (DEPTH, DN_V_HEADS), jnp.float32, 1.0, 16.0))
    dt = jnp.exp(jax.random.uniform(ks[12], (DEPTH, DN_V_HEADS), jnp.float32,
                                    float(np.log(1e-3)), float(np.log(1e-1))))
    dt_bias = dt + jnp.log(-jnp.expm1(-dt))
    dn_norm_w = 1.0 + 0.02 * nrm(ks[13], (DEPTH, DN_HEAD_V), jnp.float32)
    w_o_swa = nrm(ks[14], (DEPTH, SWA_Q, D), jnp.float32) * (SWA_Q ** -0.5)
    w_o_dn = nrm(ks[15], (DEPTH, DN_VAL, D), jnp.float32) * (DN_VAL ** -0.5)
    w_out = nrm(ks[16], (DEPTH, D, D), jnp.float32) * (D ** -0.5)
    return {"x": x, "c": c, "positions": positions, "w_ada": w_ada, "b_ada": b_ada,
            "norm_w": norm_w, "w_in": w_in, "q_norm_w": q_norm_w, "k_norm_w": k_norm_w,
            "sinks": sinks, "conv_w": conv_w, "a_log": a_log, "dt_bias": dt_bias,
            "dn_norm_w": dn_norm_w, "w_o_swa": w_o_swa, "w_o_dn": w_o_dn, "w_out": w_out}


def reference(x, c, positions, w_ada, b_ada, norm_w, w_in, q_norm_w, k_norm_w, sinks,
              conv_w, a_log, dt_bias, dn_norm_w, w_o_swa, w_o_dn, w_out):
    for l in range(DEPTH):
        x = hybrid_layer(x, c, positions, w_ada[l], b_ada[l], norm_w[l], w_in[l], q_norm_w[l],
                         k_norm_w[l], sinks[l], conv_w[l], a_log[l], dt_bias[l], dn_norm_w[l],
                         w_o_swa[l], w_o_dn[l], w_out[l])
    return x
```

```cpp
#include <hip/hip_runtime.h>
#include <cstdio>
#include <cstdint>

namespace pg8 {
#define PG8_LAS __attribute__((address_space(3)))
typedef unsigned short bf16_t;
typedef short bf16x8 __attribute__((ext_vector_type(8)));
typedef float f32x4 __attribute__((ext_vector_type(4)));
typedef unsigned u32x4 __attribute__((ext_vector_type(4)));
typedef unsigned u32x2 __attribute__((ext_vector_type(2)));
constexpr int BM = 256, BK = 64, HALF = 128, HTB = HALF * BK * 2  , STAGE_BYTES = 8 * HTB, NXCD = 8, WGM = 8;

__host__ __device__ __forceinline__ int lds_byte(int r, int c) { const int st = (r >> 4) * 2 + (c >> 5), rr = r & 15, cc = c & 31, ob = rr * 64 + cc * 2; return st * 1024 + (ob ^ (((ob >> 9) & 1) << 5)); }
__host__ __device__ __forceinline__ void stage_rc(int b, int& R, int& C) { const int st = b / 1024, sb = b % 1024, swz = sb ^ (((sb >> 9) & 1) << 5); R = (st >> 1) * 16 + swz / 64; C = (st & 1) * 32 + (swz % 64) / 2; }
__host__ __device__ __forceinline__ int perm32(int rho) { const int n = rho >> 4, i = rho & 15; return 8 * (i >> 2) + 4 * n + (i & 3); }

struct Unit { int pm, pn; };
struct Gemm { const bf16_t* A; const bf16_t* Bt; int M, N, K, lda, ldb; };

struct StaticOrder {
    int nM, nN, nwg, G, c;
    __host__ __device__ void init(int M, int N, int G_, int c_) { nM = M / BM; nN = N / BM; nwg = nM * nN; G = G_; c = c_; }
    __host__ __device__ bool next(int i, Unit& u) const {
        const long L = (long)i * G + c; if (L >= nwg) return false;
        int wgid = (int)L; { const int q = nwg / NXCD, r = nwg % NXCD, xcd = wgid % NXCD, off = wgid / NXCD; wgid = (xcd < r ? xcd * (q + 1) : r * (q + 1) + (xcd - r) * q) + off; }
        const int nig = WGM * nN, gid = wgid / nig, fm = gid * WGM, gsz = (nM - fm) < WGM ? (nM - fm) : WGM;
        u.pm = fm + ((wgid % nig) % gsz); u.pn = (wgid % nig) / gsz; return true;
    }
    __device__ __forceinline__ void a_ready(const Unit&) const {}
    __device__ __forceinline__ void done(const Unit&) const {}
};

__device__ __forceinline__ unsigned cvt_pk_bf16(float lo, float hi) { unsigned r; asm volatile("v_cvt_pk_bf16_f32 %0, %1, %2" : "=v"(r) : "v"(lo), "v"(hi)); return r; }
__device__ __forceinline__ float bf_lo(unsigned w) { return __uint_as_float(w << 16); }
__device__ __forceinline__ float bf_hi(unsigned w) { return __uint_as_float(w & 0xffff0000u); }
__device__ __forceinline__ float sigmoidf_(float x) { return 1.0f / (1.0f + __expf(-x)); }

struct EpiProj {
    static constexpr bool PERM = true, AFTER_DRAIN = false;
    bf16_t* O; int ldc; float* DBA; int pn_f32;
    __device__ __forceinline__ void operator()(const f32x4 (&acc)[2][2][4][2], const Unit& u, int wr, int wc, int fr, int fq) const {
        const int row0 = u.pm * BM + wr * 64 + fr;
        if (u.pn == pn_f32) {
            if (wc < 2) {
#pragma unroll
                for (int ai = 0; ai < 2; ++ai)
#pragma unroll
                    for (int m = 0; m < 4; ++m) { float* p = DBA + (size_t)(row0 + ai * HALF + m * 16) * 64 + wc * 32 + 8 * fq;
                        *(f32x4*)p = acc[ai][0][m][0]; *(f32x4*)(p + 4) = acc[ai][0][m][1]; }
            }
            return;
        }
        const int col0 = u.pn * BM + wc * 32 + 8 * fq;
#pragma unroll
        for (int ai = 0; ai < 2; ++ai)
#pragma unroll
            for (int m = 0; m < 4; ++m) { bf16_t* rowp = O + (size_t)(row0 + ai * HALF + m * 16) * ldc + col0;
#pragma unroll
                for (int bj = 0; bj < 2; ++bj) { const f32x4 v0 = acc[ai][bj][m][0], v1 = acc[ai][bj][m][1];
                    u32x4 w; w.x = cvt_pk_bf16(v0[0], v0[1]); w.y = cvt_pk_bf16(v0[2], v0[3]); w.z = cvt_pk_bf16(v1[0], v1[1]); w.w = cvt_pk_bf16(v1[2], v1[3]);
                    *(u32x4*)(rowp + bj * HALF) = w; } }
    }
};
struct EpiGateF32 {
    static constexpr bool PERM = false, AFTER_DRAIN = false;
    float* C; int ldc; const bf16_t* G; int ldg;
    __device__ __forceinline__ void operator()(const f32x4 (&acc)[2][2][4][2], const Unit& u, int wr, int wc, int fr, int fq) const {
        const int row0 = u.pm * BM + wr * 64 + fr, col0 = u.pn * BM + wc * 32 + 4 * fq;
#pragma unroll
        for (int ai = 0; ai < 2; ++ai)
#pragma unroll
            for (int m = 0; m < 4; ++m) { const size_t r = (size_t)(row0 + ai * HALF + m * 16); float* rowp = C + r * ldc + col0; const bf16_t* gp = G + r * ldg + col0;
#pragma unroll
                for (int bj = 0; bj < 2; ++bj)
#pragma unroll
                    for (int n = 0; n < 2; ++n) { const u32x2 gw = *(const u32x2*)(gp + bj * HALF + n * 16); const f32x4 a = acc[ai][bj][m][n];
                        f32x4 o; o[0] = a[0] * sigmoidf_(bf_lo(gw.x)); o[1] = a[1] * sigmoidf_(bf_hi(gw.x)); o[2] = a[2] * sigmoidf_(bf_lo(gw.y)); o[3] = a[3] * sigmoidf_(bf_hi(gw.y));
                        *(f32x4*)(rowp + bj * HALF + n * 16) = o; } }
    }
};
struct EpiGateAddBf16 {
    static constexpr bool PERM = true, AFTER_DRAIN = false;
    bf16_t* O; int ldc; const float* YA; int ldy; const bf16_t* G; int ldg;
    __device__ __forceinline__ void operator()(const f32x4 (&acc)[2][2][4][2], const Unit& u, int wr, int wc, int fr, int fq) const {
        const int row0 = u.pm * BM + wr * 64 + fr, col0 = u.pn * BM + wc * 32 + 8 * fq;
#pragma unroll
        for (int ai = 0; ai < 2; ++ai)
#pragma unroll
            for (int m = 0; m < 4; ++m) { const size_t r = (size_t)(row0 + ai * HALF + m * 16); bf16_t* rowp = O + r * ldc + col0; const float* yp = YA + r * ldy + col0; const bf16_t* gp = G + r * ldg + col0;
#pragma unroll
                for (int bj = 0; bj < 2; ++bj) { const f32x4 v0 = acc[ai][bj][m][0], v1 = acc[ai][bj][m][1];
                    const u32x4 gw = *(const u32x4*)(gp + bj * HALF); const f32x4 y0 = *(const f32x4*)(yp + bj * HALF), y1 = *(const f32x4*)(yp + bj * HALF + 4);
                    const float o0 = y0[0] + v0[0] * sigmoidf_(bf_lo(gw.x)), o1 = y0[1] + v0[1] * sigmoidf_(bf_hi(gw.x)), o2 = y0[2] + v0[2] * sigmoidf_(bf_lo(gw.y)), o3 = y0[3] + v0[3] * sigmoidf_(bf_hi(gw.y));
                    const float o4 = y1[0] + v1[0] * sigmoidf_(bf_lo(gw.z)), o5 = y1[1] + v1[1] * sigmoidf_(bf_hi(gw.z)), o6 = y1[2] + v1[2] * sigmoidf_(bf_lo(gw.w)), o7 = y1[3] + v1[3] * sigmoidf_(bf_hi(gw.w));
                    u32x4 w; w.x = cvt_pk_bf16(o0, o1); w.y = cvt_pk_bf16(o2, o3); w.z = cvt_pk_bf16(o4, o5); w.w = cvt_pk_bf16(o6, o7);
                    *(u32x4*)(rowp + bj * HALF) = w; } }
    }
};
struct EpiResid {
    static constexpr bool PERM = false, AFTER_DRAIN = false;
    float* C; const float* X; int ldc; const float* modacc; const float* bias; int goff, modld, rows_per_batch;
    __device__ __forceinline__ void operator()(const f32x4 (&acc)[2][2][4][2], const Unit& u, int wr, int wc, int fr, int fq) const {
        const int row0 = u.pm * BM + wr * 64 + fr, col0 = u.pn * BM + wc * 32 + 4 * fq;
        const int b = (u.pm * BM) / rows_per_batch;
        f32x4 gv[2][2];
#pragma unroll
        for (int bj = 0; bj < 2; ++bj)
#pragma unroll
            for (int n = 0; n < 2; ++n) gv[bj][n] = *(const f32x4*)(modacc + (size_t)b * modld + goff + col0 + bj * HALF + n * 16) + *(const f32x4*)(bias + goff + col0 + bj * HALF + n * 16);
#pragma unroll
        for (int ai = 0; ai < 2; ++ai)
#pragma unroll
            for (int m = 0; m < 4; ++m) { const size_t off = (size_t)(row0 + ai * HALF + m * 16) * ldc + col0;
#pragma unroll
                for (int bj = 0; bj < 2; ++bj)
#pragma unroll
                    for (int n = 0; n < 2; ++n) { const f32x4 xv = *(const f32x4*)(X + off + bj * HALF + n * 16); *(f32x4*)(C + off + bj * HALF + n * 16) = xv + gv[bj][n] * acc[ai][bj][m][n]; } }
    }
};

template <class Epi, class Sched, bool ALIGN_EPI = false, bool SP2 = false>
__device__ __forceinline__ void gemm_phase(PG8_LAS unsigned char* lds, const Gemm g, const Sched& S, const Epi& E) {
    const int tid = threadIdx.x, wid = __builtin_amdgcn_readfirstlane(tid >> 6), lane = tid & 63, wr = wid >> 2, wc = wid & 3, fr = lane & 15, fq = lane >> 4;
    const int K = g.K, nt = K / BK;
    unsigned voffA[2], voffB[2];
#pragma unroll
    for (int i = 0; i < 2; ++i) { int R, C; stage_rc(tid * 16 + i * 8192, R, C); const int Rb = Epi::PERM ? ((R & ~31) + perm32(R & 31)) : R;
        voffA[i] = (unsigned)(R * g.lda + C) * 2u; voffB[i] = (unsigned)(Rb * g.ldb + C) * 2u; }
    const size_t kstep = (size_t)(BK * 2);
    const size_t hstepA = (size_t)HALF * g.lda * 2, hstepB = (size_t)HALF * g.ldb * 2;
    const size_t tstepA = 2 * hstepA, tstepB = 2 * hstepB;
    const unsigned ldsw = (unsigned)wid * 1024u;
    const int aoff = lds_byte(wr * 64 + fr, fq * 8), boff = lds_byte(wc * 32 + fr, fq * 8);
#define PG8_SA(b, h) (((b) * 2 + (h)) * HTB)
#define PG8_SB(b, h) ((4 + (b) * 2 + (h)) * HTB)
#define PG8_STAGE(bufoff, gbase, voff) do { _Pragma("unroll") for (int _i = 0; _i < 2; ++_i) \
        __builtin_amdgcn_global_load_lds((const unsigned*)((const char*)(gbase) + (voff)[_i]), (PG8_LAS unsigned*)(lds + (bufoff) + ldsw + _i * 8192), 16, 0, 0); } while (0)
#define PG8_LDA(dst, b, h) do { _Pragma("unroll") for (int m = 0; m < 4; ++m) _Pragma("unroll") for (int k = 0; k < 2; ++k) dst[m][k] = *(const PG8_LAS bf16x8*)(lds + PG8_SA(b, h) + aoff + m * 2048 + k * 1024); } while (0)
#define PG8_LDB(dst, b, h) do { _Pragma("unroll") for (int n = 0; n < 2; ++n) _Pragma("unroll") for (int k = 0; k < 2; ++k) dst[n][k] = *(const PG8_LAS bf16x8*)(lds + PG8_SB(b, h) + boff + n * 2048 + k * 1024); } while (0)
#define PG8_MMA(ai, bj, At, Bt) do { __builtin_amdgcn_s_setprio(1); _Pragma("unroll") for (int m = 0; m < 4; ++m) _Pragma("unroll") for (int n = 0; n < 2; ++n) _Pragma("unroll") for (int k = 0; k < 2; ++k) \
        acc[ai][bj][m][n] = __builtin_amdgcn_mfma_f32_16x16x32_bf16(Bt[n][k], At[m][k], acc[ai][bj][m][n], 0, 0, 0); __builtin_amdgcn_s_setprio(0); } while (0)
#define PG8_WAIT_V(n) asm volatile("s_waitcnt vmcnt(" #n ")" ::: "memory")
#define PG8_WAIT_L(n) asm volatile("s_waitcnt lgkmcnt(" #n ")" ::: "memory")
#define PG8_BAR __builtin_amdgcn_s_barrier()
#define PG8_SCHED __builtin_amdgcn_sched_barrier(0)
    Unit cur, nxt; int ui = 0;
    if (!S.next(0, cur)) return;
    f32x4 acc[2][2][4][2];
#pragma unroll
    for (int a = 0; a < 2; ++a)
#pragma unroll
        for (int b = 0; b < 2; ++b)
#pragma unroll
            for (int m = 0; m < 4; ++m)
#pragma unroll
                for (int n = 0; n < 2; ++n) acc[a][b][m][n] = (f32x4){0.f, 0.f, 0.f, 0.f};
    bf16x8 At[4][2], B0[2][2], B1[2][2];
    const char* cA = (const char*)g.A + (size_t)cur.pm * tstepA; const char* cB = (const char*)g.Bt + (size_t)cur.pn * tstepB;
    S.a_ready(cur);
    if constexpr (SP2) {
        PG8_STAGE(PG8_SB(0, 0), cB, voffB); PG8_STAGE(PG8_SB(0, 1), cB + hstepB, voffB); PG8_STAGE(PG8_SA(0, 0), cA, voffA); PG8_STAGE(PG8_SA(0, 1), cA + hstepA, voffA);
        if (wr == 1) PG8_BAR;
        PG8_WAIT_V(2); PG8_BAR;
        PG8_STAGE(PG8_SB(1, 0), cB + kstep, voffB); PG8_STAGE(PG8_SA(1, 0), cA + kstep, voffA); PG8_STAGE(PG8_SB(1, 1), cB + hstepB + kstep, voffB);
        PG8_WAIT_V(6); PG8_BAR;
    } else {
        PG8_STAGE(PG8_SB(0, 0), cB, voffB); PG8_STAGE(PG8_SA(0, 0), cA, voffA); PG8_STAGE(PG8_SB(0, 1), cB + hstepB, voffB); PG8_STAGE(PG8_SA(0, 1), cA + hstepA, voffA);
        if (wr == 1) PG8_BAR;
        PG8_WAIT_V(4); PG8_BAR;
        PG8_STAGE(PG8_SB(1, 0), cB + kstep, voffB); PG8_STAGE(PG8_SA(1, 0), cA + kstep, voffA); PG8_STAGE(PG8_SB(1, 1), cB + hstepB + kstep, voffB);
        PG8_WAIT_V(6); PG8_BAR;
    }
    for (;;) {
        const bool has_next = S.next(ui + 1, nxt);
        const char* nA = has_next ? (const char*)g.A + (size_t)nxt.pm * tstepA : cA; const char* nB = has_next ? (const char*)g.Bt + (size_t)nxt.pn * tstepB : cB;
        for (int t = 0; t < nt; t += 2) {
            const bool last = (t == nt - 2);
            const char* a1 = cA + (size_t)(t + 1) * kstep;
            const char* a2 = last ? nA : cA + (size_t)(t + 2) * kstep; const char* b2 = last ? nB : cB + (size_t)(t + 2) * kstep;
            const char* a3 = a2 + kstep; const char* b3 = b2 + kstep;
            if (last && has_next) S.a_ready(nxt);
            if constexpr (SP2) {
            PG8_LDB(B0, 0, 0); PG8_LDB(B1, 0, 1); PG8_SCHED; PG8_LDA(At, 0, 0); PG8_STAGE(PG8_SA(1, 1), a1 + hstepA, voffA);
            PG8_WAIT_V(8); PG8_WAIT_L(0); PG8_BAR; PG8_MMA(0, 0, At, B0); PG8_MMA(0, 1, At, B1); PG8_BAR; PG8_SCHED;
            PG8_LDA(At, 0, 1); PG8_STAGE(PG8_SB(0, 0), b2, voffB); PG8_STAGE(PG8_SB(0, 1), b2 + hstepB, voffB); PG8_STAGE(PG8_SA(0, 0), a2, voffA);
            PG8_WAIT_V(8); PG8_WAIT_L(0); PG8_BAR; PG8_MMA(1, 0, At, B0); PG8_MMA(1, 1, At, B1); PG8_BAR; PG8_SCHED;
            PG8_LDB(B0, 1, 0); PG8_LDB(B1, 1, 1); PG8_SCHED; PG8_LDA(At, 1, 0); PG8_STAGE(PG8_SA(0, 1), a2 + hstepA, voffA);
            PG8_WAIT_V(8); PG8_WAIT_L(0); PG8_BAR; PG8_MMA(0, 0, At, B0); PG8_MMA(0, 1, At, B1); PG8_BAR; PG8_SCHED;
            PG8_LDA(At, 1, 1); PG8_STAGE(PG8_SB(1, 0), b3, voffB); PG8_STAGE(PG8_SB(1, 1), b3 + hstepB, voffB); PG8_STAGE(PG8_SA(1, 0), a3, voffA);
            PG8_WAIT_V(8); PG8_WAIT_L(0); PG8_BAR; PG8_MMA(1, 0, At, B0); PG8_MMA(1, 1, At, B1); PG8_BAR; PG8_SCHED;
            } else {
            PG8_LDB(B0, 0, 0); PG8_SCHED; PG8_LDA(At, 0, 0); PG8_STAGE(PG8_SA(1, 1), a1 + hstepA, voffA);
            PG8_WAIT_L(8); PG8_BAR; PG8_WAIT_L(0); PG8_MMA(0, 0, At, B0); PG8_BAR; PG8_SCHED;
            PG8_LDB(B1, 0, 1); PG8_STAGE(PG8_SB(0, 0), b2, voffB);
            PG8_BAR; PG8_WAIT_L(0); PG8_MMA(0, 1, At, B1); PG8_BAR;
            PG8_LDA(At, 0, 1); PG8_STAGE(PG8_SA(0, 0), a2, voffA);
            PG8_BAR; PG8_WAIT_L(0); PG8_MMA(1, 0, At, B0); PG8_BAR; PG8_SCHED;
            PG8_STAGE(PG8_SB(0, 1), b2 + hstepB, voffB);
            PG8_WAIT_V(6); PG8_BAR; PG8_MMA(1, 1, At, B1); PG8_BAR;
            PG8_LDB(B0, 1, 0); PG8_SCHED; PG8_LDA(At, 1, 0); PG8_STAGE(PG8_SA(0, 1), a2 + hstepA, voffA);
            PG8_WAIT_L(8); PG8_BAR; PG8_WAIT_L(0); PG8_MMA(0, 0, At, B0); PG8_BAR; PG8_SCHED;
            PG8_LDB(B1, 1, 1); PG8_STAGE(PG8_SB(1, 0), b3, voffB);
            PG8_BAR; PG8_WAIT_L(0); PG8_MMA(0, 1, At, B1); PG8_BAR;
            PG8_LDA(At, 1, 1); PG8_STAGE(PG8_SA(1, 0), a3, voffA);
            PG8_BAR; PG8_WAIT_L(0); PG8_MMA(1, 0, At, B0); PG8_BAR; PG8_SCHED;
            PG8_STAGE(PG8_SB(1, 1), b3 + hstepB, voffB);
            PG8_WAIT_V(6); PG8_BAR; PG8_MMA(1, 1, At, B1); PG8_BAR;
            }
        }
        if constexpr (ALIGN_EPI) { if (wr == 0) PG8_BAR; }
        if constexpr (!Epi::AFTER_DRAIN) { E(acc, cur, wr, wc, fr, fq); S.done(cur); }
        if (!has_next) break;
#pragma unroll
        for (int a = 0; a < 2; ++a)
#pragma unroll
            for (int b = 0; b < 2; ++b)
#pragma unroll
                for (int m = 0; m < 4; ++m)
#pragma unroll
                    for (int n = 0; n < 2; ++n) acc[a][b][m][n] = (f32x4){0.f, 0.f, 0.f, 0.f};
        cur = nxt; cA = nA; cB = nB; ++ui;
        if constexpr (ALIGN_EPI) { if (wr == 1) PG8_BAR; }
    }
    PG8_WAIT_V(0);
    if constexpr (!ALIGN_EPI) { if (wr == 0) PG8_BAR; }
    PG8_BAR;
    if constexpr (Epi::AFTER_DRAIN) { E.fused(acc, cur, wr, wc, fr, fq, lds, wid, lane); S.done(cur); }
#undef PG8_SA
#undef PG8_SB
#undef PG8_STAGE
#undef PG8_LDA
#undef PG8_LDB
#undef PG8_MMA
#undef PG8_WAIT_V
#undef PG8_WAIT_L
#undef PG8_BAR
#undef PG8_SCHED
}
}

constexpr int NWAVES = 8;
constexpr int DM = 2048, NBATCH = 2, SEQ = 4096, MTOK = NBATCH * SEQ;
constexpr int IN_WIDTH = 21056, NP = 21248;
constexpr int C_AQ = 0, C_AK = 2048, C_AV = 2304, C_AG = 2560, C_DQKV = 4608, C_DZ = 12800, C_MGA = 16896, C_MGB = 18944, C_DBA = 20992;
constexpr int PN_DBA = C_DBA / 256;
constexpr int KCAT = 6144;
constexpr float EPS = 1e-6f;

constexpr size_t MiB = 1u << 20;
constexpr size_t WS_CTL = 0, CTL_ZERO_BYTES = 128 * 1024;
constexpr size_t WS_MODACC = 64 * 1024;
constexpr size_t WS_WTIN = 2 * MiB;
constexpr size_t WS_WOCAT = 85 * MiB;
constexpr size_t WS_WOUT = 109 * MiB;
constexpr size_t WS_H = 117 * MiB;
constexpr size_t WS_PROJ = 149 * MiB;
constexpr size_t WS_A2 = 481 * MiB;
constexpr size_t WS_Y = 577 * MiB;
constexpr size_t WS_ROPE = 609 * MiB;
constexpr size_t WS_DBA = 610 * MiB;
constexpr size_t WS_END = 612 * MiB;
constexpr size_t WS_YA = 2 * MiB;
static_assert(WS_WTIN + (size_t)NP * DM * 2 <= WS_WOCAT && WS_PROJ + (size_t)MTOK * NP * 2 <= WS_A2 && WS_YA + (size_t)MTOK * DM * 4 <= WS_WOCAT, "d_ws map");
constexpr int CW_BAR = 1024;

constexpr int RING_BYTES = 131072;
constexpr int LDSCTL_OFF = RING_BYTES, MISC_OFF = LDSCTL_OFF + 320;
constexpr int SMALL_OFF = RING_BYTES + 1024;
constexpr int LDS_BYTES = 147456;

#define GAS __attribute__((address_space(1)))
#define LAS __attribute__((address_space(3)))
typedef unsigned short bf16;
typedef unsigned v4u __attribute__((ext_vector_type(4)));
typedef float f32x4 __attribute__((ext_vector_type(4)));
typedef GAS unsigned gu32;
#define RLX_AGENT __ATOMIC_RELAXED, __HIP_MEMORY_SCOPE_AGENT
#define LDS_WAIT() asm volatile("s_waitcnt lgkmcnt(0)" ::: "memory")
#define VM_WAIT() asm volatile("s_waitcnt vmcnt(0)" ::: "memory")
__device__ __forceinline__ unsigned f2bf(float f) { unsigned u = __builtin_bit_cast(unsigned, f); return (u + 0x7fffu + ((u >> 16) & 1u)) >> 16; }
__device__ __forceinline__ unsigned pk2(float lo, float hi) { return f2bf(lo) | (f2bf(hi) << 16); }
__device__ __forceinline__ float bf2f(bf16 v) { return __uint_as_float((unsigned)v << 16); }
__device__ __forceinline__ float blo(unsigned w) { return __uint_as_float(w << 16); }
__device__ __forceinline__ float bhi(unsigned w) { return __uint_as_float(w & 0xffff0000u); }
__device__ __forceinline__ float siluf_(float x) { return x / (1.0f + __expf(-x)); }
__device__ __forceinline__ float sigm_(float x) { return 1.0f / (1.0f + __expf(-x)); }

#define XB_TMO      128
#define XB_XCNT(j)  (256  + 64 * (j))
#define XB_XSUB(j)  (1280 + 64 * (j))
#define XB_XGEN(j)  (2304 + 64 * (j))
#define XB_TOP      3328
#define XB_TOPGEN   3392
#define XCD_BAR_WORDS 3456
#define XB_SPIN_CAP (1u << 18)

__device__ __forceinline__ unsigned xb_ld(unsigned* p)              { return __hip_atomic_load(p, __ATOMIC_RELAXED, __HIP_MEMORY_SCOPE_AGENT); }
__device__ __forceinline__ unsigned xb_add(unsigned* p, unsigned v) { return __hip_atomic_fetch_add(p, v, __ATOMIC_RELAXED, __HIP_MEMORY_SCOPE_AGENT); }
__device__ __forceinline__ unsigned xb_xcc_id() { return (unsigned)__builtin_amdgcn_s_getreg((3 << 11) | 20) & 0xFu; }
#define XB_SPIN(cond, bar) do { unsigned _sp = 0; while (cond) { __builtin_amdgcn_s_sleep(1); \
    if ((++_sp & 255u) == 0u) { if (xb_ld(&(bar)[XB_TMO])) break; if (_sp > XB_SPIN_CAP) { atomicAdd(&(bar)[XB_TMO], 1u); break; } } } } while (0)

struct XcdBarrier {
    unsigned* bar; unsigned x;
    volatile LAS unsigned* st;
};

__device__ __forceinline__ XcdBarrier xcd_barrier_post(unsigned* bar, volatile LAS unsigned* st) {
    XcdBarrier b; b.bar = bar; b.x = xb_xcc_id(); b.st = st;
    if (threadIdx.x == 0) (void)xb_add(&bar[XB_XCNT(b.x)], 1u);
    return b;
}
__device__ __forceinline__ void xcd_barrier_complete(unsigned* bar, unsigned x, unsigned& nloc, unsigned& nx) {
    const unsigned G = gridDim.x * gridDim.y * gridDim.z;
    unsigned sum, cnt, mine, sp = 0u;
    for (;;) {
        sum = 0u; cnt = 0u; mine = 0u;
#pragma unroll
        for (unsigned j = 0; j < 16; ++j) { const unsigned c = xb_ld(&bar[XB_XCNT(j)]); sum += c; cnt += (c > 0u) ? 1u : 0u; mine = (j == x) ? c : mine; }
        if (sum == G) break;
        __builtin_amdgcn_s_sleep(1);
        if ((++sp & 255u) == 0u) { if (xb_ld(&bar[XB_TMO])) break; if (sp > XB_SPIN_CAP) { atomicAdd(&bar[XB_TMO], 1u); break; } }
    }
    nloc = mine > 0u ? mine : 1u; nx = cnt > 0u ? cnt : 1u;
}

__device__ __forceinline__ void xcd_barrier(const XcdBarrier& b) {
    asm volatile("s_waitcnt vmcnt(0)" ::: "memory");
    __syncthreads();
    if (threadIdx.x == 0) {
        unsigned* bar = b.bar;
        __builtin_amdgcn_s_waitcnt(0);
        unsigned nloc = b.st[0], nx = b.st[1];
        if (nloc == 0u) { xcd_barrier_complete(bar, b.x, nloc, nx); b.st[0] = nloc; b.st[1] = nx; }
        const unsigned old = xb_add(&bar[XB_XSUB(b.x)], 1u);
        const unsigned gen = old / nloc;
        if (old + 1u == (gen + 1u) * nloc) {
            __builtin_amdgcn_fence(__ATOMIC_RELEASE, "agent");
            asm volatile("s_waitcnt vmcnt(0)" ::: "memory");
            const unsigned og = xb_add(&bar[XB_TOP], 1u);
            const unsigned tg = og / nx;
            if (og + 1u == (tg + 1u) * nx) xb_add(&bar[XB_TOPGEN], 1u);
            else XB_SPIN(xb_ld(&bar[XB_TOPGEN]) == tg, bar);
            __builtin_amdgcn_fence(__ATOMIC_ACQUIRE, "agent");
            xb_add(&bar[XB_XGEN(b.x)], 1u);
            asm volatile("s_waitcnt vmcnt(0)" ::: "memory");
        } else {
            XB_SPIN(xb_ld(&bar[XB_XGEN(b.x)]) == gen, bar);
            __builtin_amdgcn_fence(__ATOMIC_ACQUIRE, "agent");
            asm volatile("s_waitcnt vmcnt(0)" ::: "memory");
        }
    }
    __syncthreads();
}

struct Frame {
    LAS unsigned char* lds;
    volatile LAS unsigned* MISC;
    gu32* ctl;
    int tid, lane, wave;
    int vcu, G;
    const float *x, *c; const int* positions; const float *w_ada, *b_ada, *norm_w, *w_in, *q_norm_w, *k_norm_w, *sinks, *conv_w, *a_log, *dt_bias, *dn_norm_w, *w_o_swa, *w_o_dn, *w_out;
    float* out;
    float* modacc; bf16 *WTIN, *WOCAT, *WOUT, *H, *PROJ, *A2, *Y; float *ROPE, *DBA, *YA;
};

__device__ __forceinline__ float wave_sum(float v) {
#pragma unroll
    for (int o = 1; o < 64; o <<= 1) v += __shfl_xor(v, o);
    return v;
}

__device__ __forceinline__ void p0_transpose_item(const float* W, int ldw, bf16* WT, int ldo, int k_off, int k0, int n_src0, int n_dst0, LAS float* scr, int lane) {
    const int c = lane & 7;
    if (n_src0 < 0) {
#pragma unroll
        for (int j = 0; j < 4; ++j) { const int n = (lane >> 3) + 8 * j; *(GAS v4u*)(WT + (size_t)(n_dst0 + n) * ldo + k_off + k0 + 8 * c) = (v4u){0u, 0u, 0u, 0u}; }
        return;
    }
#pragma unroll 8
    for (int i = 0; i < 32; ++i) { const int kk = 2 * i + (lane >> 5); scr[kk * 33 + (lane & 31)] = W[(size_t)(k0 + kk) * ldw + n_src0 + (lane & 31)]; }
    LDS_WAIT(); asm volatile("" ::: "memory");
#pragma unroll
    for (int j = 0; j < 4; ++j) { const int n = (lane >> 3) + 8 * j; const LAS float* s = scr + (8 * c) * 33 + n;
        v4u o; o.x = pk2(s[0 * 33], s[1 * 33]); o.y = pk2(s[2 * 33], s[3 * 33]); o.z = pk2(s[4 * 33], s[5 * 33]); o.w = pk2(s[6 * 33], s[7 * 33]);
        *(GAS v4u*)(WT + (size_t)(n_dst0 + n) * ldo + k_off + k0 + 8 * c) = o; }
    LDS_WAIT(); asm volatile("" ::: "memory");
}
__device__ __forceinline__ int proj_src_col(int n) { return n < C_MGA ? n : (n < C_DBA ? n + 64 : (n < IN_WIDTH ? n - C_DBA + 16896 : -1)); }

__device__ __forceinline__ void p0_prologue(Frame& F) {
    LAS float* scr = (LAS float*)(F.lds + F.wave * 16384);
    const int gw = F.vcu * NWAVES + F.wave, NGW = F.G * NWAVES;
    for (int it = gw; it < 64 * 24; it += NGW) {
        const int kc = it / 24, cg = it % 24;
        f32x4 a0 = {0.f, 0.f, 0.f, 0.f}, a1 = {0.f, 0.f, 0.f, 0.f};
        const float* wp = F.w_ada + (size_t)(kc * 32) * 6144 + cg * 256 + F.lane * 4;
#pragma unroll 8
        for (int r = 0; r < 32; ++r) { const int k = kc * 32 + r; const float s0 = siluf_(F.c[k]), s1 = siluf_(F.c[DM + k]); const f32x4 w = *(const f32x4*)(wp + (size_t)r * 6144); a0 += s0 * w; a1 += s1 * w; }
        float* m0 = F.modacc + cg * 256 + F.lane * 4; float* m1 = m0 + 6144;
#pragma unroll
        for (int e = 0; e < 4; ++e) { atomicAdd(m0 + e, a0[e]); atomicAdd(m1 + e, a1[e]); }
    }
    {
        const int gt = (F.vcu * NWAVES + F.wave) * 64 + F.lane, NGT = NGW * 64;
        for (int idx = gt; idx < MTOK * 8; idx += NGT) {
            const int m = idx >> 3, j = idx & 7;
            const unsigned fb = j == 0 ? 0x3f800000u : j == 1 ? 0x3e4693afu : j == 2 ? 0x3d1a08c8u : j == 3 ? 0x3beef74eu : j == 4 ? 0x3ab95d22u : j == 5 ? 0x398fc8f8u : j == 6 ? 0x385f10c5u : 0x372d07a8u;
            const float ang = (float)F.positions[m] * __uint_as_float(fb);
            const double a = (double)ang;
            const double kq = __builtin_rint(a * 0.63661977236758134308);
            const double s = (a - kq * 1.57079632679489655800) - kq * 6.12323399573676603587e-17;
            const double s2 = s * s;
            const double sn = s * (1.0 + s2 * (-1.0 / 6 + s2 * (1.0 / 120 + s2 * (-1.0 / 5040 + s2 * (1.0 / 362880 + s2 * (-1.0 / 39916800 + s2 * (1.0 / 6227020800.0)))))));
            const double cs = 1.0 + s2 * (-0.5 + s2 * (1.0 / 24 + s2 * (-1.0 / 720 + s2 * (1.0 / 40320 + s2 * (-1.0 / 3628800 + s2 * (1.0 / 479001600 + s2 * (-1.0 / 87178291200.0)))))));
            const int q = ((int)kq) & 3;
            const double cv = q == 0 ? cs : q == 1 ? -sn : q == 2 ? -cs : sn;
            const double sv = q == 0 ? sn : q == 1 ? cs : q == 2 ? -sn : -cs;
            F.ROPE[(size_t)m * 16 + j] = (float)cv; F.ROPE[(size_t)m * 16 + 8 + j] = (float)sv;
        }
    }
    constexpr int I_IN = (DM / 64) * (NP / 32), I_OS = (DM / 64) * (DM / 32), I_OD = (4096 / 64) * (DM / 32), I_OUT = (DM / 64) * (DM / 32);
    constexpr int NITEMS = I_IN + I_OS + I_OD + I_OUT;
    for (int it = gw; it < NITEMS; it += NGW) {
        int r = it;
        if (r < I_IN) { const int kb = r / (NP / 32), nb = r % (NP / 32); p0_transpose_item(F.w_in, IN_WIDTH, F.WTIN, DM, 0, 64 * kb, proj_src_col(32 * nb), 32 * nb, scr, F.lane); continue; } r -= I_IN;
        if (r < I_OS) { const int kb = r / (DM / 32), nb = r % (DM / 32); p0_transpose_item(F.w_o_swa, DM, F.WOCAT, KCAT, 0, 64 * kb, 32 * nb, 32 * nb, scr, F.lane); continue; } r -= I_OS;
        if (r < I_OD) { const int kb = r / (DM / 32), nb = r % (DM / 32); p0_transpose_item(F.w_o_dn, DM, F.WOCAT, KCAT, 2048, 64 * kb, 32 * nb, 32 * nb, scr, F.lane); continue; } r -= I_OD;
        { const int kb = r / (DM / 32), nb = r % (DM / 32); p0_transpose_item(F.w_out, DM, F.WOUT, DM, 0, 64 * kb, 32 * nb, 32 * nb, scr, F.lane); }
    }
}

__device__ __forceinline__ void p1_hrows(Frame& F) {
    const int gw = F.vcu * NWAVES + F.wave, NGW = F.G * NWAVES;
    for (int m = gw; m < MTOK; m += NGW) {
        const int b = m / SEQ;
        const GAS f32x4* xr = (const GAS f32x4*)(F.x + (size_t)m * DM) + F.lane;
        f32x4 v[8]; float s = 0.f;
#pragma unroll
        for (int j = 0; j < 8; ++j) { v[j] = xr[64 * j]; s += (v[j].x * v[j].x + v[j].y * v[j].y) + (v[j].z * v[j].z + v[j].w * v[j].w); }
        const float rstd = rsqrtf(wave_sum(s) * (1.f / DM) + EPS);
        GAS unsigned long long* o8 = (GAS unsigned long long*)(F.H + (size_t)m * DM) + F.lane;
#pragma unroll
        for (int j = 0; j < 8; ++j) {
            const int col = 4 * F.lane + 256 * j;
            const f32x4 nw = *(const f32x4*)(F.norm_w + col);
            const f32x4 sh = *(const f32x4*)(F.modacc + (size_t)b * 6144 + col) + *(const f32x4*)(F.b_ada + col);
            const f32x4 sc = *(const f32x4*)(F.modacc + (size_t)b * 6144 + DM + col) + *(const f32x4*)(F.b_ada + DM + col);
            const f32x4 hv = (v[j] * rstd * nw) * (1.0f + sc) + sh;
            o8[64 * j] = (unsigned long long)pk2(hv.x, hv.y) | ((unsigned long long)pk2(hv.z, hv.w) << 32);
        }
    }
}

__device__ __forceinline__ void p3_attn_item_simple(Frame& F, int b, int n, int hk) {
    LAS float* Kl = (LAS float*)F.lds; LAS float* Vl = Kl + 256 * 64;
    const int tid = F.tid;
    {
        const int key = tid >> 1, half = tid & 1; const int tok = n * 128 - 128 + key;
        float kv[32], vv[32];
        if (tok >= 0) {
            const size_t row = (size_t)b * SEQ + tok;
            const v4u* kp = (const v4u*)(F.PROJ + row * NP + C_AK + hk * 64 + half * 32);
            const v4u* vp = (const v4u*)(F.PROJ + row * NP + C_AV + hk * 64 + half * 32);
#pragma unroll
            for (int i = 0; i < 4; ++i) { const v4u a = kp[i], c = vp[i];
                kv[8 * i + 0] = blo(a.x); kv[8 * i + 1] = bhi(a.x); kv[8 * i + 2] = blo(a.y); kv[8 * i + 3] = bhi(a.y); kv[8 * i + 4] = blo(a.z); kv[8 * i + 5] = bhi(a.z); kv[8 * i + 6] = blo(a.w); kv[8 * i + 7] = bhi(a.w);
                vv[8 * i + 0] = blo(c.x); vv[8 * i + 1] = bhi(c.x); vv[8 * i + 2] = blo(c.y); vv[8 * i + 3] = bhi(c.y); vv[8 * i + 4] = blo(c.z); vv[8 * i + 5] = bhi(c.z); vv[8 * i + 6] = blo(c.w); vv[8 * i + 7] = bhi(c.w); }
            float ss = 0.f;
#pragma unroll
            for (int d = 0; d < 32; ++d) ss += kv[d] * kv[d];
            ss += __shfl_xor(ss, 1);
            const float rs = rsqrtf(ss * (1.f / 64.f) + EPS);
#pragma unroll
            for (int d = 0; d < 32; ++d) kv[d] = kv[d] * rs * F.k_norm_w[half * 32 + d];
            if (half == 0) {
                const float* cs = F.ROPE + row * 16;
#pragma unroll
                for (int d = 0; d < 8; ++d) { const float x1 = kv[d], x2 = kv[8 + d], c = cs[d], s = cs[8 + d]; kv[d] = x1 * c - x2 * s; kv[8 + d] = x2 * c + x1 * s; }
            }
        } else {
#pragma unroll
            for (int d = 0; d < 32; ++d) { kv[d] = 0.f; vv[d] = 0.f; }
        }
#pragma unroll
        for (int d = 0; d < 32; d += 4) { *(LAS f32x4*)(Kl + key * 64 + half * 32 + d) = (f32x4){kv[d], kv[d + 1], kv[d + 2], kv[d + 3]}; *(LAS f32x4*)(Vl + key * 64 + half * 32 + d) = (f32x4){vv[d], vv[d + 1], vv[d + 2], vv[d + 3]}; }
    }
    __syncthreads();
    for (int pass = 0; pass < 2; ++pass) {
        const int g = (tid >> 7) + 4 * pass, i = tid & 127, h = hk * 8 + g;
        const size_t row = (size_t)b * SEQ + n * 128 + i;
        float q[64], o[64];
        {
            const v4u* qp = (const v4u*)(F.PROJ + row * NP + C_AQ + h * 64);
#pragma unroll
            for (int k = 0; k < 8; ++k) { const v4u a = qp[k];
                q[8 * k + 0] = blo(a.x); q[8 * k + 1] = bhi(a.x); q[8 * k + 2] = blo(a.y); q[8 * k + 3] = bhi(a.y); q[8 * k + 4] = blo(a.z); q[8 * k + 5] = bhi(a.z); q[8 * k + 6] = blo(a.w); q[8 * k + 7] = bhi(a.w); }
            float ss = 0.f;
#pragma unroll
            for (int d = 0; d < 64; ++d) ss += q[d] * q[d];
            const float rs = rsqrtf(ss * (1.f / 64.f) + EPS);
#pragma unroll
            for (int d = 0; d < 64; ++d) q[d] = q[d] * rs * F.q_norm_w[d];
            const float* cs = F.ROPE + row * 16;
#pragma unroll
            for (int d = 0; d < 8; ++d) { const float x1 = q[d], x2 = q[8 + d], c = cs[d], s = cs[8 + d]; q[d] = x1 * c - x2 * s; q[8 + d] = x2 * c + x1 * s; }
#pragma unroll
            for (int d = 0; d < 64; ++d) { q[d] *= 0.125f; o[d] = 0.f; }
        }
        float m = F.sinks[h], l = 1.0f;
        const int i0 = i & ~63;
        int jlo = i0 + 1, jhi = i0 + 63 + 128; if (n == 0 && jlo < 128) jlo = 128;
        for (int jj = jlo; jj <= jhi; ++jj) {
            const bool valid = (jj > i) && (jj <= i + 128);
            if (valid) {
                float s = 0.f;
#pragma unroll
                for (int d = 0; d < 64; d += 4) { const f32x4 kk = *(const LAS f32x4*)(Kl + jj * 64 + d); s += q[d] * kk.x + q[d + 1] * kk.y + q[d + 2] * kk.z + q[d + 3] * kk.w; }
                if (s > m) { const float sc = __expf(m - s); l *= sc;
#pragma unroll
                    for (int d = 0; d < 64; ++d) o[d] *= sc;
                    m = s; }
                const float p = __expf(s - m); l += p;
#pragma unroll
                for (int d = 0; d < 64; d += 4) { const f32x4 vv = *(const LAS f32x4*)(Vl + jj * 64 + d); o[d] += p * vv.x; o[d + 1] += p * vv.y; o[d + 2] += p * vv.z; o[d + 3] += p * vv.w; }
            }
        }
        const float inv = 1.0f / l;
        const v4u* gp = (const v4u*)(F.PROJ + row * NP + C_AG + h * 64);
        v4u* op = (v4u*)(F.A2 + row * KCAT + h * 64);
#pragma unroll
        for (int k = 0; k < 8; ++k) { const v4u a = gp[k]; v4u w;
            w.x = pk2(o[8 * k + 0] * inv * siluf_(blo(a.x)), o[8 * k + 1] * inv * siluf_(bhi(a.x)));
            w.y = pk2(o[8 * k + 2] * inv * siluf_(blo(a.y)), o[8 * k + 3] * inv * siluf_(bhi(a.y)));
            w.z = pk2(o[8 * k + 4] * inv * siluf_(blo(a.z)), o[8 * k + 5] * inv * siluf_(bhi(a.z)));
            w.w = pk2(o[8 * k + 6] * inv * siluf_(blo(a.w)), o[8 * k + 7] * inv * siluf_(bhi(a.w)));
            op[k] = w; }
    }
    __syncthreads();
}

__device__ __forceinline__ void p3_scan_item_simple(Frame& F, int b, int h) {
    LAS float* Qs = (LAS float*)F.lds; LAS float* Ks = Qs + 8192; LAS float* Vs = Ks + 8192; LAS float* Os = Vs + 8192;
    LAS float* bet = (LAS float*)(F.lds + SMALL_OFF); LAS float* eg = bet + 64;
    const int tid = F.tid, j = tid >> 2, dq = tid & 3, kh = h >> 1;
    float S[32];
#pragma unroll
    for (int d = 0; d < 32; ++d) S[d] = 0.f;
    const float aexp = __expf(F.a_log[h]), dtb = F.dt_bias[h];
    for (int ch = 0; ch < SEQ / 64; ++ch) {
        const int t0 = ch * 64;
        for (int idx = tid; idx < 64 * 384; idx += 512) {
            const int tok = idx / 384, c = idx - tok * 384;
            const int wch = c < 128 ? kh * 128 + c : (c < 256 ? 2048 + kh * 128 + (c - 128) : 4096 + h * 128 + (c - 256));
            float acc = 0.f;
#pragma unroll
            for (int jj = 0; jj < 4; ++jj) { const int tt = t0 + tok - 3 + jj; if (tt >= 0) acc += bf2f(F.PROJ[((size_t)b * SEQ + tt) * NP + C_DQKV + wch]) * F.conv_w[jj * 8192 + wch]; }
            const float y = siluf_(acc);
            LAS float* dst = c < 128 ? Qs : (c < 256 ? Ks : Vs);
            dst[tok * 128 + (c & 127)] = y;
        }
        if (tid < 64) { const size_t row = (size_t)b * SEQ + t0 + tid; const float db = F.DBA[row * 64 + h], da = F.DBA[row * 64 + 32 + h];
            bet[tid] = sigm_(db); const float xx = da + dtb; const float sp = xx > 20.f ? xx : log1pf(__expf(xx)); eg[tid] = __expf(-aexp * sp); }
        __syncthreads();
        for (int r = 0; r < 16; ++r) { const int row = F.wave * 16 + r; LAS float* p = row < 64 ? Qs + row * 128 : Ks + (row - 64) * 128;
            const float a = p[F.lane], bb = p[F.lane + 64]; const float ss = wave_sum(a * a + bb * bb);
            const float sc = rsqrtf(ss + EPS) * (row < 64 ? 0.08838834764831845f : 1.0f); p[F.lane] = a * sc; p[F.lane + 64] = bb * sc; }
        __syncthreads();
        for (int t = 0; t < 64; ++t) {
            const float e = eg[t], be = bet[t];
            float kk[32]; float part = 0.f;
#pragma unroll
            for (int d = 0; d < 32; d += 4) { const f32x4 k4 = *(const LAS f32x4*)(Ks + t * 128 + dq * 32 + d); kk[d] = k4.x; kk[d + 1] = k4.y; kk[d + 2] = k4.z; kk[d + 3] = k4.w; }
#pragma unroll
            for (int d = 0; d < 32; ++d) part += S[d] * kk[d];
            part += __shfl_xor(part, 1); part += __shfl_xor(part, 2);
            const float vn = be * (Vs[t * 128 + j] - e * part);
#pragma unroll
            for (int d = 0; d < 32; ++d) S[d] = e * S[d] + kk[d] * vn;
            float po = 0.f;
#pragma unroll
            for (int d = 0; d < 32; d += 4) { const f32x4 q4 = *(const LAS f32x4*)(Qs + t * 128 + dq * 32 + d); po += S[d] * q4.x + S[d + 1] * q4.y + S[d + 2] * q4.z + S[d + 3] * q4.w; }
            po += __shfl_xor(po, 1); po += __shfl_xor(po, 2);
            if (dq == 0) Os[t * 128 + j] = po;
        }
        __syncthreads();
        for (int r = 0; r < 8; ++r) { const int tok = F.wave * 8 + r; const size_t row = (size_t)b * SEQ + t0 + tok;
            const float a = Os[tok * 128 + F.lane], bb = Os[tok * 128 + F.lane + 64]; const float ss = wave_sum(a * a + bb * bb);
            const float rs = rsqrtf(ss * (1.f / 128.f) + EPS);
            const float z0 = bf2f(F.PROJ[row * NP + C_DZ + h * 128 + F.lane]), z1 = bf2f(F.PROJ[row * NP + C_DZ + h * 128 + F.lane + 64]);
            F.A2[row * KCAT + 2048 + h * 128 + F.lane] = (bf16)f2bf(a * rs * F.dn_norm_w[F.lane] * siluf_(z0));
            F.A2[row * KCAT + 2048 + h * 128 + F.lane + 64] = (bf16)f2bf(bb * rs * F.dn_norm_w[F.lane + 64] * siluf_(z1)); }
        __syncthreads();
    }
}

#ifndef MK_N_LAUNCHES
#define MK_N_LAUNCHES 7
#endif
constexpr int PER_PHASE = 7;
constexpr int N_LAUNCHES = MK_N_LAUNCHES;
struct Args { const void* in[17]; float* out; unsigned char* ws; int ph_lo, ph_hi, li, pad; };

__global__ void __launch_bounds__(NWAVES * 64, 2) skel_fwd(Args args) {
    extern __shared__ __attribute__((aligned(16))) unsigned char lds[];
    Frame F;
    F.lds = (LAS unsigned char*)lds;
    F.MISC = (volatile LAS unsigned*)(F.lds + MISC_OFF);
    F.tid = threadIdx.x; F.lane = F.tid & 63; F.wave = __builtin_amdgcn_readfirstlane(F.tid >> 6);
    F.G = gridDim.x; { const int bx = blockIdx.x; F.vcu = (F.G % 8 == 0) ? (bx % 8) * (F.G / 8) + bx / 8 : bx; }
    unsigned char* ws = args.ws;
    F.ctl = (gu32*)(ws + WS_CTL);
    F.x = (const float*)args.in[0]; F.c = (const float*)args.in[1]; F.positions = (const int*)args.in[2]; F.w_ada = (const float*)args.in[3]; F.b_ada = (const float*)args.in[4];
    F.norm_w = (const float*)args.in[5]; F.w_in = (const float*)args.in[6]; F.q_norm_w = (const float*)args.in[7]; F.k_norm_w = (const float*)args.in[8]; F.sinks = (const float*)args.in[9];
    F.conv_w = (const float*)args.in[10]; F.a_log = (const float*)args.in[11]; F.dt_bias = (const float*)args.in[12]; F.dn_norm_w = (const float*)args.in[13];
    F.w_o_swa = (const float*)args.in[14]; F.w_o_dn = (const float*)args.in[15]; F.w_out = (const float*)args.in[16]; F.out = args.out;
    F.modacc = (float*)(ws + WS_MODACC); F.WTIN = (bf16*)(ws + WS_WTIN); F.WOCAT = (bf16*)(ws + WS_WOCAT); F.WOUT = (bf16*)(ws + WS_WOUT); F.H = (bf16*)(ws + WS_H);
    F.PROJ = (bf16*)(ws + WS_PROJ); F.A2 = (bf16*)(ws + WS_A2); F.Y = (bf16*)(ws + WS_Y); F.ROPE = (float*)(ws + WS_ROPE); F.DBA = (float*)(ws + WS_DBA); F.YA = (float*)(ws + WS_YA);
    for (int u = F.tid; u < (LDS_BYTES - LDSCTL_OFF) / 4; u += NWAVES * 64) ((LAS unsigned*)(F.lds + LDSCTL_OFF))[u] = 0u;
    __syncthreads();
    XcdBarrier bar; bar.bar = (unsigned*)(F.ctl + CW_BAR) + args.li * XCD_BAR_WORDS; bar.x = 0; bar.st = nullptr;
    if (N_LAUNCHES != PER_PHASE) bar = xcd_barrier_post((unsigned*)(F.ctl + CW_BAR) + args.li * XCD_BAR_WORDS, F.MISC + 8);
#define GRID_BAR() do { if (N_LAUNCHES != PER_PHASE) xcd_barrier(bar); } while (0)
    const int lo = args.ph_lo, hi = args.ph_hi;
#define IN(k) (lo <= (k) && (k) < hi)
#define BOTH(k) (IN(k) && IN((k) + 1))

    if (IN(0)) { p0_prologue(F); if (BOTH(0)) GRID_BAR(); }
    if (IN(1)) { p1_hrows(F); if (BOTH(1)) GRID_BAR(); }
    if (IN(2)) {
        pg8::Gemm g{F.H, F.WTIN, MTOK, NP, DM, DM, DM}; pg8::StaticOrder S; S.init(MTOK, NP, F.G, (int)blockIdx.x);
        pg8::EpiProj E{F.PROJ, NP, F.DBA, PN_DBA};
        pg8::gemm_phase<pg8::EpiProj, pg8::StaticOrder, true, true>(F.lds, g, S, E);
        if (BOTH(2)) GRID_BAR();
    }
    if (IN(3)) {
        for (int it = blockIdx.x; it < 64 + 256; it += F.G) {
            if (it < 64) p3_scan_item_simple(F, it >> 5, it & 31);
            else { const int a = it - 64; p3_attn_item_simple(F, a >> 7, (a >> 2) & 31, a & 3); }
        }
        if (BOTH(3)) GRID_BAR();
    }
    if (IN(4)) {
        pg8::Gemm g{F.A2, F.WOCAT, MTOK, DM, DM, KCAT, KCAT}; pg8::StaticOrder S; S.init(MTOK, DM, F.G, (int)blockIdx.x);
        pg8::EpiGateF32 E{F.YA, DM, F.PROJ + C_MGA, NP};
        pg8::gemm_phase<pg8::EpiGateF32, pg8::StaticOrder, true, true>(F.lds, g, S, E);
        if (BOTH(4)) GRID_BAR();
    }
    if (IN(5)) {
        pg8::Gemm g{F.A2 + 2048, F.WOCAT + 2048, MTOK, DM, 4096, KCAT, KCAT}; pg8::StaticOrder S; S.init(MTOK, DM, F.G, (int)blockIdx.x);
        pg8::EpiGateAddBf16 E{F.Y, DM, F.YA, DM, F.PROJ + C_MGB, NP};
        pg8::gemm_phase<pg8::EpiGateAddBf16, pg8::StaticOrder, true, true>(F.lds, g, S, E);
        if (BOTH(5)) GRID_BAR();
    }
    if (IN(6)) {
        pg8::Gemm g{F.Y, F.WOUT, MTOK, DM, DM, DM, DM}; pg8::StaticOrder S; S.init(MTOK, DM, F.G, (int)blockIdx.x);
        pg8::EpiResid E{F.out, F.x, DM, F.modacc, F.b_ada, 2 * DM, 6144, SEQ};
        pg8::gemm_phase<pg8::EpiResid, pg8::StaticOrder, true, true>(F.lds, g, S, E);
    }
#undef IN
#undef BOTH
}

extern "C" void kernel_launch(void* const* d_in, const int* in_sizes, int n_in, void* d_out, int out_size, void* d_ws, size_t ws_size, hipStream_t stream) {
    static int grid = 0;
    if (grid == 0) {
        if (n_in != 17 || in_sizes[0] != MTOK * DM || out_size != MTOK * DM || ws_size < WS_END) { fprintf(stderr, "kernel_launch: unexpected shapes / workspace (n_in %d, in0 %d, out %d, ws %zu, need %zu); nothing launched\n", n_in, n_in > 0 ? in_sizes[0] : -1, out_size, ws_size, (size_t)WS_END); grid = -1; return; }
        int dev = 0, cus = 0, per_cu = 0;
        if (hipGetDevice(&dev) != hipSuccess || hipDeviceGetAttribute(&cus, hipDeviceAttributeMultiprocessorCount, dev) != hipSuccess) { grid = -1; return; }
        if (hipFuncSetAttribute((const void*)skel_fwd, hipFuncAttributeMaxDynamicSharedMemorySize, LDS_BYTES) != hipSuccess) { fprintf(stderr, "kernel_launch: hipFuncSetAttribute failed\n"); grid = -1; return; }
        if (hipOccupancyMaxActiveBlocksPerMultiprocessor(&per_cu, (const void*)skel_fwd, NWAVES * 64, LDS_BYTES) != hipSuccess || per_cu < 1) { fprintf(stderr, "kernel_launch: occupancy query says %d blocks per CU\n", per_cu); per_cu = 1; }
        (void)hipGetLastError();
        grid = cus;
    }
    if (grid < 0) return;
    (void)hipMemsetAsync((char*)d_ws + WS_CTL, 0, CTL_ZERO_BYTES, stream);
    Args a{};
    for (int i = 0; i < 17; ++i) a.in[i] = d_in[i];
    a.out = (float*)d_out; a.ws = (unsigned char*)d_ws;
    for (int li = 0; li < N_LAUNCHES; ++li) {
        a.ph_lo = (N_LAUNCHES == PER_PHASE) ? li : 0; a.ph_hi = (N_LAUNCHES == PER_PHASE) ? li + 1 : PER_PHASE; a.li = (N_LAUNCHES == PER_PHASE) ? 0 : li;
        hipLaunchKernelGGL(skel_fwd, dim3(grid), dim3(NWAVES * 64), LDS_BYTES, stream, a);
    }
}
```

```cpp
#include <hip/hip_runtime.h>
#include <cstdio>
#include <cstdint>

namespace pg8 {
#define PG8_LAS __attribute__((address_space(3)))
typedef unsigned short bf16_t;
typedef short bf16x8 __attribute__((ext_vector_type(8)));
typedef float f32x4 __attribute__((ext_vector_type(4)));
typedef unsigned u32x4 __attribute__((ext_vector_type(4)));
typedef unsigned u32x2 __attribute__((ext_vector_type(2)));
constexpr int BM = 256, BK = 64, HALF = 128, HTB = HALF * BK * 2  , STAGE_BYTES = 8 * HTB, NXCD = 8, WGM = 8;

__host__ __device__ __forceinline__ int lds_byte(int r, int c) { const int st = (r >> 4) * 2 + (c >> 5), rr = r & 15, cc = c & 31, ob = rr * 64 + cc * 2; return st * 1024 + (ob ^ (((ob >> 9) & 1) << 5)); }
__host__ __device__ __forceinline__ void stage_rc(int b, int& R, int& C) { const int st = b / 1024, sb = b % 1024, swz = sb ^ (((sb >> 9) & 1) << 5); R = (st >> 1) * 16 + swz / 64; C = (st & 1) * 32 + (swz % 64) / 2; }
__host__ __device__ __forceinline__ int perm32(int rho) { const int n = rho >> 4, i = rho & 15; return 8 * (i >> 2) + 4 * n + (i & 3); }

struct Unit { int pm, pn; };
struct Gemm { const bf16_t* A; const bf16_t* Bt; int M, N, K, lda, ldb; };

struct StaticOrder {
    int nM, nN, nwg, G, c;
    __host__ __device__ void init(int M, int N, int G_, int c_) { nM = M / BM; nN = N / BM; nwg = nM * nN; G = G_; c = c_; }
    __host__ __device__ bool next(int i, Unit& u) const {
        const long L = (long)i * G + c; if (L >= nwg) return false;
        int wgid = (int)L; { const int q = nwg / NXCD, r = nwg % NXCD, xcd = wgid % NXCD, off = wgid / NXCD; wgid = (xcd < r ? xcd * (q + 1) : r * (q + 1) + (xcd - r) * q) + off; }
        const int nig = WGM * nN, gid = wgid / nig, fm = gid * WGM, gsz = (nM - fm) < WGM ? (nM - fm) : WGM;
        u.pm = fm + ((wgid % nig) % gsz); u.pn = (wgid % nig) / gsz; return true;
    }
    __device__ __forceinline__ void a_ready(const Unit&) const {}
    __device__ __forceinline__ void done(const Unit&) const {}
};

__device__ __forceinline__ unsigned cvt_pk_bf16(float lo, float hi) { unsigned r; asm volatile("v_cvt_pk_bf16_f32 %0, %1, %2" : "=v"(r) : "v"(lo), "v"(hi)); return r; }
__device__ __forceinline__ float bf_lo(unsigned w) { return __uint_as_float(w << 16); }
__device__ __forceinline__ float bf_hi(unsigned w) { return __uint_as_float(w & 0xffff0000u); }
__device__ __forceinline__ float sigmoidf_(float x) { return 1.0f / (1.0f + __expf(-x)); }

struct EpiProj {
    static constexpr bool PERM = true, AFTER_DRAIN = false;
    bf16_t* O; int ldc; float* DBA; int pn_f32;
    __device__ __forceinline__ void operator()(const f32x4 (&acc)[2][2][4][2], const Unit& u, int wr, int wc, int fr, int fq) const {
        const int row0 = u.pm * BM + wr * 64 + fr;
        if (u.pn == pn_f32) {
            if (wc < 2) {
#pragma unroll
                for (int ai = 0; ai < 2; ++ai)
#pragma unroll
                    for (int m = 0; m < 4; ++m) { float* p = DBA + (size_t)(row0 + ai * HALF + m * 16) * 64 + wc * 32 + 8 * fq;
                        *(f32x4*)p = acc[ai][0][m][0]; *(f32x4*)(p + 4) = acc[ai][0][m][1]; }
            }
            return;
        }
        const int col0 = u.pn * BM + wc * 32 + 8 * fq;
#pragma unroll
        for (int ai = 0; ai < 2; ++ai)
#pragma unroll
            for (int m = 0; m < 4; ++m) { bf16_t* rowp = O + (size_t)(row0 + ai * HALF + m * 16) * ldc + col0;
#pragma unroll
                for (int bj = 0; bj < 2; ++bj) { const f32x4 v0 = acc[ai][bj][m][0], v1 = acc[ai][bj][m][1];
                    u32x4 w; w.x = cvt_pk_bf16(v0[0], v0[1]); w.y = cvt_pk_bf16(v0[2], v0[3]); w.z = cvt_pk_bf16(v1[0], v1[1]); w.w = cvt_pk_bf16(v1[2], v1[3]);
                    *(u32x4*)(rowp + bj * HALF) = w; } }
    }
};
struct EpiGateF32 {
    static constexpr bool PERM = false, AFTER_DRAIN = false;
    float* C; int ldc; const bf16_t* G; int ldg;
    __device__ __forceinline__ void operator()(const f32x4 (&acc)[2][2][4][2], const Unit& u, int wr, int wc, int fr, int fq) const {
        const int row0 = u.pm * BM + wr * 64 + fr, col0 = u.pn * BM + wc * 32 + 4 * fq;
#pragma unroll
        for (int ai = 0; ai < 2; ++ai)
#pragma unroll
            for (int m = 0; m < 4; ++m) { const size_t r = (size_t)(row0 + ai * HALF + m * 16); float* rowp = C + r * ldc + col0; const bf16_t* gp = G + r * ldg + col0;
#pragma unroll
                for (int bj = 0; bj < 2; ++bj)
#pragma unroll
                    for (int n = 0; n < 2; ++n) { const u32x2 gw = *(const u32x2*)(gp + bj * HALF + n * 16); const f32x4 a = acc[ai][bj][m][n];
                        f32x4 o; o[0] = a[0] * sigmoidf_(bf_lo(gw.x)); o[1] = a[1] * sigmoidf_(bf_hi(gw.x)); o[2] = a[2] * sigmoidf_(bf_lo(gw.y)); o[3] = a[3] * sigmoidf_(bf_hi(gw.y));
                        *(f32x4*)(rowp + bj * HALF + n * 16) = o; } }
    }
};
struct EpiGateAddBf16 {
    static constexpr bool PERM = true, AFTER_DRAIN = false;
    bf16_t* O; int ldc; const float* YA; int ldy; const bf16_t* G; int ldg;
    __device__ __forceinline__ void operator()(const f32x4 (&acc)[2][2][4][2], const Unit& u, int wr, int wc, int fr, int fq) const {
        const int row0 = u.pm * BM + wr * 64 + fr, col0 = u.pn * BM + wc * 32 + 8 * fq;
#pragma unroll
        for (int ai = 0; ai < 2; ++ai)
#pragma unroll
            for (int m = 0; m < 4; ++m) { const size_t r = (size_t)(row0 + ai * HALF + m * 16); bf16_t* rowp = O + r * ldc + col0; const float* yp = YA + r * ldy + col0; const bf16_t* gp = G + r * ldg + col0;
#pragma unroll
                for (int bj = 0; bj < 2; ++bj) { const f32x4 v0 = acc[ai][bj][m][0], v1 = acc[ai][bj][m][1];
                    const u32x4 gw = *(const u32x4*)(gp + bj * HALF); const f32x4 y0 = *(const f32x4*)(yp + bj * HALF), y1 = *(const f32x4*)(yp + bj * HALF + 4);
                    const float o0 = y0[0] + v0[0] * sigmoidf_(bf_lo(gw.x)), o1 = y0[1] + v0[1] * sigmoidf_(bf_hi(gw.x)), o2 = y0[2] + v0[2] * sigmoidf_(bf_lo(gw.y)), o3 = y0[3] + v0[3] * sigmoidf_(bf_hi(gw.y));
                    const float o4 = y1[0] + v1[0] * sigmoidf_(bf_lo(gw.z)), o5 = y1[1] + v1[1] * sigmoidf_(bf_hi(gw.z)), o6 = y1[2] + v1[2] * sigmoidf_(bf_lo(gw.w)), o7 = y1[3] + v1[3] * sigmoidf_(bf_hi(gw.w));
                    u32x4 w; w.x = cvt_pk_bf16(o0, o1); w.y = cvt_pk_bf16(o2, o3); w.z = cvt_pk_bf16(o4, o5); w.w = cvt_pk_bf16(o6, o7);
                    *(u32x4*)(rowp + bj * HALF) = w; } }
    }
};
struct EpiResid {
    static constexpr bool PERM = false, AFTER_DRAIN = false;
    float* C; const float* X; int ldc; const float* modacc; const float* bias; int goff, modld, rows_per_batch;
    __device__ __forceinline__ void operator()(const f32x4 (&acc)[2][2][4][2], const Unit& u, int wr, int wc, int fr, int fq) const {
        const int row0 = u.pm * BM + wr * 64 + fr, col0 = u.pn * BM + wc * 32 + 4 * fq;
        const int b = (u.pm * BM) / rows_per_batch;
        f32x4 gv[2][2];
#pragma unroll
        for (int bj = 0; bj < 2; ++bj)
#pragma unroll
            for (int n = 0; n < 2; ++n) gv[bj][n] = *(const f32x4*)(modacc + (size_t)b * modld + goff + col0 + bj * HALF + n * 16) + *(const f32x4*)(bias + goff + col0 + bj * HALF + n * 16);
#pragma unroll
        for (int ai = 0; ai < 2; ++ai)
#pragma unroll
            for (int m = 0; m < 4; ++m) { const size_t off = (size_t)(row0 + ai * HALF + m * 16) * ldc + col0;
#pragma unroll
                for (int bj = 0; bj < 2; ++bj)
#pragma unroll
                    for (int n = 0; n < 2; ++n) { const f32x4 xv = *(const f32x4*)(X + off + bj * HALF + n * 16); *(f32x4*)(C + off + bj * HALF + n * 16) = xv + gv[bj][n] * acc[ai][bj][m][n]; } }
    }
};

template <class Epi, class Sched, bool ALIGN_EPI = false, bool SP2 = false>
__device__ __forceinline__ void gemm_phase(PG8_LAS unsigned char* lds, const Gemm g, const Sched& S, const Epi& E) {
    const int tid = threadIdx.x, wid = __builtin_amdgcn_readfirstlane(tid >> 6), lane = tid & 63, wr = wid >> 2, wc = wid & 3, fr = lane & 15, fq = lane >> 4;
    const int K = g.K, nt = K / BK;
    unsigned voffA[2], voffB[2];
#pragma unroll
    for (int i = 0; i < 2; ++i) { int R, C; stage_rc(tid * 16 + i * 8192, R, C); const int Rb = Epi::PERM ? ((R & ~31) + perm32(R & 31)) : R;
        voffA[i] = (unsigned)(R * g.lda + C) * 2u; voffB[i] = (unsigned)(Rb * g.ldb + C) * 2u; }
    const size_t kstep = (size_t)(BK * 2);
    const size_t hstepA = (size_t)HALF * g.lda * 2, hstepB = (size_t)HALF * g.ldb * 2;
    const size_t tstepA = 2 * hstepA, tstepB = 2 * hstepB;
    const unsigned ldsw = (unsigned)wid * 1024u;
    const int aoff = lds_byte(wr * 64 + fr, fq * 8), boff = lds_byte(wc * 32 + fr, fq * 8);
#define PG8_SA(b, h) (((b) * 2 + (h)) * HTB)
#define PG8_SB(b, h) ((4 + (b) * 2 + (h)) * HTB)
#define PG8_STAGE(bufoff, gbase, voff) do { _Pragma("unroll") for (int _i = 0; _i < 2; ++_i) \
        __builtin_amdgcn_global_load_lds((const unsigned*)((const char*)(gbase) + (voff)[_i]), (PG8_LAS unsigned*)(lds + (bufoff) + ldsw + _i * 8192), 16, 0, 0); } while (0)
#define PG8_LDA(dst, b, h) do { _Pragma("unroll") for (int m = 0; m < 4; ++m) _Pragma("unroll") for (int k = 0; k < 2; ++k) dst[m][k] = *(const PG8_LAS bf16x8*)(lds + PG8_SA(b, h) + aoff + m * 2048 + k * 1024); } while (0)
#define PG8_LDB(dst, b, h) do { _Pragma("unroll") for (int n = 0; n < 2; ++n) _Pragma("unroll") for (int k = 0; k < 2; ++k) dst[n][k] = *(const PG8_LAS bf16x8*)(lds + PG8_SB(b, h) + boff + n * 2048 + k * 1024); } while (0)
#define PG8_MMA(ai, bj, At, Bt) do { __builtin_amdgcn_s_setprio(1); _Pragma("unroll") for (int m = 0; m < 4; ++m) _Pragma("unroll") for (int n = 0; n < 2; ++n) _Pragma("unroll") for (int k = 0; k < 2; ++k) \
        acc[ai][bj][m][n] = __builtin_amdgcn_mfma_f32_16x16x32_bf16(Bt[n][k], At[m][k], acc[ai][bj][m][n], 0, 0, 0); __builtin_amdgcn_s_setprio(0); } while (0)
#define PG8_WAIT_V(n) asm volatile("s_waitcnt vmcnt(" #n ")" ::: "memory")
#define PG8_WAIT_L(n) asm volatile("s_waitcnt lgkmcnt(" #n ")" ::: "memory")
#define PG8_BAR __builtin_amdgcn_s_barrier()
#define PG8_SCHED __builtin_amdgcn_sched_barrier(0)
    Unit cur, nxt; int ui = 0;
    if (!S.next(0, cur)) return;
    f32x4 acc[2][2][4][2];
#pragma unroll
    for (int a = 0; a < 2; ++a)
#pragma unroll
        for (int b = 0; b < 2; ++b)
#pragma unroll
            for (int m = 0; m < 4; ++m)
#pragma unroll
                for (int n = 0; n < 2; ++n) acc[a][b][m][n] = (f32x4){0.f, 0.f, 0.f, 0.f};
    bf16x8 At[4][2], B0[2][2], B1[2][2];
    const char* cA = (const char*)g.A + (size_t)cur.pm * tstepA; const char* cB = (const char*)g.Bt + (size_t)cur.pn * tstepB;
    S.a_ready(cur);
    if constexpr (SP2) {
        PG8_STAGE(PG8_SB(0, 0), cB, voffB); PG8_STAGE(PG8_SB(0, 1), cB + hstepB, voffB); PG8_STAGE(PG8_SA(0, 0), cA, voffA); PG8_STAGE(PG8_SA(0, 1), cA + hstepA, voffA);
        if (wr == 1) PG8_BAR;
        PG8_WAIT_V(2); PG8_BAR;
        PG8_STAGE(PG8_SB(1, 0), cB + kstep, voffB); PG8_STAGE(PG8_SA(1, 0), cA + kstep, voffA); PG8_STAGE(PG8_SB(1, 1), cB + hstepB + kstep, voffB);
        PG8_WAIT_V(6); PG8_BAR;
    } else {
        PG8_STAGE(PG8_SB(0, 0), cB, voffB); PG8_STAGE(PG8_SA(0, 0), cA, voffA); PG8_STAGE(PG8_SB(0, 1), cB + hstepB, voffB); PG8_STAGE(PG8_SA(0, 1), cA + hstepA, voffA);
        if (wr == 1) PG8_BAR;
        PG8_WAIT_V(4); PG8_BAR;
        PG8_STAGE(PG8_SB(1, 0), cB + kstep, voffB); PG8_STAGE(PG8_SA(1, 0), cA + kstep, voffA); PG8_STAGE(PG8_SB(1, 1), cB + hstepB + kstep, voffB);
        PG8_WAIT_V(6); PG8_BAR;
    }
    for (;;) {
        const bool has_next = S.next(ui + 1, nxt);
        const char* nA = has_next ? (const char*)g.A + (size_t)nxt.pm * tstepA : cA; const char* nB = has_next ? (const char*)g.Bt + (size_t)nxt.pn * tstepB : cB;
        for (int t = 0; t < nt; t += 2) {
            const bool last = (t == nt - 2);
            const char* a1 = cA + (size_t)(t + 1) * kstep;
            const char* a2 = last ? nA : cA + (size_t)(t + 2) * kstep; const char* b2 = last ? nB : cB + (size_t)(t + 2) * kstep;
            const char* a3 = a2 + kstep; const char* b3 = b2 + kstep;
            if (last && has_next) S.a_ready(nxt);
            if constexpr (SP2) {
            PG8_LDB(B0, 0, 0); PG8_LDB(B1, 0, 1); PG8_SCHED; PG8_LDA(At, 0, 0); PG8_STAGE(PG8_SA(1, 1), a1 + hstepA, voffA);
            PG8_WAIT_V(8); PG8_WAIT_L(0); PG8_BAR; PG8_MMA(0, 0, At, B0); PG8_MMA(0, 1, At, B1); PG8_BAR; PG8_SCHED;
            PG8_LDA(At, 0, 1); PG8_STAGE(PG8_SB(0, 0), b2, voffB); PG8_STAGE(PG8_SB(0, 1), b2 + hstepB, voffB); PG8_STAGE(PG8_SA(0, 0), a2, voffA);
            PG8_WAIT_V(8); PG8_WAIT_L(0); PG8_BAR; PG8_MMA(1, 0, At, B0); PG8_MMA(1, 1, At, B1); PG8_BAR; PG8_SCHED;
            PG8_LDB(B0, 1, 0); PG8_LDB(B1, 1, 1); PG8_SCHED; PG8_LDA(At, 1, 0); PG8_STAGE(PG8_SA(0, 1), a2 + hstepA, voffA);
            PG8_WAIT_V(8); PG8_WAIT_L(0); PG8_BAR; PG8_MMA(0, 0, At, B0); PG8_MMA(0, 1, At, B1); PG8_BAR; PG8_SCHED;
            PG8_LDA(At, 1, 1); PG8_STAGE(PG8_SB(1, 0), b3, voffB); PG8_STAGE(PG8_SB(1, 1), b3 + hstepB, voffB); PG8_STAGE(PG8_SA(1, 0), a3, voffA);
            PG8_WAIT_V(8); PG8_WAIT_L(0); PG8_BAR; PG8_MMA(1, 0, At, B0); PG8_MMA(1, 1, At, B1); PG8_BAR; PG8_SCHED;
            } else {
            PG8_LDB(B0, 0, 0); PG8_SCHED; PG8_LDA(At, 0, 0); PG8_STAGE(PG8_SA(1, 1), a1 + hstepA, voffA);
            PG8_WAIT_L(8); PG8_BAR; PG8_WAIT_L(0); PG8_MMA(0, 0, At, B0); PG8_BAR; PG8_SCHED;
            PG8_LDB(B1, 0, 1); PG8_STAGE(PG8_SB(0, 0), b2, voffB);
            PG8_BAR; PG8_WAIT_L(0); PG8_MMA(0, 1, At, B1); PG8_BAR;
            PG8_LDA(At, 0, 1); PG8_STAGE(PG8_SA(0, 0), a2, voffA);
            PG8_BAR; PG8_WAIT_L(0); PG8_MMA(1, 0, At, B0); PG8_BAR; PG8_SCHED;
            PG8_STAGE(PG8_SB(0, 1), b2 + hstepB, voffB);
            PG8_WAIT_V(6); PG8_BAR; PG8_MMA(1, 1, At, B1); PG8_BAR;
            PG8_LDB(B0, 1, 0); PG8_SCHED; PG8_LDA(At, 1, 0); PG8_STAGE(PG8_SA(0, 1), a2 + hstepA, voffA);
            PG8_WAIT_L(8); PG8_BAR; PG8_WAIT_L(0); PG8_MMA(0, 0, At, B0); PG8_BAR; PG8_SCHED;
            PG8_LDB(B1, 1, 1); PG8_STAGE(PG8_SB(1, 0), b3, voffB);
            PG8_BAR; PG8_WAIT_L(0); PG8_MMA(0, 1, At, B1); PG8_BAR;
            PG8_LDA(At, 1, 1); PG8_STAGE(PG8_SA(1, 0), a3, voffA);
            PG8_BAR; PG8_WAIT_L(0); PG8_MMA(1, 0, At, B0); PG8_BAR; PG8_SCHED;
            PG8_STAGE(PG8_SB(1, 1), b3 + hstepB, voffB);
            PG8_WAIT_V(6); PG8_BAR; PG8_MMA(1, 1, At, B1); PG8_BAR;
            }
        }
        if constexpr (ALIGN_EPI) { if (wr == 0) PG8_BAR; }
        if constexpr (!Epi::AFTER_DRAIN) { E(acc, cur, wr, wc, fr, fq); S.done(cur); }
        if (!has_next) break;
#pragma unroll
        for (int a = 0; a < 2; ++a)
#pragma unroll
            for (int b = 0; b < 2; ++b)
#pragma unroll
                for (int m = 0; m < 4; ++m)
#pragma unroll
                    for (int n = 0; n < 2; ++n) acc[a][b][m][n] = (f32x4){0.f, 0.f, 0.f, 0.f};
        cur = nxt; cA = nA; cB = nB; ++ui;
        if constexpr (ALIGN_EPI) { if (wr == 1) PG8_BAR; }
    }
    PG8_WAIT_V(0);
    if constexpr (!ALIGN_EPI) { if (wr == 0) PG8_BAR; }
    PG8_BAR;
    if constexpr (Epi::AFTER_DRAIN) { E.fused(acc, cur, wr, wc, fr, fq, lds, wid, lane); S.done(cur); }
#undef PG8_SA
#undef PG8_SB
#undef PG8_STAGE
#undef PG8_LDA
#undef PG8_LDB
#undef PG8_MMA
#undef PG8_WAIT_V
#undef PG8_WAIT_L
#undef PG8_BAR
#undef PG8_SCHED
}
}

constexpr int NWAVES = 8;
constexpr int DM = 2048, NBATCH = 2, SEQ = 4096, MTOK = NBATCH * SEQ;
constexpr int IN_WIDTH = 21056, NP = 21248;
constexpr int C_AQ = 0, C_AK = 2048, C_AV = 2304, C_AG = 2560, C_DQKV = 4608, C_DZ = 12800, C_MGA = 16896, C_MGB = 18944, C_DBA = 20992;
constexpr int PN_DBA = C_DBA / 256;
constexpr int KCAT = 6144;
constexpr float EPS = 1e-6f;

constexpr size_t MiB = 1u << 20;
constexpr size_t WS_CTL = 0, CTL_ZERO_BYTES = 128 * 1024;
constexpr size_t WS_MODACC = 64 * 1024;
constexpr size_t WS_WTIN = 2 * MiB;
constexpr size_t WS_WOCAT = 85 * MiB;
constexpr size_t WS_WOUT = 109 * MiB;
constexpr size_t WS_H = 117 * MiB;
constexpr size_t WS_PROJ = 149 * MiB;
constexpr size_t WS_A2 = 481 * MiB;
constexpr size_t WS_Y = 577 * MiB;
constexpr size_t WS_ROPE = 609 * MiB;
constexpr size_t WS_DBA = 610 * MiB;
constexpr size_t WS_END = 612 * MiB;
constexpr size_t WS_YA = 2 * MiB;
static_assert(WS_WTIN + (size_t)NP * DM * 2 <= WS_WOCAT && WS_PROJ + (size_t)MTOK * NP * 2 <= WS_A2 && WS_YA + (size_t)MTOK * DM * 4 <= WS_WOCAT, "d_ws map");
constexpr int CW_BAR = 1024;

constexpr int RING_BYTES = 131072;
constexpr int LDSCTL_OFF = RING_BYTES, MISC_OFF = LDSCTL_OFF + 320;
constexpr int SMALL_OFF = RING_BYTES + 1024;
constexpr int LDS_BYTES = 147456;

#define GAS __attribute__((address_space(1)))
#define LAS __attribute__((address_space(3)))
typedef unsigned short bf16;
typedef unsigned v4u __attribute__((ext_vector_type(4)));
typedef float f32x4 __attribute__((ext_vector_type(4)));
typedef GAS unsigned gu32;
#define RLX_AGENT __ATOMIC_RELAXED, __HIP_MEMORY_SCOPE_AGENT
#define LDS_WAIT() asm volatile("s_waitcnt lgkmcnt(0)" ::: "memory")
#define VM_WAIT() asm volatile("s_waitcnt vmcnt(0)" ::: "memory")
__device__ __forceinline__ unsigned f2bf(float f) { unsigned u = __builtin_bit_cast(unsigned, f); return (u + 0x7fffu + ((u >> 16) & 1u)) >> 16; }
__device__ __forceinline__ unsigned pk2(float lo, float hi) { return f2bf(lo) | (f2bf(hi) << 16); }
__device__ __forceinline__ float bf2f(bf16 v) { return __uint_as_float((unsigned)v << 16); }
__device__ __forceinline__ float blo(unsigned w) { return __uint_as_float(w << 16); }
__device__ __forceinline__ float bhi(unsigned w) { return __uint_as_float(w & 0xffff0000u); }
__device__ __forceinline__ float siluf_(float x) { return x / (1.0f + __expf(-x)); }
__device__ __forceinline__ float sigm_(float x) { return 1.0f / (1.0f + __expf(-x)); }

#define XB_TMO      128
#define XB_XCNT(j)  (256  + 64 * (j))
#define XB_XSUB(j)  (1280 + 64 * (j))
#define XB_XGEN(j)  (2304 + 64 * (j))
#define XB_TOP      3328
#define XB_TOPGEN   3392
#define XCD_BAR_WORDS 3456
#define XB_SPIN_CAP (1u << 18)

__device__ __forceinline__ unsigned xb_ld(unsigned* p)              { return __hip_atomic_load(p, __ATOMIC_RELAXED, __HIP_MEMORY_SCOPE_AGENT); }
__device__ __forceinline__ unsigned xb_add(unsigned* p, unsigned v) { return __hip_atomic_fetch_add(p, v, __ATOMIC_RELAXED, __HIP_MEMORY_SCOPE_AGENT); }
__device__ __forceinline__ unsigned xb_xcc_id() { return (unsigned)__builtin_amdgcn_s_getreg((3 << 11) | 20) & 0xFu; }
#define XB_SPIN(cond, bar) do { unsigned _sp = 0; while (cond) { __builtin_amdgcn_s_sleep(1); \
    if ((++_sp & 255u) == 0u) { if (xb_ld(&(bar)[XB_TMO])) break; if (_sp > XB_SPIN_CAP) { atomicAdd(&(bar)[XB_TMO], 1u); break; } } } } while (0)

struct XcdBarrier {
    unsigned* bar; unsigned x;
    volatile LAS unsigned* st;
};

__device__ __forceinline__ XcdBarrier xcd_barrier_post(unsigned* bar, volatile LAS unsigned* st) {
    XcdBarrier b; b.bar = bar; b.x = xb_xcc_id(); b.st = st;
    if (threadIdx.x == 0) (void)xb_add(&bar[XB_XCNT(b.x)], 1u);
    return b;
}
__device__ __forceinline__ void xcd_barrier_complete(unsigned* bar, unsigned x, unsigned& nloc, unsigned& nx) {
    const unsigned G = gridDim.x * gridDim.y * gridDim.z;
    unsigned sum, cnt, mine, sp = 0u;
    for (;;) {
        sum = 0u; cnt = 0u; mine = 0u;
#pragma unroll
        for (unsigned j = 0; j < 16; ++j) { const unsigned c = xb_ld(&bar[XB_XCNT(j)]); sum += c; cnt += (c > 0u) ? 1u : 0u; mine = (j == x) ? c : mine; }
        if (sum == G) break;
        __builtin_amdgcn_s_sleep(1);
        if ((++sp & 255u) == 0u) { if (xb_ld(&bar[XB_TMO])) break; if (sp > XB_SPIN_CAP) { atomicAdd(&bar[XB_TMO], 1u); break; } }
    }
    nloc = mine > 0u ? mine : 1u; nx = cnt > 0u ? cnt : 1u;
}

__device__ __forceinline__ void xcd_barrier(const XcdBarrier& b) {
    asm volatile("s_waitcnt vmcnt(0)" ::: "memory");
    __syncthreads();
    if (threadIdx.x == 0) {
        unsigned* bar = b.bar;
        __builtin_amdgcn_s_waitcnt(0);
        unsigned nloc = b.st[0], nx = b.st[1];
        if (nloc == 0u) { xcd_barrier_complete(bar, b.x, nloc, nx); b.st[0] = nloc; b.st[1] = nx; }
        const unsigned old = xb_add(&bar[XB_XSUB(b.x)], 1u);
        const unsigned gen = old / nloc;
        if (old + 1u == (gen + 1u) * nloc) {
            __builtin_amdgcn_fence(__ATOMIC_RELEASE, "agent");
            asm volatile("s_waitcnt vmcnt(0)" ::: "memory");
            const unsigned og = xb_add(&bar[XB_TOP], 1u);
            const unsigned tg = og / nx;
            if (og + 1u == (tg + 1u) * nx) xb_add(&bar[XB_TOPGEN], 1u);
            else XB_SPIN(xb_ld(&bar[XB_TOPGEN]) == tg, bar);
            __builtin_amdgcn_fence(__ATOMIC_ACQUIRE, "agent");
            xb_add(&bar[XB_XGEN(b.x)], 1u);
            asm volatile("s_waitcnt vmcnt(0)" ::: "memory");
        } else {
            XB_SPIN(xb_ld(&bar[XB_XGEN(b.x)]) == gen, bar);
            __builtin_amdgcn_fence(__ATOMIC_ACQUIRE, "agent");
            asm volatile("s_waitcnt vmcnt(0)" ::: "memory");
        }
    }
    __syncthreads();
}

struct Frame {
    LAS unsigned char* lds;
    volatile LAS unsigned* MISC;
    gu32* ctl;
    int tid, lane, wave;
    int vcu, G;
    const float *x, *c; const int* positions; const float *w_ada, *b_ada, *norm_w, *w_in, *q_norm_w, *k_norm_w, *sinks, *conv_w, *a_log, *dt_bias, *dn_norm_w, *w_o_swa, *w_o_dn, *w_out;
    float* out;
    float* modacc; bf16 *WTIN, *WOCAT, *WOUT, *H, *PROJ, *A2, *Y; float *ROPE, *DBA, *YA;
};

__device__ __forceinline__ float wave_sum(float v) {
#pragma unroll
    for (int o = 1; o < 64; o <<= 1) v += __shfl_xor(v, o);
    return v;
}

__device__ __forceinline__ void p0_transpose_item(const float* W, int ldw, bf16* WT, int ldo, int k_off, int k0, int n_src0, int n_dst0, LAS float* scr, int lane) {
    const int c = lane & 7;
    if (n_src0 < 0) {
#pragma unroll
        for (int j = 0; j < 4; ++j) { const int n = (lane >> 3) + 8 * j; *(GAS v4u*)(WT + (size_t)(n_dst0 + n) * ldo + k_off + k0 + 8 * c) = (v4u){0u, 0u, 0u, 0u}; }
        return;
    }
#pragma unroll 8
    for (int i = 0; i < 32; ++i) { const int kk = 2 * i + (lane >> 5); scr[kk * 33 + (lane & 31)] = W[(size_t)(k0 + kk) * ldw + n_src0 + (lane & 31)]; }
    LDS_WAIT(); asm volatile("" ::: "memory");
#pragma unroll
    for (int j = 0; j < 4; ++j) { const int n = (lane >> 3) + 8 * j; const LAS float* s = scr + (8 * c) * 33 + n;
        v4u o; o.x = pk2(s[0 * 33], s[1 * 33]); o.y = pk2(s[2 * 33], s[3 * 33]); o.z = pk2(s[4 * 33], s[5 * 33]); o.w = pk2(s[6 * 33], s[7 * 33]);
        *(GAS v4u*)(WT + (size_t)(n_dst0 + n) * ldo + k_off + k0 + 8 * c) = o; }
    LDS_WAIT(); asm volatile("" ::: "memory");
}
__device__ __forceinline__ int proj_src_col(int n) { return n < C_MGA ? n : (n < C_DBA ? n + 64 : (n < IN_WIDTH ? n - C_DBA + 16896 : -1)); }

__device__ __forceinline__ void p0_prologue(Frame& F) {
    LAS float* scr = (LAS float*)(F.lds + F.wave * 16384);
    const int gw = F.vcu * NWAVES + F.wave, NGW = F.G * NWAVES;
    for (int it = gw; it < 64 * 24; it += NGW) {
        const int kc = it / 24, cg = it % 24;
        f32x4 a0 = {0.f, 0.f, 0.f, 0.f}, a1 = {0.f, 0.f, 0.f, 0.f};
        const float* wp = F.w_ada + (size_t)(kc * 32) * 6144 + cg * 256 + F.lane * 4;
#pragma unroll 8
        for (int r = 0; r < 32; ++r) { const int k = kc * 32 + r; const float s0 = siluf_(F.c[k]), s1 = siluf_(F.c[DM + k]); const f32x4 w = *(const f32x4*)(wp + (size_t)r * 6144); a0 += s0 * w; a1 += s1 * w; }
        float* m0 = F.modacc + cg * 256 + F.lane * 4; float* m1 = m0 + 6144;
#pragma unroll
        for (int e = 0; e < 4; ++e) { atomicAdd(m0 + e, a0[e]); atomicAdd(m1 + e, a1[e]); }
    }
    {
        const int gt = (F.vcu * NWAVES + F.wave) * 64 + F.lane, NGT = NGW * 64;
        for (int idx = gt; idx < MTOK * 8; idx += NGT) {
            const int m = idx >> 3, j = idx & 7;
            const unsigned fb = j == 0 ? 0x3f800000u : j == 1 ? 0x3e4693afu : j == 2 ? 0x3d1a08c8u : j == 3 ? 0x3beef74eu : j == 4 ? 0x3ab95d22u : j == 5 ? 0x398fc8f8u : j == 6 ? 0x385f10c5u : 0x372d07a8u;
            const float ang = (float)F.positions[m] * __uint_as_float(fb);
            const double a = (double)ang;
            const double kq = __builtin_rint(a * 0.63661977236758134308);
            const double s = (a - kq * 1.57079632679489655800) - kq * 6.12323399573676603587e-17;
            const double s2 = s * s;
            const double sn = s * (1.0 + s2 * (-1.0 / 6 + s2 * (1.0 / 120 + s2 * (-1.0 / 5040 + s2 * (1.0 / 362880 + s2 * (-1.0 / 39916800 + s2 * (1.0 / 6227020800.0)))))));
            const double cs = 1.0 + s2 * (-0.5 + s2 * (1.0 / 24 + s2 * (-1.0 / 720 + s2 * (1.0 / 40320 + s2 * (-1.0 / 3628800 + s2 * (1.0 / 479001600 + s2 * (-1.0 / 87178291200.0)))))));
            const int q = ((int)kq) & 3;
            const double cv = q == 0 ? cs : q == 1 ? -sn : q == 2 ? -cs : sn;
            const double sv = q == 0 ? sn : q == 1 ? cs : q == 2 ? -sn : -cs;
            F.ROPE[(size_t)m * 16 + j] = (float)cv; F.ROPE[(size_t)m * 16 + 8 + j] = (float)sv;
        }
    }
    constexpr int I_IN = (DM / 64) * (NP / 32), I_OS = (DM / 64) * (DM / 32), I_OD = (4096 / 64) * (DM / 32), I_OUT = (DM / 64) * (DM / 32);
    constexpr int NITEMS = I_IN + I_OS + I_OD + I_OUT;
    for (int it = gw; it < NITEMS; it += NGW) {
        int r = it;
        if (r < I_IN) { const int kb = r / (NP / 32), nb = r % (NP / 32); p0_transpose_item(F.w_in, IN_WIDTH, F.WTIN, DM, 0, 64 * kb, proj_src_col(32 * nb), 32 * nb, scr, F.lane); continue; } r -= I_IN;
        if (r < I_OS) { const int kb = r / (DM / 32), nb = r % (DM / 32); p0_transpose_item(F.w_o_swa, DM, F.WOCAT, KCAT, 0, 64 * kb, 32 * nb, 32 * nb, scr, F.lane); continue; } r -= I_OS;
        if (r < I_OD) { const int kb = r / (DM / 32), nb = r % (DM / 32); p0_transpose_item(F.w_o_dn, DM, F.WOCAT, KCAT, 2048, 64 * kb, 32 * nb, 32 * nb, scr, F.lane); continue; } r -= I_OD;
        { const int kb = r / (DM / 32), nb = r % (DM / 32); p0_transpose_item(F.w_out, DM, F.WOUT, DM, 0, 64 * kb, 32 * nb, 32 * nb, scr, F.lane); }
    }
}

__device__ __forceinline__ void p1_hrows(Frame& F) {
    const int gw = F.vcu * NWAVES + F.wave, NGW = F.G * NWAVES;
    for (int m = gw; m < MTOK; m += NGW) {
        const int b = m / SEQ;
        const GAS f32x4* xr = (const GAS f32x4*)(F.x + (size_t)m * DM) + F.lane;
        f32x4 v[8]; float s = 0.f;
#pragma unroll
        for (int j = 0; j < 8; ++j) { v[j] = xr[64 * j]; s += (v[j].x * v[j].x + v[j].y * v[j].y) + (v[j].z * v[j].z + v[j].w * v[j].w); }
        const float rstd = rsqrtf(wave_sum(s) * (1.f / DM) + EPS);
        GAS unsigned long long* o8 = (GAS unsigned long long*)(F.H + (size_t)m * DM) + F.lane;
#pragma unroll
        for (int j = 0; j < 8; ++j) {
            const int col = 4 * F.lane + 256 * j;
            const f32x4 nw = *(const f32x4*)(F.norm_w + col);
            const f32x4 sh = *(const f32x4*)(F.modacc + (size_t)b * 6144 + col) + *(const f32x4*)(F.b_ada + col);
            const f32x4 sc = *(const f32x4*)(F.modacc + (size_t)b * 6144 + DM + col) + *(const f32x4*)(F.b_ada + DM + col);
            const f32x4 hv = (v[j] * rstd * nw) * (1.0f + sc) + sh;
            o8[64 * j] = (unsigned long long)pk2(hv.x, hv.y) | ((unsigned long long)pk2(hv.z, hv.w) << 32);
        }
    }
}

__device__ __forceinline__ void p3_attn_item_simple(Frame& F, int b, int n, int hk) {
    LAS float* Kl = (LAS float*)F.lds; LAS float* Vl = Kl + 256 * 64;
    const int tid = F.tid;
    {
        const int key = tid >> 1, half = tid & 1; const int tok = n * 128 - 128 + key;
        float kv[32], vv[32];
        if (tok >= 0) {
            const size_t row = (size_t)b * SEQ + tok;
            const v4u* kp = (const v4u*)(F.PROJ + row * NP + C_AK + hk * 64 + half * 32);
            const v4u* vp = (const v4u*)(F.PROJ + row * NP + C_AV + hk * 64 + half * 32);
#pragma unroll
            for (int i = 0; i < 4; ++i) { const v4u a = kp[i], c = vp[i];
                kv[8 * i + 0] = blo(a.x); kv[8 * i + 1] = bhi(a.x); kv[8 * i + 2] = blo(a.y); kv[8 * i + 3] = bhi(a.y); kv[8 * i + 4] = blo(a.z); kv[8 * i + 5] = bhi(a.z); kv[8 * i + 6] = blo(a.w); kv[8 * i + 7] = bhi(a.w);
                vv[8 * i + 0] = blo(c.x); vv[8 * i + 1] = bhi(c.x); vv[8 * i + 2] = blo(c.y); vv[8 * i + 3] = bhi(c.y); vv[8 * i + 4] = blo(c.z); vv[8 * i + 5] = bhi(c.z); vv[8 * i + 6] = blo(c.w); vv[8 * i + 7] = bhi(c.w); }
            float ss = 0.f;
#pragma unroll
            for (int d = 0; d < 32; ++d) ss += kv[d] * kv[d];
            ss += __shfl_xor(ss, 1);
            const float rs = rsqrtf(ss * (1.f / 64.f) + EPS);
#pragma unroll
            for (int d = 0; d < 32; ++d) kv[d] = kv[d] * rs * F.k_norm_w[half * 32 + d];
            if (half == 0) {
                const float* cs = F.ROPE + row * 16;
#pragma unroll
                for (int d = 0; d < 8; ++d) { const float x1 = kv[d], x2 = kv[8 + d], c = cs[d], s = cs[8 + d]; kv[d] = x1 * c - x2 * s; kv[8 + d] = x2 * c + x1 * s; }
            }
        } else {
#pragma unroll
            for (int d = 0; d < 32; ++d) { kv[d] = 0.f; vv[d] = 0.f; }
        }
#pragma unroll
        for (int d = 0; d < 32; d += 4) { *(LAS f32x4*)(Kl + key * 64 + half * 32 + d) = (f32x4){kv[d], kv[d + 1], kv[d + 2], kv[d + 3]}; *(LAS f32x4*)(Vl + key * 64 + half * 32 + d) = (f32x4){vv[d], vv[d + 1], vv[d + 2], vv[d + 3]}; }
    }
    __syncthreads();
    for (int pass = 0; pass < 2; ++pass) {
        const int g = (tid >> 7) + 4 * pass, i = tid & 127, h = hk * 8 + g;
        const size_t row = (size_t)b * SEQ + n * 128 + i;
        float q[64], o[64];
        {
            const v4u* qp = (const v4u*)(F.PROJ + row * NP + C_AQ + h * 64);
#pragma unroll
            for (int k = 0; k < 8; ++k) { const v4u a = qp[k];
                q[8 * k + 0] = blo(a.x); q[8 * k + 1] = bhi(a.x); q[8 * k + 2] = blo(a.y); q[8 * k + 3] = bhi(a.y); q[8 * k + 4] = blo(a.z); q[8 * k + 5] = bhi(a.z); q[8 * k + 6] = blo(a.w); q[8 * k + 7] = bhi(a.w); }
            float ss = 0.f;
#pragma unroll
            for (int d = 0; d < 64; ++d) ss += q[d] * q[d];
            const float rs = rsqrtf(ss * (1.f / 64.f) + EPS);
#pragma unroll
            for (int d = 0; d < 64; ++d) q[d] = q[d] * rs * F.q_norm_w[d];
            const float* cs = F.ROPE + row * 16;
#pragma unroll
            for (int d = 0; d < 8; ++d) { const float x1 = q[d], x2 = q[8 + d], c = cs[d], s = cs[8 + d]; q[d] = x1 * c - x2 * s; q[8 + d] = x2 * c + x1 * s; }
#pragma unroll
            for (int d = 0; d < 64; ++d) { q[d] *= 0.125f; o[d] = 0.f; }
        }
        float m = F.sinks[h], l = 1.0f;
        const int i0 = i & ~63;
        int jlo = i0 + 1, jhi = i0 + 63 + 128; if (n == 0 && jlo < 128) jlo = 128;
        for (int jj = jlo; jj <= jhi; ++jj) {
            const bool valid = (jj > i) && (jj <= i + 128);
            if (valid) {
                float s = 0.f;
#pragma unroll
                for (int d = 0; d < 64; d += 4) { const f32x4 kk = *(const LAS f32x4*)(Kl + jj * 64 + d); s += q[d] * kk.x + q[d + 1] * kk.y + q[d + 2] * kk.z + q[d + 3] * kk.w; }
                if (s > m) { const float sc = __expf(m - s); l *= sc;
#pragma unroll
                    for (int d = 0; d < 64; ++d) o[d] *= sc;
                    m = s; }
                const float p = __expf(s - m); l += p;
#pragma unroll
                for (int d = 0; d < 64; d += 4) { const f32x4 vv = *(const LAS f32x4*)(Vl + jj * 64 + d); o[d] += p * vv.x; o[d + 1] += p * vv.y; o[d + 2] += p * vv.z; o[d + 3] += p * vv.w; }
            }
        }
        const float inv = 1.0f / l;
        const v4u* gp = (const v4u*)(F.PROJ + row * NP + C_AG + h * 64);
        v4u* op = (v4u*)(F.A2 + row * KCAT + h * 64);
#pragma unroll
        for (int k = 0; k < 8; ++k) { const v4u a = gp[k]; v4u w;
            w.x = pk2(o[8 * k + 0] * inv * siluf_(blo(a.x)), o[8 * k + 1] * inv * siluf_(bhi(a.x)));
            w.y = pk2(o[8 * k + 2] * inv * siluf_(blo(a.y)), o[8 * k + 3] * inv * siluf_(bhi(a.y)));
            w.z = pk2(o[8 * k + 4] * inv * siluf_(blo(a.z)), o[8 * k + 5] * inv * siluf_(bhi(a.z)));
            w.w = pk2(o[8 * k + 6] * inv * siluf_(blo(a.w)), o[8 * k + 7] * inv * siluf_(bhi(a.w)));
            op[k] = w; }
    }
    __syncthreads();
}

__device__ __forceinline__ void p3_scan_item_simple(Frame& F, int b, int h) {
    LAS float* Qs = (LAS float*)F.lds; LAS float* Ks = Qs + 8192; LAS float* Vs = Ks + 8192; LAS float* Os = Vs + 8192;
    LAS float* bet = (LAS float*)(F.lds + SMALL_OFF); LAS float* eg = bet + 64;
    const int tid = F.tid, j = tid >> 2, dq = tid & 3, kh = h >> 1;
    float S[32];
#pragma unroll
    for (int d = 0; d < 32; ++d) S[d] = 0.f;
    const float aexp = __expf(F.a_log[h]), dtb = F.dt_bias[h];
    for (int ch = 0; ch < SEQ / 64; ++ch) {
        const int t0 = ch * 64;
        for (int idx = tid; idx < 64 * 384; idx += 512) {
            const int tok = idx / 384, c = idx - tok * 384;
            const int wch = c < 128 ? kh * 128 + c : (c < 256 ? 2048 + kh * 128 + (c - 128) : 4096 + h * 128 + (c - 256));
            float acc = 0.f;
#pragma unroll
            for (int jj = 0; jj < 4; ++jj) { const int tt = t0 + tok - 3 + jj; if (tt >= 0) acc += bf2f(F.PROJ[((size_t)b * SEQ + tt) * NP + C_DQKV + wch]) * F.conv_w[jj * 8192 + wch]; }
            const float y = siluf_(acc);
            LAS float* dst = c < 128 ? Qs : (c < 256 ? Ks : Vs);
            dst[tok * 128 + (c & 127)] = y;
        }
        if (tid < 64) { const size_t row = (size_t)b * SEQ + t0 + tid; const float db = F.DBA[row * 64 + h], da = F.DBA[row * 64 + 32 + h];
            bet[tid] = sigm_(db); const float xx = da + dtb; const float sp = xx > 20.f ? xx : log1pf(__expf(xx)); eg[tid] = __expf(-aexp * sp); }
        __syncthreads();
        for (int r = 0; r < 16; ++r) { const int row = F.wave * 16 + r; LAS float* p = row < 64 ? Qs + row * 128 : Ks + (row - 64) * 128;
            const float a = p[F.lane], bb = p[F.lane + 64]; const float ss = wave_sum(a * a + bb * bb);
            const float sc = rsqrtf(ss + EPS) * (row < 64 ? 0.08838834764831845f : 1.0f); p[F.lane] = a * sc; p[F.lane + 64] = bb * sc; }
        __syncthreads();
        for (int t = 0; t < 64; ++t) {
            const float e = eg[t], be = bet[t];
            float kk[32]; float part = 0.f;
#pragma unroll
            for (int d = 0; d < 32; d += 4) { const f32x4 k4 = *(const LAS f32x4*)(Ks + t * 128 + dq * 32 + d); kk[d] = k4.x; kk[d + 1] = k4.y; kk[d + 2] = k4.z; kk[d + 3] = k4.w; }
#pragma unroll
            for (int d = 0; d < 32; ++d) part += S[d] * kk[d];
            part += __shfl_xor(part, 1); part += __shfl_xor(part, 2);
            const float vn = be * (Vs[t * 128 + j] - e * part);
#pragma unroll
            for (int d = 0; d < 32; ++d) S[d] = e * S[d] + kk[d] * vn;
            float po = 0.f;
#pragma unroll
            for (int d = 0; d < 32; d += 4) { const f32x4 q4 = *(const LAS f32x4*)(Qs + t * 128 + dq * 32 + d); po += S[d] * q4.x + S[d + 1] * q4.y + S[d + 2] * q4.z + S[d + 3] * q4.w; }
            po += __shfl_xor(po, 1); po += __shfl_xor(po, 2);
            if (dq == 0) Os[t * 128 + j] = po;
        }
        __syncthreads();
        for (int r = 0; r < 8; ++r) { const int tok = F.wave * 8 + r; const size_t row = (size_t)b * SEQ + t0 + tok;
            const float a = Os[tok * 128 + F.lane], bb = Os[tok * 128 + F.lane + 64]; const float ss = wave_sum(a * a + bb * bb);
            const float rs = rsqrtf(ss * (1.f / 128.f) + EPS);
            const float z0 = bf2f(F.PROJ[row * NP + C_DZ + h * 128 + F.lane]), z1 = bf2f(F.PROJ[row * NP + C_DZ + h * 128 + F.lane + 64]);
            F.A2[row * KCAT + 2048 + h * 128 + F.lane] = (bf16)f2bf(a * rs * F.dn_norm_w[F.lane] * siluf_(z0));
            F.A2[row * KCAT + 2048 + h * 128 + F.lane + 64] = (bf16)f2bf(bb * rs * F.dn_norm_w[F.lane + 64] * siluf_(z1)); }
        __syncthreads();
    }
}

#ifndef MK_N_LAUNCHES
#define MK_N_LAUNCHES 1
#endif
constexpr int PER_PHASE = 7;
constexpr int N_LAUNCHES = MK_N_LAUNCHES;
struct Args { const void* in[17]; float* out; unsigned char* ws; int ph_lo, ph_hi, li, pad; };

__global__ void __launch_bounds__(NWAVES * 64, 2) skel_fwd(Args args) {
    extern __shared__ __attribute__((aligned(16))) unsigned char lds[];
    Frame F;
    F.lds = (LAS unsigned char*)lds;
    F.MISC = (volatile LAS unsigned*)(F.lds + MISC_OFF);
    F.tid = threadIdx.x; F.lane = F.tid & 63; F.wave = __builtin_amdgcn_readfirstlane(F.tid >> 6);
    F.G = gridDim.x; { const int bx = blockIdx.x; F.vcu = (F.G % 8 == 0) ? (bx % 8) * (F.G / 8) + bx / 8 : bx; }
    unsigned char* ws = args.ws;
    F.ctl = (gu32*)(ws + WS_CTL);
    F.x = (const float*)args.in[0]; F.c = (const float*)args.in[1]; F.positions = (const int*)args.in[2]; F.w_ada = (const float*)args.in[3]; F.b_ada = (const float*)args.in[4];
    F.norm_w = (const float*)args.in[5]; F.w_in = (const float*)args.in[6]; F.q_norm_w = (const float*)args.in[7]; F.k_norm_w = (const float*)args.in[8]; F.sinks = (const float*)args.in[9];
    F.conv_w = (const float*)args.in[10]; F.a_log = (const float*)args.in[11]; F.dt_bias = (const float*)args.in[12]; F.dn_norm_w = (const float*)args.in[13];
    F.w_o_swa = (const float*)args.in[14]; F.w_o_dn = (const float*)args.in[15]; F.w_out = (const float*)args.in[16]; F.out = args.out;
    F.modacc = (float*)(ws + WS_MODACC); F.WTIN = (bf16*)(ws + WS_WTIN); F.WOCAT = (bf16*)(ws + WS_WOCAT); F.WOUT = (bf16*)(ws + WS_WOUT); F.H = (bf16*)(ws + WS_H);
    F.PROJ = (bf16*)(ws + WS_PROJ); F.A2 = (bf16*)(ws + WS_A2); F.Y = (bf16*)(ws + WS_Y); F.ROPE = (float*)(ws + WS_ROPE); F.DBA = (float*)(ws + WS_DBA); F.YA = (float*)(ws + WS_YA);
    for (int u = F.tid; u < (LDS_BYTES - LDSCTL_OFF) / 4; u += NWAVES * 64) ((LAS unsigned*)(F.lds + LDSCTL_OFF))[u] = 0u;
    __syncthreads();
    XcdBarrier bar; bar.bar = (unsigned*)(F.ctl + CW_BAR) + args.li * XCD_BAR_WORDS; bar.x = 0; bar.st = nullptr;
    if (N_LAUNCHES != PER_PHASE) bar = xcd_barrier_post((unsigned*)(F.ctl + CW_BAR) + args.li * XCD_BAR_WORDS, F.MISC + 8);
#define GRID_BAR() do { if (N_LAUNCHES != PER_PHASE) xcd_barrier(bar); } while (0)
    const int lo = args.ph_lo, hi = args.ph_hi;
#define IN(k) (lo <= (k) && (k) < hi)
#define BOTH(k) (IN(k) && IN((k) + 1))

    if (IN(0)) { p0_prologue(F); if (BOTH(0)) GRID_BAR(); }
    if (IN(1)) { p1_hrows(F); if (BOTH(1)) GRID_BAR(); }
    if (IN(2)) {
        pg8::Gemm g{F.H, F.WTIN, MTOK, NP, DM, DM, DM}; pg8::StaticOrder S; S.init(MTOK, NP, F.G, (int)blockIdx.x);
        pg8::EpiProj E{F.PROJ, NP, F.DBA, PN_DBA};
        pg8::gemm_phase<pg8::EpiProj, pg8::StaticOrder, true, true>(F.lds, g, S, E);
        if (BOTH(2)) GRID_BAR();
    }
    if (IN(3)) {
        for (int it = blockIdx.x; it < 64 + 256; it += F.G) {
            if (it < 64) p3_scan_item_simple(F, it >> 5, it & 31);
            else { const int a = it - 64; p3_attn_item_simple(F, a >> 7, (a >> 2) & 31, a & 3); }
        }
        if (BOTH(3)) GRID_BAR();
    }
    if (IN(4)) {
        pg8::Gemm g{F.A2, F.WOCAT, MTOK, DM, DM, KCAT, KCAT}; pg8::StaticOrder S; S.init(MTOK, DM, F.G, (int)blockIdx.x);
        pg8::EpiGateF32 E{F.YA, DM, F.PROJ + C_MGA, NP};
        pg8::gemm_phase<pg8::EpiGateF32, pg8::StaticOrder, true, true>(F.lds, g, S, E);
        if (BOTH(4)) GRID_BAR();
    }
    if (IN(5)) {
        pg8::Gemm g{F.A2 + 2048, F.WOCAT + 2048, MTOK, DM, 4096, KCAT, KCAT}; pg8::StaticOrder S; S.init(MTOK, DM, F.G, (int)blockIdx.x);
        pg8::EpiGateAddBf16 E{F.Y, DM, F.YA, DM, F.PROJ + C_MGB, NP};
        pg8::gemm_phase<pg8::EpiGateAddBf16, pg8::StaticOrder, true, true>(F.lds, g, S, E);
        if (BOTH(5)) GRID_BAR();
    }
    if (IN(6)) {
        pg8::Gemm g{F.Y, F.WOUT, MTOK, DM, DM, DM, DM}; pg8::StaticOrder S; S.init(MTOK, DM, F.G, (int)blockIdx.x);
        pg8::EpiResid E{F.out, F.x, DM, F.modacc, F.b_ada, 2 * DM, 6144, SEQ};
        pg8::gemm_phase<pg8::EpiResid, pg8::StaticOrder, true, true>(F.lds, g, S, E);
    }
#undef IN
#undef BOTH
}

extern "C" void kernel_launch(void* const* d_in, const int* in_sizes, int n_in, void* d_out, int out_size, void* d_ws, size_t ws_size, hipStream_t stream) {
    static int grid = 0;
    if (grid == 0) {
        if (n_in != 17 || in_sizes[0] != MTOK * DM || out_size != MTOK * DM || ws_size < WS_END) { fprintf(stderr, "kernel_launch: unexpected shapes / workspace (n_in %d, in0 %d, out %d, ws %zu, need %zu); nothing launched\n", n_in, n_in > 0 ? in_sizes[0] : -1, out_size, ws_size, (size_t)WS_END); grid = -1; return; }
        int dev = 0, cus = 0, per_cu = 0;
        if (hipGetDevice(&dev) != hipSuccess || hipDeviceGetAttribute(&cus, hipDeviceAttributeMultiprocessorCount, dev) != hipSuccess) { grid = -1; return; }
        if (hipFuncSetAttribute((const void*)skel_fwd, hipFuncAttributeMaxDynamicSharedMemorySize, LDS_BYTES) != hipSuccess) { fprintf(stderr, "kernel_launch: hipFuncSetAttribute failed\n"); grid = -1; return; }
        if (hipOccupancyMaxActiveBlocksPerMultiprocessor(&per_cu, (const void*)skel_fwd, NWAVES * 64, LDS_BYTES) != hipSuccess || per_cu < 1) { fprintf(stderr, "kernel_launch: occupancy query says %d blocks per CU\n", per_cu); per_cu = 1; }
        (void)hipGetLastError();
        grid = cus;
    }
    if (grid < 0) return;
    (void)hipMemsetAsync((char*)d_ws + WS_CTL, 0, CTL_ZERO_BYTES, stream);
    Args a{};
    for (int i = 0; i < 17; ++i) a.in[i] = d_in[i];
    a.out = (float*)d_out; a.ws = (unsigned char*)d_ws;
    for (int li = 0; li < N_LAUNCHES; ++li) {
        a.ph_lo = (N_LAUNCHES == PER_PHASE) ? li : 0; a.ph_hi = (N_LAUNCHES == PER_PHASE) ? li + 1 : PER_PHASE; a.li = (N_LAUNCHES == PER_PHASE) ? 0 : li;
        hipLaunchKernelGGL(skel_fwd, dim3(grid), dim3(NWAVES * 64), LDS_BYTES, stream, a);
    }
}
```

```cpp
#include <hip/hip_runtime.h>
#include <cstdio>
#include <cstdint>

namespace pg8 {
#define PG8_LAS __attribute__((address_space(3)))
typedef unsigned short bf16_t;
typedef short bf16x8 __attribute__((ext_vector_type(8)));
typedef float f32x4 __attribute__((ext_vector_type(4)));
typedef unsigned u32x4 __attribute__((ext_vector_type(4)));
typedef unsigned u32x2 __attribute__((ext_vector_type(2)));
constexpr int BM = 256, BK = 64, HALF = 128, HTB = HALF * BK * 2  , STAGE_BYTES = 8 * HTB, NXCD = 8, WGM = 8;

__host__ __device__ __forceinline__ int lds_byte(int r, int c) { const int st = (r >> 4) * 2 + (c >> 5), rr = r & 15, cc = c & 31, ob = rr * 64 + cc * 2; return st * 1024 + (ob ^ (((ob >> 9) & 1) << 5)); }
__host__ __device__ __forceinline__ void stage_rc(int b, int& R, int& C) { const int st = b / 1024, sb = b % 1024, swz = sb ^ (((sb >> 9) & 1) << 5); R = (st >> 1) * 16 + swz / 64; C = (st & 1) * 32 + (swz % 64) / 2; }
__host__ __device__ __forceinline__ int perm32(int rho) { const int n = rho >> 4, i = rho & 15; return 8 * (i >> 2) + 4 * n + (i & 3); }

struct Unit { int pm, pn; };
struct Gemm { const bf16_t* A; const bf16_t* Bt; int M, N, K, lda, ldb; };

struct StaticOrder {
    int nM, nN, nwg, G, c;
    __host__ __device__ void init(int M, int N, int G_, int c_) { nM = M / BM; nN = N / BM; nwg = nM * nN; G = G_; c = c_; }
    __host__ __device__ bool next(int i, Unit& u) const {
        const long L = (long)i * G + c; if (L >= nwg) return false;
        int wgid = (int)L; { const int q = nwg / NXCD, r = nwg % NXCD, xcd = wgid % NXCD, off = wgid / NXCD; wgid = (xcd < r ? xcd * (q + 1) : r * (q + 1) + (xcd - r) * q) + off; }
        const int nig = WGM * nN, gid = wgid / nig, fm = gid * WGM, gsz = (nM - fm) < WGM ? (nM - fm) : WGM;
        u.pm = fm + ((wgid % nig) % gsz); u.pn = (wgid % nig) / gsz; return true;
    }
    __device__ __forceinline__ void a_ready(const Unit&) const {}
    __device__ __forceinline__ void done(const Unit&) const {}
};

__device__ __forceinline__ unsigned cvt_pk_bf16(float lo, float hi) { unsigned r; asm volatile("v_cvt_pk_bf16_f32 %0, %1, %2" : "=v"(r) : "v"(lo), "v"(hi)); return r; }
__device__ __forceinline__ float bf_lo(unsigned w) { return __uint_as_float(w << 16); }
__device__ __forceinline__ float bf_hi(unsigned w) { return __uint_as_float(w & 0xffff0000u); }
__device__ __forceinline__ float sigmoidf_(float x) { return 1.0f / (1.0f + __expf(-x)); }

struct EpiProj {
    static constexpr bool PERM = true, AFTER_DRAIN = false;
    bf16_t* O; int ldc; float* DBA; int pn_f32; const float* dnw;
    __device__ __forceinline__ void operator()(const f32x4 (&acc)[2][2][4][2], const Unit& u, int wr, int wc, int fr, int fq) const {
        const int row0 = u.pm * BM + wr * 64 + fr;
        if (u.pn == pn_f32) {
            if (wc < 2) {
#pragma unroll
                for (int ai = 0; ai < 2; ++ai)
#pragma unroll
                    for (int m = 0; m < 4; ++m) { float* p = DBA + (size_t)(row0 + ai * HALF + m * 16) * 64 + wc * 32 + 8 * fq;
                        *(f32x4*)p = acc[ai][0][m][0]; *(f32x4*)(p + 4) = acc[ai][0][m][1]; }
            }
            return;
        }
        const int mode = (u.pn >= 10 && u.pn < 18) ? 1 : ((u.pn >= 50 && u.pn < 66) ? 2 : ((u.pn >= 66 && u.pn < 82) ? 3 : 0));
        const int col0 = u.pn * BM + wc * 32 + 8 * fq;
        f32x4 w0 = {1.f, 1.f, 1.f, 1.f}, w1 = {1.f, 1.f, 1.f, 1.f};
        if (mode == 2) { w0 = *(const f32x4*)(dnw + wc * 32 + 8 * fq); w1 = *(const f32x4*)(dnw + wc * 32 + 8 * fq + 4); }
#pragma unroll
        for (int ai = 0; ai < 2; ++ai)
#pragma unroll
            for (int m = 0; m < 4; ++m) { bf16_t* rowp = O + (size_t)(row0 + ai * HALF + m * 16) * ldc + col0;
#pragma unroll
                for (int bj = 0; bj < 2; ++bj) { f32x4 v0 = acc[ai][bj][m][0], v1 = acc[ai][bj][m][1];
                    if (mode != 0) {
#pragma unroll
                        for (int e = 0; e < 4; ++e) { const float t0 = sigmoidf_(v0[e]), t1 = sigmoidf_(v1[e]);
                            v0[e] = mode == 3 ? t0 : v0[e] * t0 * w0[e]; v1[e] = mode == 3 ? t1 : v1[e] * t1 * w1[e]; }
                    }
                    u32x4 w; w.x = cvt_pk_bf16(v0[0], v0[1]); w.y = cvt_pk_bf16(v0[2], v0[3]); w.z = cvt_pk_bf16(v1[0], v1[1]); w.w = cvt_pk_bf16(v1[2], v1[3]);
                    *(u32x4*)(rowp + bj * HALF) = w; } }
    }
};
struct EpiGateF32 {
    static constexpr bool PERM = false, AFTER_DRAIN = false;
    float* C; int ldc; const bf16_t* G; int ldg;
    __device__ __forceinline__ void operator()(const f32x4 (&acc)[2][2][4][2], const Unit& u, int wr, int wc, int fr, int fq) const {
        const int row0 = u.pm * BM + wr * 64 + fr, col0 = u.pn * BM + wc * 32 + 4 * fq;
#pragma unroll
        for (int ai = 0; ai < 2; ++ai)
#pragma unroll
            for (int m = 0; m < 4; ++m) { const size_t r = (size_t)(row0 + ai * HALF + m * 16); float* rowp = C + r * ldc + col0; const bf16_t* gp = G + r * ldg + col0;
#pragma unroll
                for (int bj = 0; bj < 2; ++bj)
#pragma unroll
                    for (int n = 0; n < 2; ++n) { const u32x2 gw = *(const u32x2*)(gp + bj * HALF + n * 16); const f32x4 a = acc[ai][bj][m][n];
                        f32x4 o; o[0] = a[0] * bf_lo(gw.x); o[1] = a[1] * bf_hi(gw.x); o[2] = a[2] * bf_lo(gw.y); o[3] = a[3] * bf_hi(gw.y);
                        *(f32x4*)(rowp + bj * HALF + n * 16) = o; } }
    }
};
struct EpiGateAddBf16 {
    static constexpr bool PERM = true, AFTER_DRAIN = false;
    bf16_t* O; int ldc; const float* YA; int ldy; const bf16_t* G; int ldg;
    __device__ __forceinline__ void operator()(const f32x4 (&acc)[2][2][4][2], const Unit& u, int wr, int wc, int fr, int fq) const {
        const int row0 = u.pm * BM + wr * 64 + fr, col0 = u.pn * BM + wc * 32 + 8 * fq;
#pragma unroll
        for (int ai = 0; ai < 2; ++ai)
#pragma unroll
            for (int m = 0; m < 4; ++m) { const size_t r = (size_t)(row0 + ai * HALF + m * 16); bf16_t* rowp = O + r * ldc + col0; const float* yp = YA + r * ldy + col0; const bf16_t* gp = G + r * ldg + col0;
#pragma unroll
                for (int bj = 0; bj < 2; ++bj) { const f32x4 v0 = acc[ai][bj][m][0], v1 = acc[ai][bj][m][1];
                    const u32x4 gw = *(const u32x4*)(gp + bj * HALF); const f32x4 y0 = *(const f32x4*)(yp + bj * HALF), y1 = *(const f32x4*)(yp + bj * HALF + 4);
                    const float o0 = y0[0] + v0[0] * bf_lo(gw.x), o1 = y0[1] + v0[1] * bf_hi(gw.x), o2 = y0[2] + v0[2] * bf_lo(gw.y), o3 = y0[3] + v0[3] * bf_hi(gw.y);
                    const float o4 = y1[0] + v1[0] * bf_lo(gw.z), o5 = y1[1] + v1[1] * bf_hi(gw.z), o6 = y1[2] + v1[2] * bf_lo(gw.w), o7 = y1[3] + v1[3] * bf_hi(gw.w);
                    u32x4 w; w.x = cvt_pk_bf16(o0, o1); w.y = cvt_pk_bf16(o2, o3); w.z = cvt_pk_bf16(o4, o5); w.w = cvt_pk_bf16(o6, o7);
                    *(u32x4*)(rowp + bj * HALF) = w; } }
    }
};
struct EpiResid {
    static constexpr bool PERM = false, AFTER_DRAIN = false;
    float* C; const float* X; int ldc; const float* modacc; const float* bias; int goff, modld, rows_per_batch;
    __device__ __forceinline__ void operator()(const f32x4 (&acc)[2][2][4][2], const Unit& u, int wr, int wc, int fr, int fq) const {
        const int row0 = u.pm * BM + wr * 64 + fr, col0 = u.pn * BM + wc * 32 + 4 * fq;
        const int b = (u.pm * BM) / rows_per_batch;
        f32x4 gv[2][2];
#pragma unroll
        for (int bj = 0; bj < 2; ++bj)
#pragma unroll
            for (int n = 0; n < 2; ++n) gv[bj][n] = *(const f32x4*)(modacc + (size_t)b * modld + goff + col0 + bj * HALF + n * 16) + *(const f32x4*)(bias + goff + col0 + bj * HALF + n * 16);
#pragma unroll
        for (int ai = 0; ai < 2; ++ai)
#pragma unroll
            for (int m = 0; m < 4; ++m) { const size_t off = (size_t)(row0 + ai * HALF + m * 16) * ldc + col0;
#pragma unroll
                for (int bj = 0; bj < 2; ++bj)
#pragma unroll
                    for (int n = 0; n < 2; ++n) { const f32x4 xv = *(const f32x4*)(X + off + bj * HALF + n * 16); *(f32x4*)(C + off + bj * HALF + n * 16) = xv + gv[bj][n] * acc[ai][bj][m][n]; } }
    }
};

template <class Epi, class Sched, bool ALIGN_EPI = false, bool SP2 = false>
__device__ __forceinline__ void gemm_phase(PG8_LAS unsigned char* lds, const Gemm g, const Sched& S, const Epi& E) {
    const int tid = threadIdx.x, wid = __builtin_amdgcn_readfirstlane(tid >> 6), lane = tid & 63, wr = wid >> 2, wc = wid & 3, fr = lane & 15, fq = lane >> 4;
    const int K = g.K, nt = K / BK;
    unsigned voffA[2], voffB[2];
#pragma unroll
    for (int i = 0; i < 2; ++i) { int R, C; stage_rc(tid * 16 + i * 8192, R, C); const int Rb = Epi::PERM ? ((R & ~31) + perm32(R & 31)) : R;
        voffA[i] = (unsigned)(R * g.lda + C) * 2u; voffB[i] = (unsigned)(Rb * g.ldb + C) * 2u; }
    const size_t kstep = (size_t)(BK * 2);
    const size_t hstepA = (size_t)HALF * g.lda * 2, hstepB = (size_t)HALF * g.ldb * 2;
    const size_t tstepA = 2 * hstepA, tstepB = 2 * hstepB;
    const unsigned ldsw = (unsigned)wid * 1024u;
    const int aoff = lds_byte(wr * 64 + fr, fq * 8), boff = lds_byte(wc * 32 + fr, fq * 8);
#define PG8_SA(b, h) (((b) * 2 + (h)) * HTB)
#define PG8_SB(b, h) ((4 + (b) * 2 + (h)) * HTB)
#define PG8_STAGE(bufoff, gbase, voff) do { _Pragma("unroll") for (int _i = 0; _i < 2; ++_i) \
        __builtin_amdgcn_global_load_lds((const unsigned*)((const char*)(gbase) + (voff)[_i]), (PG8_LAS unsigned*)(lds + (bufoff) + ldsw + _i * 8192), 16, 0, 0); } while (0)
#define PG8_LDA(dst, b, h) do { _Pragma("unroll") for (int m = 0; m < 4; ++m) _Pragma("unroll") for (int k = 0; k < 2; ++k) dst[m][k] = *(const PG8_LAS bf16x8*)(lds + PG8_SA(b, h) + aoff + m * 2048 + k * 1024); } while (0)
#define PG8_LDB(dst, b, h) do { _Pragma("unroll") for (int n = 0; n < 2; ++n) _Pragma("unroll") for (int k = 0; k < 2; ++k) dst[n][k] = *(const PG8_LAS bf16x8*)(lds + PG8_SB(b, h) + boff + n * 2048 + k * 1024); } while (0)
#define PG8_MMA(ai, bj, At, Bt) do { __builtin_amdgcn_s_setprio(1); _Pragma("unroll") for (int m = 0; m < 4; ++m) _Pragma("unroll") for (int n = 0; n < 2; ++n) _Pragma("unroll") for (int k = 0; k < 2; ++k) \
        acc[ai][bj][m][n] = __builtin_amdgcn_mfma_f32_16x16x32_bf16(Bt[n][k], At[m][k], acc[ai][bj][m][n], 0, 0, 0); __builtin_amdgcn_s_setprio(0); } while (0)
#define PG8_WAIT_V(n) asm volatile("s_waitcnt vmcnt(" #n ")" ::: "memory")
#define PG8_WAIT_L(n) asm volatile("s_waitcnt lgkmcnt(" #n ")" ::: "memory")
#define PG8_BAR __builtin_amdgcn_s_barrier()
#define PG8_SCHED __builtin_amdgcn_sched_barrier(0)
    Unit cur, nxt; int ui = 0;
    if (!S.next(0, cur)) return;
    f32x4 acc[2][2][4][2];
#pragma unroll
    for (int a = 0; a < 2; ++a)
#pragma unroll
        for (int b = 0; b < 2; ++b)
#pragma unroll
            for (int m = 0; m < 4; ++m)
#pragma unroll
                for (int n = 0; n < 2; ++n) acc[a][b][m][n] = (f32x4){0.f, 0.f, 0.f, 0.f};
    bf16x8 At[4][2], B0[2][2], B1[2][2];
    const char* cA = (const char*)g.A + (size_t)cur.pm * tstepA; const char* cB = (const char*)g.Bt + (size_t)cur.pn * tstepB;
    S.a_ready(cur);
    if constexpr (SP2) {
        PG8_STAGE(PG8_SB(0, 0), cB, voffB); PG8_STAGE(PG8_SB(0, 1), cB + hstepB, voffB); PG8_STAGE(PG8_SA(0, 0), cA, voffA); PG8_STAGE(PG8_SA(0, 1), cA + hstepA, voffA);
        if (wr == 1) PG8_BAR;
        PG8_WAIT_V(2); PG8_BAR;
        PG8_STAGE(PG8_SB(1, 0), cB + kstep, voffB); PG8_STAGE(PG8_SA(1, 0), cA + kstep, voffA); PG8_STAGE(PG8_SB(1, 1), cB + hstepB + kstep, voffB);
        PG8_WAIT_V(6); PG8_BAR;
    } else {
        PG8_STAGE(PG8_SB(0, 0), cB, voffB); PG8_STAGE(PG8_SA(0, 0), cA, voffA); PG8_STAGE(PG8_SB(0, 1), cB + hstepB, voffB); PG8_STAGE(PG8_SA(0, 1), cA + hstepA, voffA);
        if (wr == 1) PG8_BAR;
        PG8_WAIT_V(4); PG8_BAR;
        PG8_STAGE(PG8_SB(1, 0), cB + kstep, voffB); PG8_STAGE(PG8_SA(1, 0), cA + kstep, voffA); PG8_STAGE(PG8_SB(1, 1), cB + hstepB + kstep, voffB);
        PG8_WAIT_V(6); PG8_BAR;
    }
    for (;;) {
        const bool has_next = S.next(ui + 1, nxt);
        const char* nA = has_next ? (const char*)g.A + (size_t)nxt.pm * tstepA : cA; const char* nB = has_next ? (const char*)g.Bt + (size_t)nxt.pn * tstepB : cB;
        for (int t = 0; t < nt; t += 2) {
            const bool last = (t == nt - 2);
            const char* a1 = cA + (size_t)(t + 1) * kstep;
            const char* a2 = last ? nA : cA + (size_t)(t + 2) * kstep; const char* b2 = last ? nB : cB + (size_t)(t + 2) * kstep;
            const char* a3 = a2 + kstep; const char* b3 = b2 + kstep;
            if (last && has_next) S.a_ready(nxt);
            if constexpr (SP2) {
            PG8_LDB(B0, 0, 0); PG8_LDB(B1, 0, 1); PG8_SCHED; PG8_LDA(At, 0, 0); PG8_STAGE(PG8_SA(1, 1), a1 + hstepA, voffA);
            PG8_WAIT_V(8); PG8_WAIT_L(0); PG8_BAR; PG8_MMA(0, 0, At, B0); PG8_MMA(0, 1, At, B1); PG8_BAR; PG8_SCHED;
            PG8_LDA(At, 0, 1); PG8_STAGE(PG8_SB(0, 0), b2, voffB); PG8_STAGE(PG8_SB(0, 1), b2 + hstepB, voffB); PG8_STAGE(PG8_SA(0, 0), a2, voffA);
            PG8_WAIT_V(8); PG8_WAIT_L(0); PG8_BAR; PG8_MMA(1, 0, At, B0); PG8_MMA(1, 1, At, B1); PG8_BAR; PG8_SCHED;
            PG8_LDB(B0, 1, 0); PG8_LDB(B1, 1, 1); PG8_SCHED; PG8_LDA(At, 1, 0); PG8_STAGE(PG8_SA(0, 1), a2 + hstepA, voffA);
            PG8_WAIT_V(8); PG8_WAIT_L(0); PG8_BAR; PG8_MMA(0, 0, At, B0); PG8_MMA(0, 1, At, B1); PG8_BAR; PG8_SCHED;
            PG8_LDA(At, 1, 1); PG8_STAGE(PG8_SB(1, 0), b3, voffB); PG8_STAGE(PG8_SB(1, 1), b3 + hstepB, voffB); PG8_STAGE(PG8_SA(1, 0), a3, voffA);
            PG8_WAIT_V(8); PG8_WAIT_L(0); PG8_BAR; PG8_MMA(1, 0, At, B0); PG8_MMA(1, 1, At, B1); PG8_BAR; PG8_SCHED;
            } else {
            PG8_LDB(B0, 0, 0); PG8_SCHED; PG8_LDA(At, 0, 0); PG8_STAGE(PG8_SA(1, 1), a1 + hstepA, voffA);
            PG8_WAIT_L(8); PG8_BAR; PG8_WAIT_L(0); PG8_MMA(0, 0, At, B0); PG8_BAR; PG8_SCHED;
            PG8_LDB(B1, 0, 1); PG8_STAGE(PG8_SB(0, 0), b2, voffB);
            PG8_BAR; PG8_WAIT_L(0); PG8_MMA(0, 1, At, B1); PG8_BAR;
            PG8_LDA(At, 0, 1); PG8_STAGE(PG8_SA(0, 0), a2, voffA);
            PG8_BAR; PG8_WAIT_L(0); PG8_MMA(1, 0, At, B0); PG8_BAR; PG8_SCHED;
            PG8_STAGE(PG8_SB(0, 1), b2 + hstepB, voffB);
            PG8_WAIT_V(6); PG8_BAR; PG8_MMA(1, 1, At, B1); PG8_BAR;
            PG8_LDB(B0, 1, 0); PG8_SCHED; PG8_LDA(At, 1, 0); PG8_STAGE(PG8_SA(0, 1), a2 + hstepA, voffA);
            PG8_WAIT_L(8); PG8_BAR; PG8_WAIT_L(0); PG8_MMA(0, 0, At, B0); PG8_BAR; PG8_SCHED;
            PG8_LDB(B1, 1, 1); PG8_STAGE(PG8_SB(1, 0), b3, voffB);
            PG8_BAR; PG8_WAIT_L(0); PG8_MMA(0, 1, At, B1); PG8_BAR;
            PG8_LDA(At, 1, 1); PG8_STAGE(PG8_SA(1, 0), a3, voffA);
            PG8_BAR; PG8_WAIT_L(0); PG8_MMA(1, 0, At, B0); PG8_BAR; PG8_SCHED;
            PG8_STAGE(PG8_SB(1, 1), b3 + hstepB, voffB);
            PG8_WAIT_V(6); PG8_BAR; PG8_MMA(1, 1, At, B1); PG8_BAR;
            }
        }
        if constexpr (ALIGN_EPI) { if (wr == 0) PG8_BAR; }
        if constexpr (!Epi::AFTER_DRAIN) { E(acc, cur, wr, wc, fr, fq); S.done(cur); }
        if (!has_next) break;
#pragma unroll
        for (int a = 0; a < 2; ++a)
#pragma unroll
            for (int b = 0; b < 2; ++b)
#pragma unroll
                for (int m = 0; m < 4; ++m)
#pragma unroll
                    for (int n = 0; n < 2; ++n) acc[a][b][m][n] = (f32x4){0.f, 0.f, 0.f, 0.f};
        cur = nxt; cA = nA; cB = nB; ++ui;
        if constexpr (ALIGN_EPI) { if (wr == 1) PG8_BAR; }
    }
    PG8_WAIT_V(0);
    if constexpr (!ALIGN_EPI) { if (wr == 0) PG8_BAR; }
    PG8_BAR;
    if constexpr (Epi::AFTER_DRAIN) { E.fused(acc, cur, wr, wc, fr, fq, lds, wid, lane); S.done(cur); }
#undef PG8_SA
#undef PG8_SB
#undef PG8_STAGE
#undef PG8_LDA
#undef PG8_LDB
#undef PG8_MMA
#undef PG8_WAIT_V
#undef PG8_WAIT_L
#undef PG8_BAR
#undef PG8_SCHED
}
}

constexpr int NWAVES = 8;
constexpr int DM = 2048, NBATCH = 2, SEQ = 4096, MTOK = NBATCH * SEQ;
constexpr int IN_WIDTH = 21056, NP = 21248;
constexpr int C_AQ = 0, C_AK = 2048, C_AV = 2304, C_AG = 2560, C_DQKV = 4608, C_DZ = 12800, C_MGA = 16896, C_MGB = 18944, C_DBA = 20992;
constexpr int PN_DBA = C_DBA / 256;
constexpr int KCAT = 6144;
constexpr float EPS = 1e-6f;

constexpr size_t MiB = 1u << 20;
constexpr size_t WS_CTL = 0, CTL_ZERO_BYTES = 128 * 1024;
constexpr size_t WS_MODACC = 64 * 1024;
constexpr size_t WS_WOCAT = 1 * MiB;
constexpr size_t WS_WOUT = 25 * MiB;
constexpr size_t WS_ROPE = 33 * MiB;
constexpr size_t WS_DBA = 34 * MiB;
constexpr size_t WS_PROJ = 36 * MiB;
constexpr size_t WS_A2 = 368 * MiB;
constexpr size_t WS_WTIN = 464 * MiB;
constexpr size_t WS_H = 547 * MiB;
constexpr size_t WS_Y = 579 * MiB;
constexpr size_t WS_KQ = 464 * MiB;
constexpr size_t WS_TQV = 528 * MiB;
constexpr size_t WS_YA = 464 * MiB;
constexpr size_t WS_END = 644 * MiB;
static_assert(WS_PROJ + (size_t)MTOK * NP * 2 <= WS_A2 && WS_WTIN + (size_t)NP * DM * 2 <= WS_H && WS_TQV + (size_t)4096 * 29696 <= WS_END && WS_KQ + (size_t)2048 * 32768 <= WS_TQV, "d_ws map");
constexpr int CW_BAR = 1024;

constexpr int RING_BYTES = 131072;
constexpr int LDS_BYTES = 163840;
constexpr int SMALL_OFF = 159744;
constexpr int LDSCTL_OFF = 162816, MISC_OFF = LDSCTL_OFF + 320;

#define GAS __attribute__((address_space(1)))
#define LAS __attribute__((address_space(3)))
typedef unsigned short bf16;
typedef unsigned v4u __attribute__((ext_vector_type(4)));
typedef float f32x4 __attribute__((ext_vector_type(4)));
typedef GAS unsigned gu32;
#define RLX_AGENT __ATOMIC_RELAXED, __HIP_MEMORY_SCOPE_AGENT
#define LDS_WAIT() asm volatile("s_waitcnt lgkmcnt(0)" ::: "memory")
#define VM_WAIT() asm volatile("s_waitcnt vmcnt(0)" ::: "memory")
__device__ __forceinline__ unsigned f2bf(float f) { unsigned u = __builtin_bit_cast(unsigned, f); return (u + 0x7fffu + ((u >> 16) & 1u)) >> 16; }
__device__ __forceinline__ unsigned pk2(float lo, float hi) { return f2bf(lo) | (f2bf(hi) << 16); }
__device__ __forceinline__ float bf2f(bf16 v) { return __uint_as_float((unsigned)v << 16); }
__device__ __forceinline__ float blo(unsigned w) { return __uint_as_float(w << 16); }
__device__ __forceinline__ float bhi(unsigned w) { return __uint_as_float(w & 0xffff0000u); }
__device__ __forceinline__ float siluf_(float x) { return x / (1.0f + __expf(-x)); }
__device__ __forceinline__ float sigm_(float x) { return 1.0f / (1.0f + __expf(-x)); }

#define XB_TMO      128
#define XB_XCNT(j)  (256  + 64 * (j))
#define XB_XSUB(j)  (1280 + 64 * (j))
#define XB_XGEN(j)  (2304 + 64 * (j))
#define XB_TOP      3328
#define XB_TOPGEN   3392
#define XCD_BAR_WORDS 3456
#define XB_SPIN_CAP (1u << 18)

__device__ __forceinline__ unsigned xb_ld(unsigned* p)              { return __hip_atomic_load(p, __ATOMIC_RELAXED, __HIP_MEMORY_SCOPE_AGENT); }
__device__ __forceinline__ unsigned xb_add(unsigned* p, unsigned v) { return __hip_atomic_fetch_add(p, v, __ATOMIC_RELAXED, __HIP_MEMORY_SCOPE_AGENT); }
__device__ __forceinline__ unsigned xb_xcc_id() { return (unsigned)__builtin_amdgcn_s_getreg((3 << 11) | 20) & 0xFu; }
#define XB_SPIN(cond, bar) do { unsigned _sp = 0; while (cond) { __builtin_amdgcn_s_sleep(1); \
    if ((++_sp & 255u) == 0u) { if (xb_ld(&(bar)[XB_TMO])) break; if (_sp > XB_SPIN_CAP) { atomicAdd(&(bar)[XB_TMO], 1u); break; } } } } while (0)

struct XcdBarrier {
    unsigned* bar; unsigned x;
    volatile LAS unsigned* st;
};

__device__ __forceinline__ XcdBarrier xcd_barrier_post(unsigned* bar, volatile LAS unsigned* st) {
    XcdBarrier b; b.bar = bar; b.x = xb_xcc_id(); b.st = st;
    if (threadIdx.x == 0) (void)xb_add(&bar[XB_XCNT(b.x)], 1u);
    return b;
}
__device__ __forceinline__ void xcd_barrier_complete(unsigned* bar, unsigned x, unsigned& nloc, unsigned& nx) {
    const unsigned G = gridDim.x * gridDim.y * gridDim.z;
    unsigned sum, cnt, mine, sp = 0u;
    for (;;) {
        sum = 0u; cnt = 0u; mine = 0u;
#pragma unroll
        for (unsigned j = 0; j < 16; ++j) { const unsigned c = xb_ld(&bar[XB_XCNT(j)]); sum += c; cnt += (c > 0u) ? 1u : 0u; mine = (j == x) ? c : mine; }
        if (sum == G) break;
        __builtin_amdgcn_s_sleep(1);
        if ((++sp & 255u) == 0u) { if (xb_ld(&bar[XB_TMO])) break; if (sp > XB_SPIN_CAP) { atomicAdd(&bar[XB_TMO], 1u); break; } }
    }
    nloc = mine > 0u ? mine : 1u; nx = cnt > 0u ? cnt : 1u;
}

__device__ __forceinline__ void xcd_barrier(const XcdBarrier& b) {
    asm volatile("s_waitcnt vmcnt(0)" ::: "memory");
    __syncthreads();
    if (threadIdx.x == 0) {
        unsigned* bar = b.bar;
        __builtin_amdgcn_s_waitcnt(0);
        unsigned nloc = b.st[0], nx = b.st[1];
        if (nloc == 0u) { xcd_barrier_complete(bar, b.x, nloc, nx); b.st[0] = nloc; b.st[1] = nx; }
        const unsigned old = xb_add(&bar[XB_XSUB(b.x)], 1u);
        const unsigned gen = old / nloc;
        if (old + 1u == (gen + 1u) * nloc) {
            __builtin_amdgcn_fence(__ATOMIC_RELEASE, "agent");
            asm volatile("s_waitcnt vmcnt(0)" ::: "memory");
            const unsigned og = xb_add(&bar[XB_TOP], 1u);
            const unsigned tg = og / nx;
            if (og + 1u == (tg + 1u) * nx) xb_add(&bar[XB_TOPGEN], 1u);
            else XB_SPIN(xb_ld(&bar[XB_TOPGEN]) == tg, bar);
            __builtin_amdgcn_fence(__ATOMIC_ACQUIRE, "agent");
            xb_add(&bar[XB_XGEN(b.x)], 1u);
            asm volatile("s_waitcnt vmcnt(0)" ::: "memory");
        } else {
            XB_SPIN(xb_ld(&bar[XB_XGEN(b.x)]) == gen, bar);
            __builtin_amdgcn_fence(__ATOMIC_ACQUIRE, "agent");
            asm volatile("s_waitcnt vmcnt(0)" ::: "memory");
        }
    }
    __syncthreads();
}

struct Frame {
    LAS unsigned char* lds;
    volatile LAS unsigned* MISC;
    gu32* ctl;
    int tid, lane, wave;
    int vcu, G;
    const float *x, *c; const int* positions; const float *w_ada, *b_ada, *norm_w, *w_in, *q_norm_w, *k_norm_w, *sinks, *conv_w, *a_log, *dt_bias, *dn_norm_w, *w_o_swa, *w_o_dn, *w_out;
    float* out;
    float* modacc; bf16 *WTIN, *WOCAT, *WOUT, *H, *PROJ, *A2, *Y; float *ROPE, *DBA, *YA; unsigned char *KQ, *TQV;
};

__device__ __forceinline__ float wave_sum(float v) {
#pragma unroll
    for (int o = 1; o < 64; o <<= 1) v += __shfl_xor(v, o);
    return v;
}

__device__ __forceinline__ void p0_transpose_item(const float* W, int ldw, bf16* WT, int ldo, int k_off, int k0, int n_src0, int n_dst0, LAS float* scr, int lane) {
    const int c = lane & 7;
    if (n_src0 < 0) {
#pragma unroll
        for (int j = 0; j < 4; ++j) { const int n = (lane >> 3) + 8 * j; *(GAS v4u*)(WT + (size_t)(n_dst0 + n) * ldo + k_off + k0 + 8 * c) = (v4u){0u, 0u, 0u, 0u}; }
        return;
    }
#pragma unroll 8
    for (int i = 0; i < 32; ++i) { const int kk = 2 * i + (lane >> 5); scr[kk * 33 + (lane & 31)] = W[(size_t)(k0 + kk) * ldw + n_src0 + (lane & 31)]; }
    LDS_WAIT(); asm volatile("" ::: "memory");
#pragma unroll
    for (int j = 0; j < 4; ++j) { const int n = (lane >> 3) + 8 * j; const LAS float* s = scr + (8 * c) * 33 + n;
        v4u o; o.x = pk2(s[0 * 33], s[1 * 33]); o.y = pk2(s[2 * 33], s[3 * 33]); o.z = pk2(s[4 * 33], s[5 * 33]); o.w = pk2(s[6 * 33], s[7 * 33]);
        *(GAS v4u*)(WT + (size_t)(n_dst0 + n) * ldo + k_off + k0 + 8 * c) = o; }
    LDS_WAIT(); asm volatile("" ::: "memory");
}
__device__ __forceinline__ int proj_src_col(int n) { return n < C_MGA ? n : (n < C_DBA ? n + 64 : (n < IN_WIDTH ? n - C_DBA + 16896 : -1)); }

__device__ __forceinline__ void p0_prologue(Frame& F) {
    LAS float* scr = (LAS float*)(F.lds + F.wave * 16384);
    const int gw = F.vcu * NWAVES + F.wave, NGW = F.G * NWAVES;
    for (int it = gw; it < 64 * 24; it += NGW) {
        const int kc = it / 24, cg = it % 24;
        f32x4 a0 = {0.f, 0.f, 0.f, 0.f}, a1 = {0.f, 0.f, 0.f, 0.f};
        const float* wp = F.w_ada + (size_t)(kc * 32) * 6144 + cg * 256 + F.lane * 4;
#pragma unroll 8
        for (int r = 0; r < 32; ++r) { const int k = kc * 32 + r; const float s0 = siluf_(F.c[k]), s1 = siluf_(F.c[DM + k]); const f32x4 w = *(const f32x4*)(wp + (size_t)r * 6144); a0 += s0 * w; a1 += s1 * w; }
        float* m0 = F.modacc + cg * 256 + F.lane * 4; float* m1 = m0 + 6144;
#pragma unroll
        for (int e = 0; e < 4; ++e) { atomicAdd(m0 + e, a0[e]); atomicAdd(m1 + e, a1[e]); }
    }
    {
        const int gt = (F.vcu * NWAVES + F.wave) * 64 + F.lane, NGT = NGW * 64;
        for (int idx = gt; idx < MTOK * 8; idx += NGT) {
            const int m = idx >> 3, j = idx & 7;
            const unsigned fb = j == 0 ? 0x3f800000u : j == 1 ? 0x3e4693afu : j == 2 ? 0x3d1a08c8u : j == 3 ? 0x3beef74eu : j == 4 ? 0x3ab95d22u : j == 5 ? 0x398fc8f8u : j == 6 ? 0x385f10c5u : 0x372d07a8u;
            const float ang = (float)F.positions[m] * __uint_as_float(fb);
            const double a = (double)ang;
            const double kq = __builtin_rint(a * 0.63661977236758134308);
            const double s = (a - kq * 1.57079632679489655800) - kq * 6.12323399573676603587e-17;
            const double s2 = s * s;
            const double sn = s * (1.0 + s2 * (-1.0 / 6 + s2 * (1.0 / 120 + s2 * (-1.0 / 5040 + s2 * (1.0 / 362880 + s2 * (-1.0 / 39916800 + s2 * (1.0 / 6227020800.0)))))));
            const double cs = 1.0 + s2 * (-0.5 + s2 * (1.0 / 24 + s2 * (-1.0 / 720 + s2 * (1.0 / 40320 + s2 * (-1.0 / 3628800 + s2 * (1.0 / 479001600 + s2 * (-1.0 / 87178291200.0)))))));
            const int q = ((int)kq) & 3;
            const double cv = q == 0 ? cs : q == 1 ? -sn : q == 2 ? -cs : sn;
            const double sv = q == 0 ? sn : q == 1 ? cs : q == 2 ? -sn : -cs;
            F.ROPE[(size_t)m * 16 + j] = (float)cv; F.ROPE[(size_t)m * 16 + 8 + j] = (float)sv;
        }
    }
    constexpr int I_IN = (DM / 64) * (NP / 32), I_OS = (DM / 64) * (DM / 32), I_OD = (4096 / 64) * (DM / 32), I_OUT = (DM / 64) * (DM / 32);
    constexpr int NITEMS = I_IN + I_OS + I_OD + I_OUT;
    for (int it = gw; it < NITEMS; it += NGW) {
        int r = it;
        if (r < I_IN) { const int kb = r / (NP / 32), nb = r % (NP / 32); p0_transpose_item(F.w_in, IN_WIDTH, F.WTIN, DM, 0, 64 * kb, proj_src_col(32 * nb), 32 * nb, scr, F.lane); continue; } r -= I_IN;
        if (r < I_OS) { const int kb = r / (DM / 32), nb = r % (DM / 32); p0_transpose_item(F.w_o_swa, DM, F.WOCAT, KCAT, 0, 64 * kb, 32 * nb, 32 * nb, scr, F.lane); continue; } r -= I_OS;
        if (r < I_OD) { const int kb = r / (DM / 32), nb = r % (DM / 32); p0_transpose_item(F.w_o_dn, DM, F.WOCAT, KCAT, 2048, 64 * kb, 32 * nb, 32 * nb, scr, F.lane); continue; } r -= I_OD;
        { const int kb = r / (DM / 32), nb = r % (DM / 32); p0_transpose_item(F.w_out, DM, F.WOUT, DM, 0, 64 * kb, 32 * nb, 32 * nb, scr, F.lane); }
    }
}

__device__ __forceinline__ void p1_hrows(Frame& F) {
    const int gw = F.vcu * NWAVES + F.wave, NGW = F.G * NWAVES;
    for (int m = gw; m < MTOK; m += NGW) {
        const int b = m / SEQ;
        const GAS f32x4* xr = (const GAS f32x4*)(F.x + (size_t)m * DM) + F.lane;
        f32x4 v[8]; float s = 0.f;
#pragma unroll
        for (int j = 0; j < 8; ++j) { v[j] = xr[64 * j]; s += (v[j].x * v[j].x + v[j].y * v[j].y) + (v[j].z * v[j].z + v[j].w * v[j].w); }
        const float rstd = rsqrtf(wave_sum(s) * (1.f / DM) + EPS);
        GAS unsigned long long* o8 = (GAS unsigned long long*)(F.H + (size_t)m * DM) + F.lane;
#pragma unroll
        for (int j = 0; j < 8; ++j) {
            const int col = 4 * F.lane + 256 * j;
            const f32x4 nw = *(const f32x4*)(F.norm_w + col);
            const f32x4 sh = *(const f32x4*)(F.modacc + (size_t)b * 6144 + col) + *(const f32x4*)(F.b_ada + col);
            const f32x4 sc = *(const f32x4*)(F.modacc + (size_t)b * 6144 + DM + col) + *(const f32x4*)(F.b_ada + DM + col);
            const f32x4 hv = (v[j] * rstd * nw) * (1.0f + sc) + sh;
            o8[64 * j] = (unsigned long long)pk2(hv.x, hv.y) | ((unsigned long long)pk2(hv.z, hv.w) << 32);
        }
    }
}

__device__ __forceinline__ void p3_attn_item_simple(Frame& F, int b, int n, int hk) {
    LAS float* Kl = (LAS float*)F.lds; LAS float* Vl = Kl + 256 * 64;
    const int tid = F.tid;
    {
        const int key = tid >> 1, half = tid & 1; const int tok = n * 128 - 128 + key;
        float kv[32], vv[32];
        if (tok >= 0) {
            const size_t row = (size_t)b * SEQ + tok;
            const v4u* kp = (const v4u*)(F.PROJ + row * NP + C_AK + hk * 64 + half * 32);
            const v4u* vp = (const v4u*)(F.PROJ + row * NP + C_AV + hk * 64 + half * 32);
#pragma unroll
            for (int i = 0; i < 4; ++i) { const v4u a = kp[i], c = vp[i];
                kv[8 * i + 0] = blo(a.x); kv[8 * i + 1] = bhi(a.x); kv[8 * i + 2] = blo(a.y); kv[8 * i + 3] = bhi(a.y); kv[8 * i + 4] = blo(a.z); kv[8 * i + 5] = bhi(a.z); kv[8 * i + 6] = blo(a.w); kv[8 * i + 7] = bhi(a.w);
                vv[8 * i + 0] = blo(c.x); vv[8 * i + 1] = bhi(c.x); vv[8 * i + 2] = blo(c.y); vv[8 * i + 3] = bhi(c.y); vv[8 * i + 4] = blo(c.z); vv[8 * i + 5] = bhi(c.z); vv[8 * i + 6] = blo(c.w); vv[8 * i + 7] = bhi(c.w); }
            float ss = 0.f;
#pragma unroll
            for (int d = 0; d < 32; ++d) ss += kv[d] * kv[d];
            ss += __shfl_xor(ss, 1);
            const float rs = rsqrtf(ss * (1.f / 64.f) + EPS);
#pragma unroll
            for (int d = 0; d < 32; ++d) kv[d] = kv[d] * rs * F.k_norm_w[half * 32 + d];
            if (half == 0) {
                const float* cs = F.ROPE + row * 16;
#pragma unroll
                for (int d = 0; d < 8; ++d) { const float x1 = kv[d], x2 = kv[8 + d], c = cs[d], s = cs[8 + d]; kv[d] = x1 * c - x2 * s; kv[8 + d] = x2 * c + x1 * s; }
            }
        } else {
#pragma unroll
            for (int d = 0; d < 32; ++d) { kv[d] = 0.f; vv[d] = 0.f; }
        }
#pragma unroll
        for (int d = 0; d < 32; d += 4) { *(LAS f32x4*)(Kl + key * 64 + half * 32 + d) = (f32x4){kv[d], kv[d + 1], kv[d + 2], kv[d + 3]}; *(LAS f32x4*)(Vl + key * 64 + half * 32 + d) = (f32x4){vv[d], vv[d + 1], vv[d + 2], vv[d + 3]}; }
    }
    __syncthreads();
    for (int pass = 0; pass < 2; ++pass) {
        const int g = (tid >> 7) + 4 * pass, i = tid & 127, h = hk * 8 + g;
        const size_t row = (size_t)b * SEQ + n * 128 + i;
        float q[64], o[64];
        {
            const v4u* qp = (const v4u*)(F.PROJ + row * NP + C_AQ + h * 64);
#pragma unroll
            for (int k = 0; k < 8; ++k) { const v4u a = qp[k];
                q[8 * k + 0] = blo(a.x); q[8 * k + 1] = bhi(a.x); q[8 * k + 2] = blo(a.y); q[8 * k + 3] = bhi(a.y); q[8 * k + 4] = blo(a.z); q[8 * k + 5] = bhi(a.z); q[8 * k + 6] = blo(a.w); q[8 * k + 7] = bhi(a.w); }
            float ss = 0.f;
#pragma unroll
            for (int d = 0; d < 64; ++d) ss += q[d] * q[d];
            const float rs = rsqrtf(ss * (1.f / 64.f) + EPS);
#pragma unroll
            for (int d = 0; d < 64; ++d) q[d] = q[d] * rs * F.q_norm_w[d];
            const float* cs = F.ROPE + row * 16;
#pragma unroll
            for (int d = 0; d < 8; ++d) { const float x1 = q[d], x2 = q[8 + d], c = cs[d], s = cs[8 + d]; q[d] = x1 * c - x2 * s; q[8 + d] = x2 * c + x1 * s; }
#pragma unroll
            for (int d = 0; d < 64; ++d) { q[d] *= 0.125f; o[d] = 0.f; }
        }
        float m = F.sinks[h], l = 1.0f;
        const int i0 = i & ~63;
        int jlo = i0 + 1, jhi = i0 + 63 + 128; if (n == 0 && jlo < 128) jlo = 128;
        for (int jj = jlo; jj <= jhi; ++jj) {
            const bool valid = (jj > i) && (jj <= i + 128);
            if (valid) {
                float s = 0.f;
#pragma unroll
                for (int d = 0; d < 64; d += 4) { const f32x4 kk = *(const LAS f32x4*)(Kl + jj * 64 + d); s += q[d] * kk.x + q[d + 1] * kk.y + q[d + 2] * kk.z + q[d + 3] * kk.w; }
                if (s > m) { const float sc = __expf(m - s); l *= sc;
#pragma unroll
                    for (int d = 0; d < 64; ++d) o[d] *= sc;
                    m = s; }
                const float p = __expf(s - m); l += p;
#pragma unroll
                for (int d = 0; d < 64; d += 4) { const f32x4 vv = *(const LAS f32x4*)(Vl + jj * 64 + d); o[d] += p * vv.x; o[d + 1] += p * vv.y; o[d + 2] += p * vv.z; o[d + 3] += p * vv.w; }
            }
        }
        const float inv = 1.0f / l;
        const v4u* gp = (const v4u*)(F.PROJ + row * NP + C_AG + h * 64);
        v4u* op = (v4u*)(F.A2 + row * KCAT + h * 64);
#pragma unroll
        for (int k = 0; k < 8; ++k) { const v4u a = gp[k]; v4u w;
            w.x = pk2(o[8 * k + 0] * inv * blo(a.x), o[8 * k + 1] * inv * bhi(a.x));
            w.y = pk2(o[8 * k + 2] * inv * blo(a.y), o[8 * k + 3] * inv * bhi(a.y));
            w.z = pk2(o[8 * k + 4] * inv * blo(a.z), o[8 * k + 5] * inv * bhi(a.z));
            w.w = pk2(o[8 * k + 6] * inv * blo(a.w), o[8 * k + 7] * inv * bhi(a.w));
            op[k] = w; }
    }
    __syncthreads();
}


typedef short bf16x8_t __attribute__((ext_vector_type(8)));
typedef short s16x4_t __attribute__((ext_vector_type(4)));
typedef float f32x16 __attribute__((ext_vector_type(16)));
typedef unsigned u32x2_t __attribute__((ext_vector_type(2)));
typedef float f32x2_t_ __attribute__((ext_vector_type(2))); typedef __bf16 bf16x2_t_ __attribute__((ext_vector_type(2)));
__device__ __forceinline__ unsigned cvtpk(float lo, float hi) { f32x2_t_ v = {lo, hi}; bf16x2_t_ b = __builtin_convertvector(v, bf16x2_t_); return __builtin_bit_cast(unsigned, b); }
#define ACC_FRAG(X, s) __builtin_bit_cast(bf16x8_t, (v4u){cvtpk((X)[8 * (s) + 0], (X)[8 * (s) + 1]), cvtpk((X)[8 * (s) + 2], (X)[8 * (s) + 3]), cvtpk((X)[8 * (s) + 4], (X)[8 * (s) + 5]), cvtpk((X)[8 * (s) + 6], (X)[8 * (s) + 7])})
__device__ __forceinline__ s16x4_t lds_tr16(const LAS unsigned char* p) { typedef short v4i16_t __attribute__((ext_vector_type(4))); return __builtin_bit_cast(s16x4_t, __builtin_amdgcn_ds_read_tr16_b64_v4i16((LAS v4i16_t*)p)); }
#define MFMA32(A, B, C) __builtin_amdgcn_mfma_f32_32x32x16_bf16((A), (B), (C), 0, 0, 0)
struct TrAddr { unsigned a0, a1; };
__device__ __forceinline__ TrAddr tr_addr(int lane) {
    const int g16 = lane >> 4, dhalf = g16 & 1, hh = g16 >> 1, q = (lane & 15) >> 2, p = lane & 3;
    TrAddr t;
    const int cl0 = 4 * hh + q, cl1 = 8 + 4 * hh + q, sw = 4 * (p & 1) + 8 * dhalf;
    t.a0 = (unsigned)((dhalf * 64 + (p & 1) * 32 + (cl0 ^ sw)) * 16 + (p >> 1) * 8);
    t.a1 = (unsigned)((dhalf * 64 + (p & 1) * 32 + (cl1 ^ sw)) * 16 + (p >> 1) * 8);
    return t;
}
__device__ __forceinline__ bf16x8_t tr_frag(const LAS unsigned char* tile, const TrAddr& t, int ct, int s) {
    const s16x4_t lo = lds_tr16(tile + t.a0 + ct * 2048 + s * 256), hi = lds_tr16(tile + t.a1 + ct * 2048 + s * 256);
    return (bf16x8_t){lo[0], lo[1], lo[2], lo[3], hi[0], hi[1], hi[2], hi[3]};
}

__device__ __forceinline__ void p3_attn_item(Frame& F, int b, int n, int hk) {
    LAS unsigned char* Kimg = F.lds; LAS unsigned char* Vimg = F.lds + 32768;
    const int tid = F.tid, lane = F.lane;
    {
        const int key = tid >> 1, half = tid & 1; const int tok = n * 128 - 128 + key;
        const int kt = key >> 5, r = key & 31;
        float kv[32]; v4u vraw[4];
        if (tok >= 0) {
            const size_t row = (size_t)b * SEQ + tok;
            const v4u* kp = (const v4u*)(F.PROJ + row * NP + C_AK + hk * 64 + half * 32);
            const v4u* vp = (const v4u*)(F.PROJ + row * NP + C_AV + hk * 64 + half * 32);
#pragma unroll
            for (int i = 0; i < 4; ++i) { const v4u a = kp[i]; vraw[i] = vp[i];
                kv[8 * i + 0] = blo(a.x); kv[8 * i + 1] = bhi(a.x); kv[8 * i + 2] = blo(a.y); kv[8 * i + 3] = bhi(a.y); kv[8 * i + 4] = blo(a.z); kv[8 * i + 5] = bhi(a.z); kv[8 * i + 6] = blo(a.w); kv[8 * i + 7] = bhi(a.w); }
            float ss = 0.f;
#pragma unroll
            for (int d = 0; d < 32; ++d) ss += kv[d] * kv[d];
            ss += __shfl_xor(ss, 1);
            const float rs = rsqrtf(ss * (1.f / 64.f) + EPS);
#pragma unroll
            for (int d = 0; d < 32; ++d) kv[d] = kv[d] * rs * F.k_norm_w[half * 32 + d];
            if (half == 0) {
                const float* cs = F.ROPE + row * 16;
#pragma unroll
                for (int d = 0; d < 8; ++d) { const float x1 = kv[d], x2 = kv[8 + d], c = cs[d], s = cs[8 + d]; kv[d] = x1 * c - x2 * s; kv[8 + d] = x2 * c + x1 * s; }
            }
        } else {
#pragma unroll
            for (int d = 0; d < 32; ++d) kv[d] = 0.f;
#pragma unroll
            for (int i = 0; i < 4; ++i) vraw[i] = (v4u){0u, 0u, 0u, 0u};
        }
#pragma unroll
        for (int ck = 0; ck < 4; ++ck) {
            const int ks = half * 2 + (ck >> 1), h = ck & 1, e = ck & 1;
            v4u w; w.x = pk2(kv[8 * ck + 0], kv[8 * ck + 1]); w.y = pk2(kv[8 * ck + 2], kv[8 * ck + 3]); w.z = pk2(kv[8 * ck + 4], kv[8 * ck + 5]); w.w = pk2(kv[8 * ck + 6], kv[8 * ck + 7]);
            *(LAS v4u*)(Kimg + ((kt * 4 + ks) * 64 + h * 32 + r) * 16) = w;
            const int sw = 8 * (ks & 1);
            *(LAS u32x2_t*)(Vimg + ((kt * 4 + ks) * 64 + 0 * 32 + (r ^ (0 + sw))) * 16 + e * 8) = (u32x2_t){vraw[ck].x, vraw[ck].y};
            *(LAS u32x2_t*)(Vimg + ((kt * 4 + ks) * 64 + 1 * 32 + (r ^ (4 + sw))) * 16 + e * 8) = (u32x2_t){vraw[ck].z, vraw[ck].w};
        }
    }
    __syncthreads();
    const int r = lane & 31, hh = lane >> 5, g = F.wave, h = hk * 8 + g;
    const TrAddr tra = tr_addr(lane);
    const float sink = F.sinks[h];
    for (int qi = 0; qi < 4; ++qi) {
        const size_t row = (size_t)b * SEQ + n * 128 + 32 * qi + r;
        bf16x8_t qf[4];
        {
            float q[32];
#pragma unroll
            for (int ks = 0; ks < 4; ++ks) { const v4u a = *(const v4u*)(F.PROJ + row * NP + C_AQ + h * 64 + 16 * ks + 8 * hh);
                q[8 * ks + 0] = blo(a.x); q[8 * ks + 1] = bhi(a.x); q[8 * ks + 2] = blo(a.y); q[8 * ks + 3] = bhi(a.y); q[8 * ks + 4] = blo(a.z); q[8 * ks + 5] = bhi(a.z); q[8 * ks + 6] = blo(a.w); q[8 * ks + 7] = bhi(a.w); }
            float ss = 0.f;
#pragma unroll
            for (int d = 0; d < 32; ++d) ss += q[d] * q[d];
            ss += __shfl_xor(ss, 32);
            const float rs = rsqrtf(ss * (1.f / 64.f) + EPS);
#pragma unroll
            for (int ks = 0; ks < 4; ++ks)
#pragma unroll
                for (int j = 0; j < 8; ++j) q[8 * ks + j] = q[8 * ks + j] * rs * F.q_norm_w[16 * ks + 8 * hh + j];
            const float* cs = F.ROPE + row * 16;
#pragma unroll
            for (int j = 0; j < 8; ++j) { const float own = q[j], oth = __shfl_xor(own, 32), c = cs[j], s = cs[8 + j]; q[j] = own * c + (hh ? oth * s : -oth * s); }
#pragma unroll
            for (int ks = 0; ks < 4; ++ks) { v4u w; w.x = pk2(q[8 * ks + 0] * 0.125f, q[8 * ks + 1] * 0.125f); w.y = pk2(q[8 * ks + 2] * 0.125f, q[8 * ks + 3] * 0.125f); w.z = pk2(q[8 * ks + 4] * 0.125f, q[8 * ks + 5] * 0.125f); w.w = pk2(q[8 * ks + 6] * 0.125f, q[8 * ks + 7] * 0.125f);
                qf[ks] = __builtin_bit_cast(bf16x8_t, w); }
        }
        f32x16 st[5];
#pragma unroll
        for (int kp = 0; kp < 5; ++kp) {
            const int kt = qi + kp; f32x16 acc = {};
#pragma unroll
            for (int ks = 0; ks < 4; ++ks) { const bf16x8_t kf = *(const LAS bf16x8_t*)(Kimg + ((kt * 4 + ks) * 64 + lane) * 16); acc = MFMA32(kf, qf[ks], acc); }
            st[kp] = acc;
        }
        const int iq = 32 * qi + r;
        float m = sink;
#pragma unroll
        for (int kp = 0; kp < 5; ++kp)
#pragma unroll
            for (int reg = 0; reg < 16; ++reg) { const int j = 32 * (qi + kp) + (reg & 3) + 8 * (reg >> 2) + 4 * hh;
                const bool valid = (j > iq) && (j <= iq + 128) && (n > 0 || j >= 128);
                const float s = valid ? st[kp][reg] : -1e30f; st[kp][reg] = s; m = fmaxf(m, s); }
        m = fmaxf(m, __shfl_xor(m, 32));
        float l = 0.f;
#pragma unroll
        for (int kp = 0; kp < 5; ++kp)
#pragma unroll
            for (int reg = 0; reg < 16; ++reg) { const float p = __expf(st[kp][reg] - m); st[kp][reg] = p; l += p; }
        l += __shfl_xor(l, 32);
        l += __expf(sink - m);
        f32x16 ot[2];
#pragma unroll
        for (int mt = 0; mt < 2; ++mt) { f32x16 acc = {};
#pragma unroll
            for (int kp = 0; kp < 5; ++kp)
#pragma unroll
                for (int s = 0; s < 2; ++s) { const bf16x8_t vf = tr_frag(Vimg + (qi + kp) * 4096, tra, mt, s); acc = MFMA32(vf, ACC_FRAG(st[kp], s), acc); }
            ot[mt] = acc; }
        const float inv = 1.0f / l;
#pragma unroll
        for (int mt = 0; mt < 2; ++mt)
#pragma unroll
            for (int gg = 0; gg < 4; ++gg) { const int d = 32 * mt + 8 * gg + 4 * hh;
                const u32x2_t gw = *(const u32x2_t*)(F.PROJ + row * NP + C_AG + h * 64 + d);
                u32x2_t w; w.x = pk2(ot[mt][4 * gg + 0] * inv * blo(gw.x), ot[mt][4 * gg + 1] * inv * bhi(gw.x));
                w.y = pk2(ot[mt][4 * gg + 2] * inv * blo(gw.y), ot[mt][4 * gg + 3] * inv * bhi(gw.y));
                *(u32x2_t*)(F.A2 + row * KCAT + h * 64 + d) = w; }
    }
    __syncthreads();
}


constexpr int KQ_BYTES = 32768, TQV_BYTES = 29696, TQV_TB = 0, TQV_QK = 6144, TQV_VT = 12288, TQV_VEC = 28672;
constexpr int STAGE_BYTES_DN = KQ_BYTES + TQV_BYTES;
constexpr int OBUF_OFF = 2 * STAGE_BYTES_DN, OBUF_PITCH = 272, OBUF_BYTES = 64 * OBUF_PITCH;

__device__ __forceinline__ int lt_off(int s, int c) { return s < 32 ? 64 * s + c : 2048 + 32 * (s - 32) + (c - 32); }

__device__ __forceinline__ void fnma_(float& acc, float a, float b) { asm("v_fma_f32 %0, -%1, %2, %0" : "+v"(acc) : "v"(a), "v"(b)); }
template <int S_> struct SubstRow {
    static __device__ __forceinline__ void run(float (&X)[64], const LAS float* LT, int lane) {
        float a0 = (lane == S_) ? 1.0f : 0.0f, a1 = 0.f, a2 = 0.f, a3 = 0.f;
        constexpr int C0 = ((S_ + 1) / 4) * 4;
#pragma unroll
        for (int c4 = C0; c4 < 64; c4 += 4) {
            const f32x4 l4 = *(const LAS f32x4*)(LT + (S_ < 32 ? 64 * S_ + c4 : 2048 + 32 * (S_ - 32) + (c4 - 32)));
            if (c4 + 0 > S_) fnma_(a0, X[c4 + 0], l4.x);
            if (c4 + 1 > S_) fnma_(a1, X[c4 + 1], l4.y);
            if (c4 + 2 > S_) fnma_(a2, X[c4 + 2], l4.z);
            if (c4 + 3 > S_) fnma_(a3, X[c4 + 3], l4.w);
        }
        X[S_] = (a0 + a1) + (a2 + a3);
        if constexpr (S_ > 0) SubstRow<S_ - 1>::run(X, LT, lane);
    }
};

__device__ __forceinline__ void p3a_unit(Frame& F, int b, int n, int kq) {
    LAS unsigned char* KNimg = F.lds; LAS unsigned char* QNimg = F.lds + 16384;
    LAS float* LTall = (LAS float*)(F.lds + 32768);
    LAS float* betaL = (LAS float*)(F.lds + 131072);
    LAS float* gcL = betaL + 512;
    const int w = F.wave;
    const int t0 = n * 64;
    for (int kk = 0; kk < 4; ++kk) {
        int lane = F.lane; asm volatile("" : "+v"(lane));
        const int r = lane & 31, hh = lane >> 5;
        const int kh = kq * 4 + kk;
        unsigned char* kqrec = F.KQ + ((size_t)(b * 16 + kh) * 64 + n) * KQ_BYTES;
        {
            const int wch = lane < 16 ? kh * 128 + lane * 8 : (lane < 32 ? 2048 + kh * 128 + (lane - 16) * 8 : 4096 + kh * 256 + (lane - 32) * 8);
            float cw[4][8];
#pragma unroll
            for (int j = 0; j < 4; ++j) { const f32x4 a = *(const f32x4*)(F.conv_w + j * 8192 + wch), c = *(const f32x4*)(F.conv_w + j * 8192 + wch + 4);
                cw[j][0] = a.x; cw[j][1] = a.y; cw[j][2] = a.z; cw[j][3] = a.w; cw[j][4] = c.x; cw[j][5] = c.y; cw[j][6] = c.z; cw[j][7] = c.w; }
            v4u raw[11];
#pragma unroll
            for (int i = 0; i < 11; ++i) { const int tt = t0 + 8 * w - 3 + i;
                raw[i] = tt >= 0 ? *(const v4u*)(F.PROJ + ((size_t)b * SEQ + tt) * NP + C_DQKV + wch) : (v4u){0u, 0u, 0u, 0u}; }
            const float qs = lane < 16 ? 0.08838834764831845f : 1.0f;
            const int l16 = lane & 15, ks = l16 >> 1, odd = l16 & 1, mi = w >> 2;
            const bool isk = lane >= 16;
            LAS unsigned char* img = isk ? KNimg : QNimg; unsigned char* gimg = kqrec + (isk ? 0 : 16384);
            unsigned vpk[4][8];
#pragma unroll
            for (int tp = 0; tp < 4; ++tp) {
                float y[2][8];
#pragma unroll
                for (int u = 0; u < 2; ++u) { const int t = 2 * tp + u;
#pragma unroll
                    for (int e = 0; e < 8; ++e) y[u][e] = 0.f;
#pragma unroll
                    for (int j = 0; j < 4; ++j) { const v4u a = raw[t + j];
                        y[u][0] += cw[j][0] * blo(a.x); y[u][1] += cw[j][1] * bhi(a.x); y[u][2] += cw[j][2] * blo(a.y); y[u][3] += cw[j][3] * bhi(a.y);
                        y[u][4] += cw[j][4] * blo(a.z); y[u][5] += cw[j][5] * bhi(a.z); y[u][6] += cw[j][6] * blo(a.w); y[u][7] += cw[j][7] * bhi(a.w); }
                    float ss = 0.f;
#pragma unroll
                    for (int e = 0; e < 8; ++e) { y[u][e] = siluf_(y[u][e]); ss += y[u][e] * y[u][e]; }
                    ss += __shfl_xor(ss, 1); ss += __shfl_xor(ss, 2); ss += __shfl_xor(ss, 4); ss += __shfl_xor(ss, 8);
                    const float sc = lane < 32 ? rsqrtf(ss + EPS) * qs : 1.0f;
#pragma unroll
                    for (int e = 0; e < 8; ++e) y[u][e] *= sc;
                    if (lane < 32) {
                        const int rr = 8 * (w & 3) + t;
                        const u32x2_t p0 = {pk2(y[u][0], y[u][1]), pk2(y[u][2], y[u][3])}, p1 = {pk2(y[u][4], y[u][5]), pk2(y[u][6], y[u][7])};
                        const int sw = isk ? 8 * (ks & 1) : 0;
                        const int o0 = ((mi * 8 + ks) * 64 + 0 * 32 + (rr ^ sw)) * 16 + 8 * odd, o1 = ((mi * 8 + ks) * 64 + 1 * 32 + (rr ^ (isk ? 4 + sw : 0))) * 16 + 8 * odd;
                        *(LAS u32x2_t*)(img + o0) = p0; *(LAS u32x2_t*)(img + o1) = p1;
                        *(u32x2_t*)(gimg + o0) = p0; *(u32x2_t*)(gimg + o1) = p1;
                    }
                }
#pragma unroll
                for (int e = 0; e < 8; ++e) vpk[tp][e] = pk2(y[0][e], y[1][e]);
                asm volatile("" ::: "memory");
            }
            if (lane >= 32) {
                const int hv = 2 * kh + ((lane - 32) >> 4), dv0 = ((lane - 32) & 15) * 8;
                unsigned char* vt = F.TQV + ((size_t)(b * 32 + hv) * 64 + n) * TQV_BYTES + TQV_VT;
#pragma unroll
                for (int e = 0; e < 8; ++e) *(v4u*)(vt + ((size_t)(w * 128 + dv0 + e)) * 16) = (v4u){vpk[0][e], vpk[1][e], vpk[2][e], vpk[3][e]};
            }
        }
        if (w < 2) {
            const int hv = 2 * kh + w, hs = kk * 2 + w; const size_t row = (size_t)b * SEQ + t0 + lane;
            const float db = F.DBA[row * 64 + hv], da = F.DBA[row * 64 + 32 + hv];
            const float xx = da + F.dt_bias[hv]; const float sp = xx > 20.f ? xx : log1pf(__expf(xx));
            float gc = -__expf(F.a_log[hv]) * sp;
#pragma unroll
            for (int off = 1; off < 64; off <<= 1) { const float t = __shfl_up(gc, off); if (lane >= off) gc += t; }
            const float gl = __shfl(gc, 63);
            betaL[hs * 64 + lane] = sigm_(db); gcL[hs * 64 + lane] = gc;
            float* vec = (float*)(F.TQV + ((size_t)(b * 32 + hv) * 64 + n) * TQV_BYTES + TQV_VEC);
            vec[lane] = __expf(gc); vec[64 + lane] = __expf(gl - gc);
        }
        __syncthreads();
        if ((w & 3) < 3) {
            const int tsel = w & 3;
            const bool isqk = w >= 4;
            const int rt = isqk ? (tsel == 2 ? 1 : 0) : (tsel == 0 ? 0 : 1);
            const int ct = isqk ? (tsel == 0 ? 0 : 1) : (tsel == 2 ? 1 : 0);
            f32x16 acc = {};
            const int posE = hh * 32 + (r ^ (4 * hh)), posO = hh * 32 + (r ^ (4 * hh + 8));
#pragma unroll
            for (int ks = 0; ks < 8; ++ks) {
                const bf16x8_t a = *(const LAS bf16x8_t*)(KNimg + ((rt * 8 + ks) * 64 + ((ks & 1) ? posO : posE)) * 16);
                const bf16x8_t bb = isqk ? *(const LAS bf16x8_t*)(QNimg + ((ct * 8 + ks) * 64 + lane) * 16) : *(const LAS bf16x8_t*)(KNimg + ((ct * 8 + ks) * 64 + ((ks & 1) ? posO : posE)) * 16);
                acc = MFMA32(a, bb, acc);
            }
#pragma unroll
            for (int h2 = 0; h2 < 2; ++h2) {
                const int hs = kk * 2 + h2, hv = 2 * kh + h2;
                const float gcol = gcL[hs * 64 + 32 * ct + r];
                if (!isqk) {
                    const int s = 32 * ct + r;
#pragma unroll
                    for (int g = 0; g < 4; ++g) { const int c0 = 32 * rt + 8 * g + 4 * hh;
                        const f32x4 gr = *(const LAS f32x4*)(gcL + hs * 64 + c0), br = *(const LAS f32x4*)(betaL + hs * 64 + c0); f32x4 o;
                        o.x = (c0 + 0 > s) ? br.x * acc[4 * g + 0] * __expf(gr.x - gcol) : 0.f; o.y = (c0 + 1 > s) ? br.y * acc[4 * g + 1] * __expf(gr.y - gcol) : 0.f;
                        o.z = (c0 + 2 > s) ? br.z * acc[4 * g + 2] * __expf(gr.z - gcol) : 0.f; o.w = (c0 + 3 > s) ? br.w * acc[4 * g + 3] * __expf(gr.w - gcol) : 0.f;
                        *(LAS f32x4*)(LTall + hs * 3072 + lt_off(s, c0)) = o; }
                } else {
                    const int c = 32 * ct + r; f32x16 m;
#pragma unroll
                    for (int g = 0; g < 4; ++g) { const int s0 = 32 * rt + 8 * g + 4 * hh; const f32x4 gr = *(const LAS f32x4*)(gcL + hs * 64 + s0);
                        m[4 * g + 0] = (s0 + 0 <= c) ? acc[4 * g + 0] * __expf(gcol - gr.x) : 0.f; m[4 * g + 1] = (s0 + 1 <= c) ? acc[4 * g + 1] * __expf(gcol - gr.y) : 0.f;
                        m[4 * g + 2] = (s0 + 2 <= c) ? acc[4 * g + 2] * __expf(gcol - gr.z) : 0.f; m[4 * g + 3] = (s0 + 3 <= c) ? acc[4 * g + 3] * __expf(gcol - gr.w) : 0.f; }
                    unsigned char* qk = F.TQV + ((size_t)(b * 32 + hv) * 64 + n) * TQV_BYTES + TQV_QK;
                    const int blk0 = (ct == 0 ? 0 : 2) + 2 * rt;
                    *(bf16x8_t*)(qk + ((blk0 + 0) * 64 + lane) * 16) = ACC_FRAG(m, 0);
                    *(bf16x8_t*)(qk + ((blk0 + 1) * 64 + lane) * 16) = ACC_FRAG(m, 1);
                }
            }
        }
        __syncthreads();
    }
    {
        int lane = F.lane; asm volatile("" : "+v"(lane));
        const int r = lane & 31;
        const int hs = w, hv = 2 * (kq * 4 + (w >> 1)) + (w & 1);
        float X[64];
        SubstRow<63>::run(X, LTall + hs * 3072, lane);
        unsigned char* tb = F.TQV + ((size_t)(b * 32 + hv) * 64 + n) * TQV_BYTES + TQV_TB;
        const int mi2 = lane >> 5;
#pragma unroll
        for (int ks2 = 0; ks2 < 4; ++ks2) {
            if (mi2 == 1 || ks2 < 2) {
#pragma unroll
                for (int h2 = 0; h2 < 2; ++h2) { const int c0 = 16 * ks2 + 4 * h2;
                    const f32x4 b0 = *(const LAS f32x4*)(betaL + hs * 64 + c0), b1 = *(const LAS f32x4*)(betaL + hs * 64 + c0 + 8);
                    v4u c; c.x = pk2(X[c0 + 0] * b0.x, X[c0 + 1] * b0.y); c.y = pk2(X[c0 + 2] * b0.z, X[c0 + 3] * b0.w); c.z = pk2(X[c0 + 8] * b1.x, X[c0 + 9] * b1.y); c.w = pk2(X[c0 + 10] * b1.z, X[c0 + 11] * b1.w);
                    *(v4u*)(tb + (((mi2 == 0 ? 0 : 2) + ks2) * 64 + h2 * 32 + r) * 16) = c; }
            }
        }
    }
    __syncthreads();
}

__device__ __forceinline__ void glds16(const unsigned char* gsrc, LAS unsigned char* ldst) { __builtin_amdgcn_global_load_lds((const unsigned*)gsrc, (LAS unsigned*)ldst, 16, 0, 0); }

__device__ __forceinline__ void p3b_scan(Frame& F, int b, int h) {
    const int lane = F.lane, w = F.wave, r = lane & 31, hh = lane >> 5, kh = h >> 1;
    const unsigned char* kqbase = F.KQ + (size_t)(b * 16 + kh) * 64 * KQ_BYTES;
    const unsigned char* tqvbase = F.TQV + (size_t)(b * 32 + h) * 64 * TQV_BYTES;
    constexpr int NCH = SEQ / 64;
    if (w >= 4) {
        const int hw = w - 4;
#define DN_ISSUE(nn) do { LAS unsigned char* dst_ = F.lds + ((nn) & 1) * STAGE_BYTES_DN; const unsigned char* s0_ = kqbase + (size_t)(nn) * KQ_BYTES; const unsigned char* s1_ = tqvbase + (size_t)(nn) * TQV_BYTES; \
            for (int p_ = hw; p_ < 61; p_ += 4) { if (p_ < 32) glds16(s0_ + p_ * 1024 + lane * 16, dst_ + p_ * 1024); else glds16(s1_ + (p_ - 32) * 1024 + lane * 16, dst_ + p_ * 1024); } } while (0)
#define DN_OUT(nn) do { const int row_ = 16 * hw + (lane >> 2), q4_ = lane & 3; const LAS unsigned char* ob_ = F.lds + OBUF_OFF + ((nn) & 1) * OBUF_BYTES + row_ * OBUF_PITCH + q4_ * 64; \
            float ov_[32]; float ss_ = 0.f; \
            _Pragma("unroll") for (int i_ = 0; i_ < 4; ++i_) { const v4u a_ = *(const LAS v4u*)(ob_ + i_ * 16); \
                ov_[8 * i_ + 0] = blo(a_.x); ov_[8 * i_ + 1] = bhi(a_.x); ov_[8 * i_ + 2] = blo(a_.y); ov_[8 * i_ + 3] = bhi(a_.y); ov_[8 * i_ + 4] = blo(a_.z); ov_[8 * i_ + 5] = bhi(a_.z); ov_[8 * i_ + 6] = blo(a_.w); ov_[8 * i_ + 7] = bhi(a_.w); } \
            _Pragma("unroll") for (int i_ = 0; i_ < 32; ++i_) ss_ += ov_[i_] * ov_[i_]; \
            ss_ += __shfl_xor(ss_, 1); ss_ += __shfl_xor(ss_, 2); \
            const float rs_ = rsqrtf(ss_ * (1.f / 128.f) + EPS); \
            const size_t grow_ = (size_t)b * SEQ + (size_t)(nn) * 64 + row_; \
            const v4u* gz_ = (const v4u*)(F.PROJ + grow_ * NP + C_DZ + h * 128 + q4_ * 32); v4u* op_ = (v4u*)(F.A2 + grow_ * KCAT + 2048 + h * 128 + q4_ * 32); \
            _Pragma("unroll") for (int i_ = 0; i_ < 4; ++i_) { const v4u g_ = gz_[i_]; v4u o_; \
                o_.x = pk2(ov_[8 * i_ + 0] * rs_ * blo(g_.x), ov_[8 * i_ + 1] * rs_ * bhi(g_.x)); o_.y = pk2(ov_[8 * i_ + 2] * rs_ * blo(g_.y), ov_[8 * i_ + 3] * rs_ * bhi(g_.y)); \
                o_.z = pk2(ov_[8 * i_ + 4] * rs_ * blo(g_.z), ov_[8 * i_ + 5] * rs_ * bhi(g_.z)); o_.w = pk2(ov_[8 * i_ + 6] * rs_ * blo(g_.w), ov_[8 * i_ + 7] * rs_ * bhi(g_.w)); op_[i_] = o_; } } while (0)
        DN_ISSUE(0);
        asm volatile("s_waitcnt vmcnt(0)" ::: "memory");
        __builtin_amdgcn_s_barrier(); asm volatile("" ::: "memory");
        for (int n = 0; n < NCH; ++n) {
            if (n + 1 < NCH) DN_ISSUE(n + 1);
            if (n >= 1) DN_OUT(n - 1);
            asm volatile("s_waitcnt vmcnt(0) lgkmcnt(0)" ::: "memory");
            __builtin_amdgcn_s_barrier(); asm volatile("" ::: "memory");
        }
        DN_OUT(NCH - 1);
#undef DN_ISSUE
#undef DN_OUT
    } else {
        const int n0 = 32 * w;
        f32x16 S[4];
#pragma unroll
        for (int d = 0; d < 4; ++d) S[d] = (f32x16){};
        __builtin_amdgcn_s_barrier(); asm volatile("" ::: "memory");
        for (int n = 0; n < NCH; ++n) {
            int lane = F.lane; asm volatile("" : "+v"(lane));
            const int r = lane & 31, hh = lane >> 5;
            const int posE = (hh * 32 + (r ^ (4 * hh))) * 16, posO = (hh * 32 + (r ^ (4 * hh + 8))) * 16;
            const LAS unsigned char* st = F.lds + (n & 1) * STAGE_BYTES_DN;
            const LAS unsigned char* tq = st + KQ_BYTES;
            const LAS float* egp = (const LAS float*)(tq + TQV_VEC);
            bf16x8_t Sb[4][2];
#pragma unroll
            for (int d = 0; d < 4; ++d) { Sb[d][0] = ACC_FRAG(S[d], 0); Sb[d][1] = ACC_FRAG(S[d], 1); }
            f32x16 x[2], o[2];
#pragma unroll
            for (int mi = 0; mi < 2; ++mi) { f32x16 ax = {}, ao = {};
#pragma unroll
                for (int ks = 0; ks < 8; ++ks) {
                    const bf16x8_t ka = *(const LAS bf16x8_t*)(st + (mi * 8 + ks) * 1024 + ((ks & 1) ? posO : posE));
                    const bf16x8_t qa = *(const LAS bf16x8_t*)(st + 16384 + (mi * 8 + ks) * 1024 + lane * 16);
                    ax = MFMA32(ka, Sb[ks >> 1][ks & 1], ax); ao = MFMA32(qa, Sb[ks >> 1][ks & 1], ao);
                    if ((ks & 3) == 3) __builtin_amdgcn_sched_barrier(0); }
                x[mi] = ax; o[mi] = ao; }
            __builtin_amdgcn_sched_barrier(0);
            bf16x8_t Xb[2][2];
#pragma unroll
            for (int mi = 0; mi < 2; ++mi) {
#pragma unroll
                for (int g = 0; g < 4; ++g) { const int c0 = 32 * mi + 8 * g + 4 * hh;
                    const f32x4 e4 = *(const LAS f32x4*)(egp + c0);
                    const u32x2_t vv = *(const LAS u32x2_t*)(tq + TQV_VT + ((4 * mi + g) * 128 + n0 + r) * 16 + hh * 8);
                    x[mi][4 * g + 0] = blo(vv.x) - e4.x * x[mi][4 * g + 0]; x[mi][4 * g + 1] = bhi(vv.x) - e4.y * x[mi][4 * g + 1];
                    x[mi][4 * g + 2] = blo(vv.y) - e4.z * x[mi][4 * g + 2]; x[mi][4 * g + 3] = bhi(vv.y) - e4.w * x[mi][4 * g + 3];
                    o[mi][4 * g + 0] *= e4.x; o[mi][4 * g + 1] *= e4.y; o[mi][4 * g + 2] *= e4.z; o[mi][4 * g + 3] *= e4.w; }
                Xb[mi][0] = ACC_FRAG(x[mi], 0); Xb[mi][1] = ACC_FRAG(x[mi], 1); }
            __builtin_amdgcn_sched_barrier(0);
            f32x16 vn[2];
            { f32x16 a0 = {}, a1 = {};
#define TBF(i) (*(const LAS bf16x8_t*)(tq + TQV_TB + ((i) * 64 + lane) * 16))
#define QKF(i) (*(const LAS bf16x8_t*)(tq + TQV_QK + ((i) * 64 + lane) * 16))
              a0 = MFMA32(TBF(0), Xb[0][0], a0); a0 = MFMA32(TBF(1), Xb[0][1], a0);
              a1 = MFMA32(TBF(2), Xb[0][0], a1); a1 = MFMA32(TBF(3), Xb[0][1], a1); a1 = MFMA32(TBF(4), Xb[1][0], a1); a1 = MFMA32(TBF(5), Xb[1][1], a1);
              vn[0] = a0; vn[1] = a1; }
            __builtin_amdgcn_sched_barrier(0);
            bf16x8_t Vb[2][2], Vd[2][2];
#pragma unroll
            for (int mi = 0; mi < 2; ++mi) { Vb[mi][0] = ACC_FRAG(vn[mi], 0); Vb[mi][1] = ACC_FRAG(vn[mi], 1);
#pragma unroll
                for (int g = 0; g < 4; ++g) { const f32x4 d4 = *(const LAS f32x4*)(egp + 64 + 32 * mi + 8 * g + 4 * hh);
                    vn[mi][4 * g + 0] *= d4.x; vn[mi][4 * g + 1] *= d4.y; vn[mi][4 * g + 2] *= d4.z; vn[mi][4 * g + 3] *= d4.w; }
                Vd[mi][0] = ACC_FRAG(vn[mi], 0); Vd[mi][1] = ACC_FRAG(vn[mi], 1); }
            __builtin_amdgcn_sched_barrier(0);
            o[0] = MFMA32(QKF(0), Vb[0][0], o[0]); o[0] = MFMA32(QKF(1), Vb[0][1], o[0]);
            o[1] = MFMA32(QKF(2), Vb[0][0], o[1]); o[1] = MFMA32(QKF(3), Vb[0][1], o[1]); o[1] = MFMA32(QKF(4), Vb[1][0], o[1]); o[1] = MFMA32(QKF(5), Vb[1][1], o[1]);
#undef TBF
#undef QKF
            { LAS unsigned char* ob = F.lds + OBUF_OFF + (n & 1) * OBUF_BYTES + (n0 + r) * 2;
#pragma unroll
              for (int mi = 0; mi < 2; ++mi)
#pragma unroll
                for (int reg = 0; reg < 16; ++reg) { const int c = 32 * mi + (reg & 3) + 8 * (reg >> 2) + 4 * hh; *(LAS unsigned short*)(ob + c * OBUF_PITCH) = (unsigned short)f2bf(o[mi][reg]); } }
            __builtin_amdgcn_sched_barrier(0);
            const float egl = egp[63];
            int lane2 = F.lane; asm volatile("" : "+v"(lane2));
            const TrAddr tra = tr_addr(lane2);
#pragma unroll
            for (int d = 0; d < 4; ++d) { f32x16 a = S[d] * egl;
#pragma unroll
                for (int ci = 0; ci < 2; ++ci)
#pragma unroll
                    for (int s = 0; s < 2; ++s) a = MFMA32(tr_frag(st + ci * 8192, tra, d, s), Vd[ci][s], a);
                S[d] = a; __builtin_amdgcn_sched_barrier(0); }
            asm volatile("s_waitcnt lgkmcnt(0)" ::: "memory");
            __builtin_amdgcn_s_barrier(); asm volatile("" ::: "memory");
        }
    }
}

__device__ __forceinline__ void p3_scan_item_simple(Frame& F, int b, int h) {
    LAS float* Qs = (LAS float*)F.lds; LAS float* Ks = Qs + 8192; LAS float* Vs = Ks + 8192; LAS float* Os = Vs + 8192;
    LAS float* bet = (LAS float*)(F.lds + SMALL_OFF); LAS float* eg = bet + 64;
    const int tid = F.tid, j = tid >> 2, dq = tid & 3, kh = h >> 1;
    float S[32];
#pragma unroll
    for (int d = 0; d < 32; ++d) S[d] = 0.f;
    const float aexp = __expf(F.a_log[h]), dtb = F.dt_bias[h];
    for (int ch = 0; ch < SEQ / 64; ++ch) {
        const int t0 = ch * 64;
        for (int idx = tid; idx < 64 * 384; idx += 512) {
            const int tok = idx / 384, c = idx - tok * 384;
            const int wch = c < 128 ? kh * 128 + c : (c < 256 ? 2048 + kh * 128 + (c - 128) : 4096 + h * 128 + (c - 256));
            float acc = 0.f;
#pragma unroll
            for (int jj = 0; jj < 4; ++jj) { const int tt = t0 + tok - 3 + jj; if (tt >= 0) acc += bf2f(F.PROJ[((size_t)b * SEQ + tt) * NP + C_DQKV + wch]) * F.conv_w[jj * 8192 + wch]; }
            const float y = siluf_(acc);
            LAS float* dst = c < 128 ? Qs : (c < 256 ? Ks : Vs);
            dst[tok * 128 + (c & 127)] = y;
        }
        if (tid < 64) { const size_t row = (size_t)b * SEQ + t0 + tid; const float db = F.DBA[row * 64 + h], da = F.DBA[row * 64 + 32 + h];
            bet[tid] = sigm_(db); const float xx = da + dtb; const float sp = xx > 20.f ? xx : log1pf(__expf(xx)); eg[tid] = __expf(-aexp * sp); }
        __syncthreads();
        for (int r = 0; r < 16; ++r) { const int row = F.wave * 16 + r; LAS float* p = row < 64 ? Qs + row * 128 : Ks + (row - 64) * 128;
            const float a = p[F.lane], bb = p[F.lane + 64]; const float ss = wave_sum(a * a + bb * bb);
            const float sc = rsqrtf(ss + EPS) * (row < 64 ? 0.08838834764831845f : 1.0f); p[F.lane] = a * sc; p[F.lane + 64] = bb * sc; }
        __syncthreads();
        for (int t = 0; t < 64; ++t) {
            const float e = eg[t], be = bet[t];
            float kk[32]; float part = 0.f;
#pragma unroll
            for (int d = 0; d < 32; d += 4) { const f32x4 k4 = *(const LAS f32x4*)(Ks + t * 128 + dq * 32 + d); kk[d] = k4.x; kk[d + 1] = k4.y; kk[d + 2] = k4.z; kk[d + 3] = k4.w; }
#pragma unroll
            for (int d = 0; d < 32; ++d) part += S[d] * kk[d];
            part += __shfl_xor(part, 1); part += __shfl_xor(part, 2);
            const float vn = be * (Vs[t * 128 + j] - e * part);
#pragma unroll
            for (int d = 0; d < 32; ++d) S[d] = e * S[d] + kk[d] * vn;
            float po = 0.f;
#pragma unroll
            for (int d = 0; d < 32; d += 4) { const f32x4 q4 = *(const LAS f32x4*)(Qs + t * 128 + dq * 32 + d); po += S[d] * q4.x + S[d + 1] * q4.y + S[d + 2] * q4.z + S[d + 3] * q4.w; }
            po += __shfl_xor(po, 1); po += __shfl_xor(po, 2);
            if (dq == 0) Os[t * 128 + j] = po;
        }
        __syncthreads();
        for (int r = 0; r < 8; ++r) { const int tok = F.wave * 8 + r; const size_t row = (size_t)b * SEQ + t0 + tok;
            const float a = Os[tok * 128 + F.lane], bb = Os[tok * 128 + F.lane + 64]; const float ss = wave_sum(a * a + bb * bb);
            const float rs = rsqrtf(ss * (1.f / 128.f) + EPS);
            const float z0 = bf2f(F.PROJ[row * NP + C_DZ + h * 128 + F.lane]), z1 = bf2f(F.PROJ[row * NP + C_DZ + h * 128 + F.lane + 64]);
            F.A2[row * KCAT + 2048 + h * 128 + F.lane] = (bf16)f2bf(a * rs * z0);
            F.A2[row * KCAT + 2048 + h * 128 + F.lane + 64] = (bf16)f2bf(bb * rs * z1); }
        __syncthreads();
    }
}

#ifndef DN_SIMPLE
#define DN_SIMPLE 0
#endif
#ifndef MK_N_LAUNCHES
#define MK_N_LAUNCHES 1
#endif
constexpr int PER_PHASE = 8;
constexpr int N_LAUNCHES = MK_N_LAUNCHES;
struct Args { const void* in[17]; float* out; unsigned char* ws; int ph_lo, ph_hi, li, pad; };

__global__ void __launch_bounds__(NWAVES * 64, 2) skel_fwd(Args args) {
    extern __shared__ __attribute__((aligned(16))) unsigned char lds[];
    Frame F;
    F.lds = (LAS unsigned char*)lds;
    F.MISC = (volatile LAS unsigned*)(F.lds + MISC_OFF);
    F.tid = threadIdx.x; F.lane = F.tid & 63; F.wave = __builtin_amdgcn_readfirstlane(F.tid >> 6);
    F.G = gridDim.x; { const int bx = blockIdx.x; F.vcu = (F.G % 8 == 0) ? (bx % 8) * (F.G / 8) + bx / 8 : bx; }
    unsigned char* ws = args.ws;
    F.ctl = (gu32*)(ws + WS_CTL);
    F.x = (const float*)args.in[0]; F.c = (const float*)args.in[1]; F.positions = (const int*)args.in[2]; F.w_ada = (const float*)args.in[3]; F.b_ada = (const float*)args.in[4];
    F.norm_w = (const float*)args.in[5]; F.w_in = (const float*)args.in[6]; F.q_norm_w = (const float*)args.in[7]; F.k_norm_w = (const float*)args.in[8]; F.sinks = (const float*)args.in[9];
    F.conv_w = (const float*)args.in[10]; F.a_log = (const float*)args.in[11]; F.dt_bias = (const float*)args.in[12]; F.dn_norm_w = (const float*)args.in[13];
    F.w_o_swa = (const float*)args.in[14]; F.w_o_dn = (const float*)args.in[15]; F.w_out = (const float*)args.in[16]; F.out = args.out;
    F.modacc = (float*)(ws + WS_MODACC); F.WTIN = (bf16*)(ws + WS_WTIN); F.WOCAT = (bf16*)(ws + WS_WOCAT); F.WOUT = (bf16*)(ws + WS_WOUT); F.H = (bf16*)(ws + WS_H);
    F.PROJ = (bf16*)(ws + WS_PROJ); F.A2 = (bf16*)(ws + WS_A2); F.Y = (bf16*)(ws + WS_Y); F.ROPE = (float*)(ws + WS_ROPE); F.DBA = (float*)(ws + WS_DBA); F.YA = (float*)(ws + WS_YA); F.KQ = ws + WS_KQ; F.TQV = ws + WS_TQV;
    for (int u = F.tid; u < (LDS_BYTES - LDSCTL_OFF) / 4; u += NWAVES * 64) ((LAS unsigned*)(F.lds + LDSCTL_OFF))[u] = 0u;
    __syncthreads();
    XcdBarrier bar; bar.bar = (unsigned*)(F.ctl + CW_BAR) + args.li * XCD_BAR_WORDS; bar.x = 0; bar.st = nullptr;
    if (N_LAUNCHES != PER_PHASE) bar = xcd_barrier_post((unsigned*)(F.ctl + CW_BAR) + args.li * XCD_BAR_WORDS, F.MISC + 8);
#define GRID_BAR() do { if (N_LAUNCHES != PER_PHASE) xcd_barrier(bar); } while (0)
    const int lo = args.ph_lo, hi = args.ph_hi;
#define IN(k) (lo <= (k) && (k) < hi)
#define BOTH(k) (IN(k) && IN((k) + 1))

    if (IN(0)) { p0_prologue(F); if (BOTH(0)) GRID_BAR(); }
    if (IN(1)) { p1_hrows(F); if (BOTH(1)) GRID_BAR(); }
    if (IN(2)) {
        pg8::Gemm g{F.H, F.WTIN, MTOK, NP, DM, DM, DM}; pg8::StaticOrder S; S.init(MTOK, NP, F.G, (int)blockIdx.x);
        pg8::EpiProj E{F.PROJ, NP, F.DBA, PN_DBA, F.dn_norm_w};
        pg8::gemm_phase<pg8::EpiProj, pg8::StaticOrder, true, true>(F.lds, g, S, E);
        if (BOTH(2)) GRID_BAR();
    }
    if (IN(3)) {
#if !DN_SIMPLE
        for (int u = blockIdx.x; u < 512; u += F.G) p3a_unit(F, u >> 8, (u >> 2) & 63, u & 3);
#endif
        if (BOTH(3)) GRID_BAR();
    }
    if (IN(4)) {
#if DN_SIMPLE
        for (int it = blockIdx.x; it < 64 + 256; it += F.G) {
            if (it < 64) p3_scan_item_simple(F, it >> 5, it & 31);
            else { const int a = it - 64; p3_attn_item(F, a >> 7, (a >> 2) & 31, a & 3); }
        }
#else
        if (blockIdx.x < 64) { const int it = ((int)blockIdx.x & 7) * 8 + ((int)blockIdx.x >> 3); p3b_scan(F, it >> 5, it & 31); }
        else { for (int a = (int)blockIdx.x - 64; a < 256; a += F.G - 64) p3_attn_item(F, a >> 7, (a >> 2) & 31, a & 3); }
#endif
        if (BOTH(4)) GRID_BAR();
    }
    if (IN(5)) {
        pg8::Gemm g{F.A2, F.WOCAT, MTOK, DM, DM, KCAT, KCAT}; pg8::StaticOrder S; S.init(MTOK, DM, F.G, (int)blockIdx.x);
        pg8::EpiGateF32 E{F.YA, DM, F.PROJ + C_MGA, NP};
        pg8::gemm_phase<pg8::EpiGateF32, pg8::StaticOrder, true, true>(F.lds, g, S, E);
        if (BOTH(5)) GRID_BAR();
    }
    if (IN(6)) {
        pg8::Gemm g{F.A2 + 2048, F.WOCAT + 2048, MTOK, DM, 4096, KCAT, KCAT}; pg8::StaticOrder S; S.init(MTOK, DM, F.G, (int)blockIdx.x);
        pg8::EpiGateAddBf16 E{F.Y, DM, F.YA, DM, F.PROJ + C_MGB, NP};
        pg8::gemm_phase<pg8::EpiGateAddBf16, pg8::StaticOrder, true, true>(F.lds, g, S, E);
        if (BOTH(6)) GRID_BAR();
    }
    if (IN(7)) {
        pg8::Gemm g{F.Y, F.WOUT, MTOK, DM, DM, DM, DM}; pg8::StaticOrder S; S.init(MTOK, DM, F.G, (int)blockIdx.x);
        pg8::EpiResid E{F.out, F.x, DM, F.modacc, F.b_ada, 2 * DM, 6144, SEQ};
        pg8::gemm_phase<pg8::EpiResid, pg8::StaticOrder, true, true>(F.lds, g, S, E);
    }
#undef IN
#undef BOTH
}

extern "C" void kernel_launch(void* const* d_in, const int* in_sizes, int n_in, void* d_out, int out_size, void* d_ws, size_t ws_size, hipStream_t stream) {
    static int grid = 0;
    if (grid == 0) {
        if (n_in != 17 || in_sizes[0] != MTOK * DM || out_size != MTOK * DM || ws_size < WS_END) { fprintf(stderr, "kernel_launch: unexpected shapes / workspace (n_in %d, in0 %d, out %d, ws %zu, need %zu); nothing launched\n", n_in, n_in > 0 ? in_sizes[0] : -1, out_size, ws_size, (size_t)WS_END); grid = -1; return; }
        int dev = 0, cus = 0, per_cu = 0;
        if (hipGetDevice(&dev) != hipSuccess || hipDeviceGetAttribute(&cus, hipDeviceAttributeMultiprocessorCount, dev) != hipSuccess) { grid = -1; return; }
        if (hipFuncSetAttribute((const void*)skel_fwd, hipFuncAttributeMaxDynamicSharedMemorySize, LDS_BYTES) != hipSuccess) { fprintf(stderr, "kernel_launch: hipFuncSetAttribute failed\n"); grid = -1; return; }
        if (hipOccupancyMaxActiveBlocksPerMultiprocessor(&per_cu, (const void*)skel_fwd, NWAVES * 64, LDS_BYTES) != hipSuccess || per_cu < 1) { fprintf(stderr, "kernel_launch: occupancy query says %d blocks per CU\n", per_cu); per_cu = 1; }
        (void)hipGetLastError();
        grid = cus;
    }
    if (grid < 0) return;
    (void)hipMemsetAsync((char*)d_ws + WS_CTL, 0, CTL_ZERO_BYTES, stream);
    Args a{};
    for (int i = 0; i < 17; ++i) a.in[i] = d_in[i];
    a.out = (float*)d_out; a.ws = (unsigned char*)d_ws;
    for (int li = 0; li < N_LAUNCHES; ++li) {
        a.ph_lo = (N_LAUNCHES == PER_PHASE) ? li : 0; a.ph_hi = (N_LAUNCHES == PER_PHASE) ? li + 1 : PER_PHASE; a.li = (N_LAUNCHES == PER_PHASE) ? 0 : li;
        hipLaunchKernelGGL(skel_fwd, dim3(grid), dim3(NWAVES * 64), LDS_BYTES, stream, a);
    }
}
```

```cpp
#include <hip/hip_runtime.h>
#include <cstdio>
#include <cstdint>

namespace pg8 {
#define PG8_LAS __attribute__((address_space(3)))
typedef unsigned short bf16_t;
typedef short bf16x8 __attribute__((ext_vector_type(8)));
typedef float f32x4 __attribute__((ext_vector_type(4)));
typedef unsigned u32x4 __attribute__((ext_vector_type(4)));
typedef unsigned u32x2 __attribute__((ext_vector_type(2)));
constexpr int BM = 256, BK = 64, HALF = 128, HTB = HALF * BK * 2  , STAGE_BYTES = 8 * HTB, NXCD = 8, WGM = 8;

__host__ __device__ __forceinline__ int lds_byte(int r, int c) { const int st = (r >> 4) * 2 + (c >> 5), rr = r & 15, cc = c & 31, ob = rr * 64 + cc * 2; return st * 1024 + (ob ^ (((ob >> 9) & 1) << 5)); }
__host__ __device__ __forceinline__ void stage_rc(int b, int& R, int& C) { const int st = b / 1024, sb = b % 1024, swz = sb ^ (((sb >> 9) & 1) << 5); R = (st >> 1) * 16 + swz / 64; C = (st & 1) * 32 + (swz % 64) / 2; }
__host__ __device__ __forceinline__ int perm32(int rho) { const int n = rho >> 4, i = rho & 15; return 8 * (i >> 2) + 4 * n + (i & 3); }

struct Unit { int pm, pn; };
struct Gemm { const bf16_t* A; const bf16_t* Bt; int M, N, K, lda, ldb; };

struct StaticOrder {
    int nM, nN, nwg, G, c;
    __host__ __device__ void init(int M, int N, int G_, int c_) { nM = M / BM; nN = N / BM; nwg = nM * nN; G = G_; c = c_; }
    __host__ __device__ bool next(int i, Unit& u) const {
        const long L = (long)i * G + c; if (L >= nwg) return false;
        int wgid = (int)L; { const int q = nwg / NXCD, r = nwg % NXCD, xcd = wgid % NXCD, off = wgid / NXCD; wgid = (xcd < r ? xcd * (q + 1) : r * (q + 1) + (xcd - r) * q) + off; }
        const int nig = WGM * nN, gid = wgid / nig, fm = gid * WGM, gsz = (nM - fm) < WGM ? (nM - fm) : WGM;
        u.pm = fm + ((wgid % nig) % gsz); u.pn = (wgid % nig) / gsz; return true;
    }
    __device__ __forceinline__ void a_ready(const Unit&) const {}
    __device__ __forceinline__ void done(const Unit&) const {}
};

struct ListOrder {
    int mode, c, nt1, nt2;
    __host__ __device__ static void map(int nM, int nN, int L, Unit& u) {
        const int nwg = nM * nN; int wgid = L; { const int q = nwg / NXCD, r = nwg % NXCD, xcd = wgid % NXCD, off = wgid / NXCD; wgid = (xcd < r ? xcd * (q + 1) : r * (q + 1) + (xcd - r) * q) + off; }
        const int nig = WGM * nN, gid = wgid / nig, fm = gid * WGM, gsz = (nM - fm) < WGM ? (nM - fm) : WGM;
        u.pm = fm + ((wgid % nig) % gsz); u.pn = (wgid % nig) / gsz;
    }
    __host__ __device__ bool next(int i, Unit& u) const {
        int part, L;
        if (mode == 0) { if (i < 8) { part = 0; L = i * 256 + c; } else if (i == 8) { if (c < 96) { part = 0; L = 2048 + c; } else { part = 1; L = c - 96; } } else return false; }
        else { part = 1; L = 160 + i * 192 + c; if (i >= 2 || L >= 32 * nt2) return false; }
        if (part == 0) map(32, nt1, L, u); else { map(32, nt2, L, u); u.pn += nt1; }
        return true;
    }
    __device__ __forceinline__ void a_ready(const Unit&) const {}
    __device__ __forceinline__ void done(const Unit&) const {}
};

__device__ __forceinline__ unsigned cvt_pk_bf16(float lo, float hi) { unsigned r; asm volatile("v_cvt_pk_bf16_f32 %0, %1, %2" : "=v"(r) : "v"(lo), "v"(hi)); return r; }
__device__ __forceinline__ float bf_lo(unsigned w) { return __uint_as_float(w << 16); }
__device__ __forceinline__ float bf_hi(unsigned w) { return __uint_as_float(w & 0xffff0000u); }
__device__ __forceinline__ float sigmoidf_(float x) { return __builtin_amdgcn_rcpf(1.0f + __builtin_amdgcn_exp2f(-1.4426950408889634f * x)); }

struct EpiProj {
    static constexpr bool PERM = true, AFTER_DRAIN = false; static constexpr int MIDT = -1;
    bf16_t* O; int ldc; float* DBA; int pn_f32; const float* dnw;
    __device__ __forceinline__ void operator()(const f32x4 (&acc)[2][2][4][2], const Unit& u, int wr, int wc, int fr, int fq) const {
        const int row0 = u.pm * BM + wr * 64 + fr;
        if (u.pn == pn_f32) {
            if (wc < 2) {
#pragma unroll
                for (int ai = 0; ai < 2; ++ai)
#pragma unroll
                    for (int m = 0; m < 4; ++m) { float* p = DBA + (size_t)(row0 + ai * HALF + m * 16) * 64 + wc * 32 + 8 * fq;
                        *(f32x4*)p = acc[ai][0][m][0]; *(f32x4*)(p + 4) = acc[ai][0][m][1]; }
            }
            return;
        }
        const int mode = (u.pn >= 59 && u.pn < 67) ? 1 : ((u.pn >= 32 && u.pn < 48) ? 2 : (u.pn >= 67 ? 3 : 0));
        const int col0 = u.pn * BM + wc * 32 + 8 * fq;
        f32x4 w0 = {1.f, 1.f, 1.f, 1.f}, w1 = {1.f, 1.f, 1.f, 1.f};
        if (mode == 2) { w0 = *(const f32x4*)(dnw + wc * 32 + 8 * fq); w1 = *(const f32x4*)(dnw + wc * 32 + 8 * fq + 4); }
#pragma unroll
        for (int ai = 0; ai < 2; ++ai)
#pragma unroll
            for (int m = 0; m < 4; ++m) { bf16_t* rowp = O + (size_t)(row0 + ai * HALF + m * 16) * ldc + col0;
#pragma unroll
                for (int bj = 0; bj < 2; ++bj) { f32x4 v0 = acc[ai][bj][m][0], v1 = acc[ai][bj][m][1];
                    if (mode != 0) {
#pragma unroll
                        for (int e = 0; e < 4; ++e) { const float t0 = sigmoidf_(v0[e]), t1 = sigmoidf_(v1[e]);
                            v0[e] = mode == 3 ? t0 : v0[e] * t0 * w0[e]; v1[e] = mode == 3 ? t1 : v1[e] * t1 * w1[e]; }
                    }
                    u32x4 w; w.x = cvt_pk_bf16(v0[0], v0[1]); w.y = cvt_pk_bf16(v0[2], v0[3]); w.z = cvt_pk_bf16(v1[0], v1[1]); w.w = cvt_pk_bf16(v1[2], v1[3]);
                    __builtin_nontemporal_store(w, (u32x4*)(rowp + bj * HALF)); } }
    }
};
struct EpiGateF32 {
    static constexpr bool PERM = false, AFTER_DRAIN = false; static constexpr int MIDT = -1;
    float* C; int ldc; const bf16_t* G; int ldg;
    __device__ __forceinline__ void operator()(const f32x4 (&acc)[2][2][4][2], const Unit& u, int wr, int wc, int fr, int fq) const {
        const int row0 = u.pm * BM + wr * 64 + fr, col0 = u.pn * BM + wc * 32 + 4 * fq;
#pragma unroll
        for (int ai = 0; ai < 2; ++ai)
#pragma unroll
            for (int m = 0; m < 4; ++m) { const size_t r = (size_t)(row0 + ai * HALF + m * 16); float* rowp = C + r * ldc + col0; const bf16_t* gp = G + r * ldg + col0;
#pragma unroll
                for (int bj = 0; bj < 2; ++bj)
#pragma unroll
                    for (int n = 0; n < 2; ++n) { const u32x2 gw = *(const u32x2*)(gp + bj * HALF + n * 16); const f32x4 a = acc[ai][bj][m][n];
                        f32x4 o; o[0] = a[0] * bf_lo(gw.x); o[1] = a[1] * bf_hi(gw.x); o[2] = a[2] * bf_lo(gw.y); o[3] = a[3] * bf_hi(gw.y);
                        *(f32x4*)(rowp + bj * HALF + n * 16) = o; } }
    }
};
struct EpiGateAddBf16 {
    static constexpr bool PERM = true, AFTER_DRAIN = false; static constexpr int MIDT = -1;
    bf16_t* O; int ldc; const float* YA; int ldy; const bf16_t* G; int ldg;
    __device__ __forceinline__ void operator()(const f32x4 (&acc)[2][2][4][2], const Unit& u, int wr, int wc, int fr, int fq) const {
        const int row0 = u.pm * BM + wr * 64 + fr, col0 = u.pn * BM + wc * 32 + 8 * fq;
#pragma unroll
        for (int ai = 0; ai < 2; ++ai)
#pragma unroll
            for (int m = 0; m < 4; ++m) { const size_t r = (size_t)(row0 + ai * HALF + m * 16); bf16_t* rowp = O + r * ldc + col0; const float* yp = YA + r * ldy + col0; const bf16_t* gp = G + r * ldg + col0;
#pragma unroll
                for (int bj = 0; bj < 2; ++bj) { const f32x4 v0 = acc[ai][bj][m][0], v1 = acc[ai][bj][m][1];
                    const u32x4 gw = *(const u32x4*)(gp + bj * HALF); const f32x4 y0 = *(const f32x4*)(yp + bj * HALF), y1 = *(const f32x4*)(yp + bj * HALF + 4);
                    const float o0 = y0[0] + v0[0] * bf_lo(gw.x), o1 = y0[1] + v0[1] * bf_hi(gw.x), o2 = y0[2] + v0[2] * bf_lo(gw.y), o3 = y0[3] + v0[3] * bf_hi(gw.y);
                    const float o4 = y1[0] + v1[0] * bf_lo(gw.z), o5 = y1[1] + v1[1] * bf_hi(gw.z), o6 = y1[2] + v1[2] * bf_lo(gw.w), o7 = y1[3] + v1[3] * bf_hi(gw.w);
                    u32x4 w; w.x = cvt_pk_bf16(o0, o1); w.y = cvt_pk_bf16(o2, o3); w.z = cvt_pk_bf16(o4, o5); w.w = cvt_pk_bf16(o6, o7);
                    *(u32x4*)(rowp + bj * HALF) = w; } }
    }
};
struct EpiMerge {
    static constexpr bool PERM = true, AFTER_DRAIN = false; static constexpr int MIDT = 32;
    bf16_t* O; int ldc; const bf16_t* GA; const bf16_t* GB; int ldg;
    __device__ __forceinline__ void mid(f32x4 (&acc)[2][2][4][2], const Unit& u, int wr, int wc, int fr, int fq) const {
        asm volatile("" : "+v"(fr), "+v"(fq));
        const int row0 = u.pm * BM + wr * 64 + fr, col0 = u.pn * BM + wc * 32 + 8 * fq;
#pragma unroll
        for (int ai = 0; ai < 2; ++ai)
#pragma unroll
            for (int m = 0; m < 4; ++m) { const size_t r = (size_t)(row0 + ai * HALF + m * 16);
#pragma unroll
                for (int bj = 0; bj < 2; ++bj) { const u32x4 ga = *(const u32x4*)(GA + r * ldg + col0 + bj * HALF), gb = *(const u32x4*)(GB + r * ldg + col0 + bj * HALF);
                    f32x4& v0 = acc[ai][bj][m][0]; f32x4& v1 = acc[ai][bj][m][1];
                    v0[0] *= bf_lo(ga.x) * __builtin_amdgcn_rcpf(fmaxf(bf_lo(gb.x), 1e-30f)); v0[1] *= bf_hi(ga.x) * __builtin_amdgcn_rcpf(fmaxf(bf_hi(gb.x), 1e-30f));
                    v0[2] *= bf_lo(ga.y) * __builtin_amdgcn_rcpf(fmaxf(bf_lo(gb.y), 1e-30f)); v0[3] *= bf_hi(ga.y) * __builtin_amdgcn_rcpf(fmaxf(bf_hi(gb.y), 1e-30f));
                    v1[0] *= bf_lo(ga.z) * __builtin_amdgcn_rcpf(fmaxf(bf_lo(gb.z), 1e-30f)); v1[1] *= bf_hi(ga.z) * __builtin_amdgcn_rcpf(fmaxf(bf_hi(gb.z), 1e-30f));
                    v1[2] *= bf_lo(ga.w) * __builtin_amdgcn_rcpf(fmaxf(bf_lo(gb.w), 1e-30f)); v1[3] *= bf_hi(ga.w) * __builtin_amdgcn_rcpf(fmaxf(bf_hi(gb.w), 1e-30f)); }
                __builtin_amdgcn_sched_barrier(0); }
    }
    __device__ __forceinline__ void operator()(const f32x4 (&acc)[2][2][4][2], const Unit& u, int wr, int wc, int fr, int fq) const {
        const int row0 = u.pm * BM + wr * 64 + fr, col0 = u.pn * BM + wc * 32 + 8 * fq;
#pragma unroll
        for (int ai = 0; ai < 2; ++ai)
#pragma unroll
            for (int m = 0; m < 4; ++m) { const size_t r = (size_t)(row0 + ai * HALF + m * 16); bf16_t* rowp = O + r * ldc + col0;
#pragma unroll
                for (int bj = 0; bj < 2; ++bj) { const f32x4 v0 = acc[ai][bj][m][0], v1 = acc[ai][bj][m][1]; const u32x4 gb = *(const u32x4*)(GB + r * ldg + col0 + bj * HALF);
                    u32x4 w; w.x = cvt_pk_bf16(v0[0] * bf_lo(gb.x), v0[1] * bf_hi(gb.x)); w.y = cvt_pk_bf16(v0[2] * bf_lo(gb.y), v0[3] * bf_hi(gb.y));
                    w.z = cvt_pk_bf16(v1[0] * bf_lo(gb.z), v1[1] * bf_hi(gb.z)); w.w = cvt_pk_bf16(v1[2] * bf_lo(gb.w), v1[3] * bf_hi(gb.w));
                    *(u32x4*)(rowp + bj * HALF) = w; } }
    }
};
struct EpiResid {
    static constexpr bool PERM = false, AFTER_DRAIN = false; static constexpr int MIDT = -1;
    float* C; const float* X; int ldc; const float* modacc; const float* bias; int goff, modld, rows_per_batch;
    __device__ __forceinline__ void operator()(const f32x4 (&acc)[2][2][4][2], const Unit& u, int wr, int wc, int fr, int fq) const {
        const int row0 = u.pm * BM + wr * 64 + fr, col0 = u.pn * BM + wc * 32 + 4 * fq;
        const int b = (u.pm * BM) / rows_per_batch;
        f32x4 gv[2][2];
#pragma unroll
        for (int bj = 0; bj < 2; ++bj)
#pragma unroll
            for (int n = 0; n < 2; ++n) gv[bj][n] = *(const f32x4*)(modacc + (size_t)b * modld + goff + col0 + bj * HALF + n * 16) + *(const f32x4*)(bias + goff + col0 + bj * HALF + n * 16);
#pragma unroll
        for (int ai = 0; ai < 2; ++ai)
#pragma unroll
            for (int m = 0; m < 4; ++m) { const size_t off = (size_t)(row0 + ai * HALF + m * 16) * ldc + col0;
#pragma unroll
                for (int bj = 0; bj < 2; ++bj)
#pragma unroll
                    for (int n = 0; n < 2; ++n) { const f32x4 xv = __builtin_nontemporal_load((const f32x4*)(X + off + bj * HALF + n * 16)); __builtin_nontemporal_store(xv + gv[bj][n] * acc[ai][bj][m][n], (f32x4*)(C + off + bj * HALF + n * 16)); } }
    }
};

template <class Epi, class Sched, bool ALIGN_EPI = false, bool SP2 = false>
__device__ __forceinline__ void gemm_phase(PG8_LAS unsigned char* lds, const Gemm g, const Sched& S, const Epi& E) {
    const int tid = threadIdx.x, wid = __builtin_amdgcn_readfirstlane(tid >> 6), lane = tid & 63, wr = wid >> 2, wc = wid & 3, fr = lane & 15, fq = lane >> 4;
    const int K = g.K, nt = K / BK;
    unsigned voffA[2], voffB[2];
#pragma unroll
    for (int i = 0; i < 2; ++i) { int R, C; stage_rc(tid * 16 + i * 8192, R, C); const int Rb = Epi::PERM ? ((R & ~31) + perm32(R & 31)) : R;
        voffA[i] = (unsigned)(R * g.lda + C) * 2u; voffB[i] = (unsigned)(Rb * g.ldb + C) * 2u; }
    const size_t kstep = (size_t)(BK * 2);
    const size_t hstepA = (size_t)HALF * g.lda * 2, hstepB = (size_t)HALF * g.ldb * 2;
    const size_t tstepA = 2 * hstepA, tstepB = 2 * hstepB;
    const unsigned ldsw = (unsigned)wid * 1024u;
    const int aoff = lds_byte(wr * 64 + fr, fq * 8), boff = lds_byte(wc * 32 + fr, fq * 8);
#define PG8_SA(b, h) (((b) * 2 + (h)) * HTB)
#define PG8_SB(b, h) ((4 + (b) * 2 + (h)) * HTB)
#define PG8_STAGE(bufoff, gbase, voff) do { _Pragma("unroll") for (int _i = 0; _i < 2; ++_i) \
        __builtin_amdgcn_global_load_lds((const unsigned*)((const char*)(gbase) + (voff)[_i]), (PG8_LAS unsigned*)(lds + (bufoff) + ldsw + _i * 8192), 16, 0, 0); } while (0)
#define PG8_LDA(dst, b, h) do { _Pragma("unroll") for (int m = 0; m < 4; ++m) _Pragma("unroll") for (int k = 0; k < 2; ++k) dst[m][k] = *(const PG8_LAS bf16x8*)(lds + PG8_SA(b, h) + aoff + m * 2048 + k * 1024); } while (0)
#define PG8_LDB(dst, b, h) do { _Pragma("unroll") for (int n = 0; n < 2; ++n) _Pragma("unroll") for (int k = 0; k < 2; ++k) dst[n][k] = *(const PG8_LAS bf16x8*)(lds + PG8_SB(b, h) + boff + n * 2048 + k * 1024); } while (0)
#define PG8_MMA(ai, bj, At, Bt) do { __builtin_amdgcn_s_setprio(1); _Pragma("unroll") for (int m = 0; m < 4; ++m) _Pragma("unroll") for (int n = 0; n < 2; ++n) _Pragma("unroll") for (int k = 0; k < 2; ++k) \
        acc[ai][bj][m][n] = __builtin_amdgcn_mfma_f32_16x16x32_bf16(Bt[n][k], At[m][k], acc[ai][bj][m][n], 0, 0, 0); __builtin_amdgcn_s_setprio(0); } while (0)
#define PG8_WAIT_V(n) asm volatile("s_waitcnt vmcnt(" #n ")" ::: "memory")
#define PG8_WAIT_L(n) asm volatile("s_waitcnt lgkmcnt(" #n ")" ::: "memory")
#define PG8_BAR __builtin_amdgcn_s_barrier()
#define PG8_SCHED __builtin_amdgcn_sched_barrier(0)
    Unit cur, nxt; int ui = 0;
    if (!S.next(0, cur)) return;
    f32x4 acc[2][2][4][2];
#pragma unroll
    for (int a = 0; a < 2; ++a)
#pragma unroll
        for (int b = 0; b < 2; ++b)
#pragma unroll
            for (int m = 0; m < 4; ++m)
#pragma unroll
                for (int n = 0; n < 2; ++n) acc[a][b][m][n] = (f32x4){0.f, 0.f, 0.f, 0.f};
    bf16x8 At[4][2], B0[2][2], B1[2][2];
    const char* cA = (const char*)g.A + (size_t)cur.pm * tstepA; const char* cB = (const char*)g.Bt + (size_t)cur.pn * tstepB;
    S.a_ready(cur);
    if constexpr (SP2) {
        PG8_STAGE(PG8_SB(0, 0), cB, voffB); PG8_STAGE(PG8_SB(0, 1), cB + hstepB, voffB); PG8_STAGE(PG8_SA(0, 0), cA, voffA); PG8_STAGE(PG8_SA(0, 1), cA + hstepA, voffA);
        if (wr == 1) PG8_BAR;
        PG8_WAIT_V(2); PG8_BAR;
        PG8_STAGE(PG8_SB(1, 0), cB + kstep, voffB); PG8_STAGE(PG8_SA(1, 0), cA + kstep, voffA); PG8_STAGE(PG8_SB(1, 1), cB + hstepB + kstep, voffB);
        PG8_WAIT_V(6); PG8_BAR;
    } else {
        PG8_STAGE(PG8_SB(0, 0), cB, voffB); PG8_STAGE(PG8_SA(0, 0), cA, voffA); PG8_STAGE(PG8_SB(0, 1), cB + hstepB, voffB); PG8_STAGE(PG8_SA(0, 1), cA + hstepA, voffA);
        if (wr == 1) PG8_BAR;
        PG8_WAIT_V(4); PG8_BAR;
        PG8_STAGE(PG8_SB(1, 0), cB + kstep, voffB); PG8_STAGE(PG8_SA(1, 0), cA + kstep, voffA); PG8_STAGE(PG8_SB(1, 1), cB + hstepB + kstep, voffB);
        PG8_WAIT_V(6); PG8_BAR;
    }
    for (;;) {
        const bool has_next = S.next(ui + 1, nxt);
        const char* nA = has_next ? (const char*)g.A + (size_t)nxt.pm * tstepA : cA; const char* nB = has_next ? (const char*)g.Bt + (size_t)nxt.pn * tstepB : cB;
        for (int t = 0; t < nt; t += 2) {
            if constexpr (Epi::MIDT >= 0) { if (t == Epi::MIDT) E.mid(acc, cur, wr, wc, fr, fq); }
            const bool last = (t == nt - 2);
            const char* a1 = cA + (size_t)(t + 1) * kstep;
            const char* a2 = last ? nA : cA + (size_t)(t + 2) * kstep; const char* b2 = last ? nB : cB + (size_t)(t + 2) * kstep;
            const char* a3 = a2 + kstep; const char* b3 = b2 + kstep;
            if (last && has_next) S.a_ready(nxt);
            if constexpr (SP2) {
            PG8_LDB(B0, 0, 0); PG8_LDB(B1, 0, 1); PG8_SCHED; PG8_LDA(At, 0, 0); PG8_STAGE(PG8_SA(1, 1), a1 + hstepA, voffA);
            PG8_WAIT_V(8); PG8_WAIT_L(0); PG8_BAR; PG8_MMA(0, 0, At, B0); PG8_MMA(0, 1, At, B1); PG8_BAR; PG8_SCHED;
            PG8_LDA(At, 0, 1); PG8_STAGE(PG8_SB(0, 0), b2, voffB); PG8_STAGE(PG8_SB(0, 1), b2 + hstepB, voffB); PG8_STAGE(PG8_SA(0, 0), a2, voffA);
            PG8_WAIT_V(8); PG8_WAIT_L(0); PG8_BAR; PG8_MMA(1, 0, At, B0); PG8_MMA(1, 1, At, B1); PG8_BAR; PG8_SCHED;
            PG8_LDB(B0, 1, 0); PG8_LDB(B1, 1, 1); PG8_SCHED; PG8_LDA(At, 1, 0); PG8_STAGE(PG8_SA(0, 1), a2 + hstepA, voffA);
            PG8_WAIT_V(8); PG8_WAIT_L(0); PG8_BAR; PG8_MMA(0, 0, At, B0); PG8_MMA(0, 1, At, B1); PG8_BAR; PG8_SCHED;
            PG8_LDA(At, 1, 1); PG8_STAGE(PG8_SB(1, 0), b3, voffB); PG8_STAGE(PG8_SB(1, 1), b3 + hstepB, voffB); PG8_STAGE(PG8_SA(1, 0), a3, voffA);
            PG8_WAIT_V(8); PG8_WAIT_L(0); PG8_BAR; PG8_MMA(1, 0, At, B0); PG8_MMA(1, 1, At, B1); PG8_BAR; PG8_SCHED;
            } else {
            PG8_LDB(B0, 0, 0); PG8_SCHED; PG8_LDA(At, 0, 0); PG8_STAGE(PG8_SA(1, 1), a1 + hstepA, voffA);
            PG8_WAIT_L(8); PG8_BAR; PG8_WAIT_L(0); PG8_MMA(0, 0, At, B0); PG8_BAR; PG8_SCHED;
            PG8_LDB(B1, 0, 1); PG8_STAGE(PG8_SB(0, 0), b2, voffB);
            PG8_BAR; PG8_WAIT_L(0); PG8_MMA(0, 1, At, B1); PG8_BAR;
            PG8_LDA(At, 0, 1); PG8_STAGE(PG8_SA(0, 0), a2, voffA);
            PG8_BAR; PG8_WAIT_L(0); PG8_MMA(1, 0, At, B0); PG8_BAR; PG8_SCHED;
            PG8_STAGE(PG8_SB(0, 1), b2 + hstepB, voffB);
            PG8_WAIT_V(6); PG8_BAR; PG8_MMA(1, 1, At, B1); PG8_BAR;
            PG8_LDB(B0, 1, 0); PG8_SCHED; PG8_LDA(At, 1, 0); PG8_STAGE(PG8_SA(0, 1), a2 + hstepA, voffA);
            PG8_WAIT_L(8); PG8_BAR; PG8_WAIT_L(0); PG8_MMA(0, 0, At, B0); PG8_BAR; PG8_SCHED;
            PG8_LDB(B1, 1, 1); PG8_STAGE(PG8_SB(1, 0), b3, voffB);
            PG8_BAR; PG8_WAIT_L(0); PG8_MMA(0, 1, At, B1); PG8_BAR;
            PG8_LDA(At, 1, 1); PG8_STAGE(PG8_SA(1, 0), a3, voffA);
            PG8_BAR; PG8_WAIT_L(0); PG8_MMA(1, 0, At, B0); PG8_BAR; PG8_SCHED;
            PG8_STAGE(PG8_SB(1, 1), b3 + hstepB, voffB);
            PG8_WAIT_V(6); PG8_BAR; PG8_MMA(1, 1, At, B1); PG8_BAR;
            }
        }
        if constexpr (ALIGN_EPI) { if (wr == 0) PG8_BAR; }
        if constexpr (!Epi::AFTER_DRAIN) { E(acc, cur, wr, wc, fr, fq); S.done(cur); }
        if (!has_next) break;
#pragma unroll
        for (int a = 0; a < 2; ++a)
#pragma unroll
            for (int b = 0; b < 2; ++b)
#pragma unroll
                for (int m = 0; m < 4; ++m)
#pragma unroll
                    for (int n = 0; n < 2; ++n) acc[a][b][m][n] = (f32x4){0.f, 0.f, 0.f, 0.f};
        cur = nxt; cA = nA; cB = nB; ++ui;
        if constexpr (ALIGN_EPI) { if (wr == 1) PG8_BAR; }
    }
    PG8_WAIT_V(0);
    if constexpr (!ALIGN_EPI) { if (wr == 0) PG8_BAR; }
    PG8_BAR;
    if constexpr (Epi::AFTER_DRAIN) { E.fused(acc, cur, wr, wc, fr, fq, lds, wid, lane); S.done(cur); }
#undef PG8_SA
#undef PG8_SB
#undef PG8_STAGE
#undef PG8_LDA
#undef PG8_LDB
#undef PG8_MMA
#undef PG8_WAIT_V
#undef PG8_WAIT_L
#undef PG8_BAR
#undef PG8_SCHED
}
}

constexpr int NWAVES = 8;
constexpr int DM = 2048, NBATCH = 2, SEQ = 4096, MTOK = NBATCH * SEQ;
constexpr int IN_WIDTH = 21056, NP = 21248;
constexpr int C_DQKV = 0, C_DZ = 8192, C_DBA = 12288, C_AQ = 12544, C_AK = 14592, C_AV = 14848, C_AG = 15104, C_MGA = 17152, C_MGB = 19200;
constexpr int PN_DBA = C_DBA / 256;
constexpr int NT1 = 67, NT2 = 16;
static_assert(C_MGB + 2048 == NP && (NT1 + NT2) * 256 == NP && C_MGA == NT1 * 256, "proj column layout");
constexpr int KCAT = 6144;
constexpr float EPS = 1e-6f;

constexpr size_t MiB = 1u << 20;
constexpr size_t WS_CTL = 0, CTL_ZERO_BYTES = 128 * 1024;
constexpr size_t WS_MODACC = 64 * 1024;
constexpr size_t WS_WOCAT = 1 * MiB;
constexpr size_t WS_WOUT = 25 * MiB;
constexpr size_t WS_ROPE = 33 * MiB;
constexpr size_t WS_DBA = 34 * MiB;
constexpr size_t WS_PROJ = 36 * MiB;
constexpr size_t WS_A2 = 368 * MiB;
constexpr size_t WS_WTIN = 464 * MiB;
constexpr size_t WS_H = 547 * MiB;
constexpr size_t WS_Y = 579 * MiB;
constexpr size_t WS_TQV0 = 493 * MiB, WS_TQV1 = 464 * MiB, WS_TQV2 = 579 * MiB, WS_TQV3 = 608 * MiB, TQV_REGION = (size_t)1024 * 29696;
constexpr size_t WS_END = 644 * MiB;
static_assert(WS_PROJ + (size_t)MTOK * NP * 2 <= WS_A2 && WS_WTIN + (size_t)NP * DM * 2 <= WS_H && WS_TQV1 + TQV_REGION <= WS_TQV0 && WS_TQV0 + TQV_REGION <= WS_WTIN + (size_t)67 * 256 * DM * 2 && WS_TQV2 + TQV_REGION <= WS_TQV3 && WS_TQV3 + TQV_REGION <= WS_END, "d_ws map");
constexpr int CW_BAR = 1024, CW_MODCNT = 512, CW_FLAGS = 8192;

constexpr int RING_BYTES = 131072;
constexpr int LDS_BYTES = 163840;
constexpr int SMALL_OFF = 159744;
constexpr int LDSCTL_OFF = 162816, MISC_OFF = LDSCTL_OFF + 320;

#define GAS __attribute__((address_space(1)))
#define LAS __attribute__((address_space(3)))
typedef unsigned short bf16;
typedef unsigned v4u __attribute__((ext_vector_type(4)));
typedef float f32x4 __attribute__((ext_vector_type(4)));
typedef GAS unsigned gu32;
#define RLX_AGENT __ATOMIC_RELAXED, __HIP_MEMORY_SCOPE_AGENT
#define LDS_WAIT() asm volatile("s_waitcnt lgkmcnt(0)" ::: "memory")
#define VM_WAIT() asm volatile("s_waitcnt vmcnt(0)" ::: "memory")
__device__ __forceinline__ unsigned f2bf(float f) { unsigned u = __builtin_bit_cast(unsigned, f); return (u + 0x7fffu + ((u >> 16) & 1u)) >> 16; }
typedef float f32x2_t_ __attribute__((ext_vector_type(2))); typedef __bf16 bf16x2_t_ __attribute__((ext_vector_type(2)));
__device__ __forceinline__ unsigned cvtpk(float lo, float hi) { f32x2_t_ v = {lo, hi}; bf16x2_t_ b = __builtin_convertvector(v, bf16x2_t_); return __builtin_bit_cast(unsigned, b); }
__device__ __forceinline__ unsigned pk2(float lo, float hi) { return cvtpk(lo, hi); }
__device__ __forceinline__ float bf2f(bf16 v) { return __uint_as_float((unsigned)v << 16); }
__device__ __forceinline__ float blo(unsigned w) { return __uint_as_float(w << 16); }
__device__ __forceinline__ float bhi(unsigned w) { return __uint_as_float(w & 0xffff0000u); }
__device__ __forceinline__ float siluf_(float x) { return x * __builtin_amdgcn_rcpf(1.0f + __builtin_amdgcn_exp2f(-1.4426950408889634f * x)); }
__device__ __forceinline__ float sigm_(float x) { return __builtin_amdgcn_rcpf(1.0f + __builtin_amdgcn_exp2f(-1.4426950408889634f * x)); }

#define XB_TMO      128
#define XB_XCNT(j)  (256  + 64 * (j))
#define XB_XSUB(j)  (1280 + 64 * (j))
#define XB_XGEN(j)  (2304 + 64 * (j))
#define XB_TOP      3328
#define XB_TOPGEN   3392
#define XCD_BAR_WORDS 3456
#define XB_SPIN_CAP (1u << 18)

__device__ __forceinline__ unsigned xb_ld(unsigned* p)              { return __hip_atomic_load(p, __ATOMIC_RELAXED, __HIP_MEMORY_SCOPE_AGENT); }
__device__ __forceinline__ unsigned xb_add(unsigned* p, unsigned v) { return __hip_atomic_fetch_add(p, v, __ATOMIC_RELAXED, __HIP_MEMORY_SCOPE_AGENT); }
__device__ __forceinline__ unsigned xb_xcc_id() { return (unsigned)__builtin_amdgcn_s_getreg((3 << 11) | 20) & 0xFu; }
#define XB_SPIN(cond, bar) do { unsigned _sp = 0; while (cond) { __builtin_amdgcn_s_sleep(1); \
    if ((++_sp & 255u) == 0u) { if (xb_ld(&(bar)[XB_TMO])) break; if (_sp > XB_SPIN_CAP) { atomicAdd(&(bar)[XB_TMO], 1u); break; } } } } while (0)

struct XcdBarrier {
    unsigned* bar; unsigned x;
    volatile LAS unsigned* st;
};

__device__ __forceinline__ XcdBarrier xcd_barrier_post(unsigned* bar, volatile LAS unsigned* st) {
    XcdBarrier b; b.bar = bar; b.x = xb_xcc_id(); b.st = st;
    if (threadIdx.x == 0) (void)xb_add(&bar[XB_XCNT(b.x)], 1u);
    return b;
}
__device__ __forceinline__ void xcd_barrier_complete(unsigned* bar, unsigned x, unsigned& nloc, unsigned& nx) {
    const unsigned G = gridDim.x * gridDim.y * gridDim.z;
    unsigned sum, cnt, mine, sp = 0u;
    for (;;) {
        sum = 0u; cnt = 0u; mine = 0u;
#pragma unroll
        for (unsigned j = 0; j < 16; ++j) { const unsigned c = xb_ld(&bar[XB_XCNT(j)]); sum += c; cnt += (c > 0u) ? 1u : 0u; mine = (j == x) ? c : mine; }
        if (sum == G) break;
        __builtin_amdgcn_s_sleep(1);
        if ((++sp & 255u) == 0u) { if (xb_ld(&bar[XB_TMO])) break; if (sp > XB_SPIN_CAP) { atomicAdd(&bar[XB_TMO], 1u); break; } }
    }
    nloc = mine > 0u ? mine : 1u; nx = cnt > 0u ? cnt : 1u;
}

__device__ __forceinline__ void xcd_barrier(const XcdBarrier& b) {
    asm volatile("s_waitcnt vmcnt(0)" ::: "memory");
    __syncthreads();
    if (threadIdx.x == 0) {
        unsigned* bar = b.bar;
        __builtin_amdgcn_s_waitcnt(0);
        unsigned nloc = b.st[0], nx = b.st[1];
        if (nloc == 0u) { xcd_barrier_complete(bar, b.x, nloc, nx); b.st[0] = nloc; b.st[1] = nx; }
        const unsigned old = xb_add(&bar[XB_XSUB(b.x)], 1u);
        const unsigned gen = old / nloc;
        if (old + 1u == (gen + 1u) * nloc) {
            __builtin_amdgcn_fence(__ATOMIC_RELEASE, "agent");
            asm volatile("s_waitcnt vmcnt(0)" ::: "memory");
            const unsigned og = xb_add(&bar[XB_TOP], 1u);
            const unsigned tg = og / nx;
            if (og + 1u == (tg + 1u) * nx) xb_add(&bar[XB_TOPGEN], 1u);
            else XB_SPIN(xb_ld(&bar[XB_TOPGEN]) == tg, bar);
            __builtin_amdgcn_fence(__ATOMIC_ACQUIRE, "agent");
            xb_add(&bar[XB_XGEN(b.x)], 1u);
            asm volatile("s_waitcnt vmcnt(0)" ::: "memory");
        } else {
            XB_SPIN(xb_ld(&bar[XB_XGEN(b.x)]) == gen, bar);
            __builtin_amdgcn_fence(__ATOMIC_ACQUIRE, "agent");
            asm volatile("s_waitcnt vmcnt(0)" ::: "memory");
        }
    }
    __syncthreads();
}

struct Frame {
    LAS unsigned char* lds;
    volatile LAS unsigned* MISC;
    gu32* ctl;
    int tid, lane, wave;
    int vcu, G;
    const float *x, *c; const int* positions; const float *w_ada, *b_ada, *norm_w, *w_in, *q_norm_w, *k_norm_w, *sinks, *conv_w, *a_log, *dt_bias, *dn_norm_w, *w_o_swa, *w_o_dn, *w_out;
    float* out;
    float* modacc; bf16 *WTIN, *WOCAT, *WOUT, *H, *PROJ, *A2, *Y; float *ROPE, *DBA; unsigned char *KQ; unsigned char* ws;
};

__device__ __forceinline__ float wave_sum(float v) {
#pragma unroll
    for (int o = 1; o < 64; o <<= 1) v += __shfl_xor(v, o);
    return v;
}

__device__ __forceinline__ void p0_transpose_item(const float* W, int ldw, bf16* WT, int ldo, int k_off, int k0, int n_src0, int n_dst0, LAS float* scr, int lane) {
    const int c = lane & 7;
    if (n_src0 < 0) {
#pragma unroll
        for (int j = 0; j < 4; ++j) { const int n = (lane >> 3) + 8 * j; *(GAS v4u*)(WT + (size_t)(n_dst0 + n) * ldo + k_off + k0 + 8 * c) = (v4u){0u, 0u, 0u, 0u}; }
        return;
    }
#pragma unroll 8
    for (int i = 0; i < 32; ++i) { const int kk = 2 * i + (lane >> 5); scr[kk * 33 + (lane & 31)] = W[(size_t)(k0 + kk) * ldw + n_src0 + (lane & 31)]; }
    LDS_WAIT(); asm volatile("" ::: "memory");
#pragma unroll
    for (int j = 0; j < 4; ++j) { const int n = (lane >> 3) + 8 * j; const LAS float* s = scr + (8 * c) * 33 + n;
        v4u o; o.x = pk2(s[0 * 33], s[1 * 33]); o.y = pk2(s[2 * 33], s[3 * 33]); o.z = pk2(s[4 * 33], s[5 * 33]); o.w = pk2(s[6 * 33], s[7 * 33]);
        *(GAS v4u*)(WT + (size_t)(n_dst0 + n) * ldo + k_off + k0 + 8 * c) = o; }
    LDS_WAIT(); asm volatile("" ::: "memory");
}
__device__ __forceinline__ int proj_src_col(int n) {
    if (n < C_DZ) return 4608 + n;
    if (n < C_DBA) return 12800 + (n - C_DZ);
    if (n < C_DBA + 64) return 16896 + (n - C_DBA);
    if (n < C_AQ) return -1;
    if (n < C_AG) return n - C_AQ;
    if (n < C_MGA) return 2560 + (n - C_AG);
    return 16960 + (n - C_MGA);
}

__device__ __forceinline__ void p0_prologue(Frame& F) {
    LAS float* scr = (LAS float*)(F.lds + F.wave * 16384);
    const int gw = F.vcu * NWAVES + F.wave, NGW = F.G * NWAVES;
    int nmod = 0;
    for (int it = gw; it < 64 * 24; it += NGW) {
        const int kc = it / 24, cg = it % 24;
        f32x4 a0 = {0.f, 0.f, 0.f, 0.f}, a1 = {0.f, 0.f, 0.f, 0.f};
        const float* wp = F.w_ada + (size_t)(kc * 32) * 6144 + cg * 256 + F.lane * 4;
#pragma unroll 8
        for (int r = 0; r < 32; ++r) { const int k = kc * 32 + r; const float s0 = siluf_(F.c[k]), s1 = siluf_(F.c[DM + k]); const f32x4 w = *(const f32x4*)(wp + (size_t)r * 6144); a0 += s0 * w; a1 += s1 * w; }
        float* m0 = F.modacc + cg * 256 + F.lane * 4; float* m1 = m0 + 6144;
#pragma unroll
        for (int e = 0; e < 4; ++e) { atomicAdd(m0 + e, a0[e]); atomicAdd(m1 + e, a1[e]); }
        ++nmod;
    }
    if (nmod) { asm volatile("s_waitcnt vmcnt(0)" ::: "memory"); if (F.lane == 0) __hip_atomic_fetch_add((unsigned*)(F.ctl + CW_MODCNT), (unsigned)nmod, __ATOMIC_RELAXED, __HIP_MEMORY_SCOPE_AGENT); }
    {
        const int gt = (F.vcu * NWAVES + F.wave) * 64 + F.lane, NGT = NGW * 64;
        for (int idx = gt; idx < MTOK * 8; idx += NGT) {
            const int m = idx >> 3, j = idx & 7;
            const unsigned fb = j == 0 ? 0x3f800000u : j == 1 ? 0x3e4693afu : j == 2 ? 0x3d1a08c8u : j == 3 ? 0x3beef74eu : j == 4 ? 0x3ab95d22u : j == 5 ? 0x398fc8f8u : j == 6 ? 0x385f10c5u : 0x372d07a8u;
            const float ang = (float)F.positions[m] * __uint_as_float(fb);
            const double a = (double)ang;
            const double kq = __builtin_rint(a * 0.63661977236758134308);
            const double s = (a - kq * 1.57079632679489655800) - kq * 6.12323399573676603587e-17;
            const double s2 = s * s;
            const double sn = s * (1.0 + s2 * (-1.0 / 6 + s2 * (1.0 / 120 + s2 * (-1.0 / 5040 + s2 * (1.0 / 362880 + s2 * (-1.0 / 39916800 + s2 * (1.0 / 6227020800.0)))))));
            const double cs = 1.0 + s2 * (-0.5 + s2 * (1.0 / 24 + s2 * (-1.0 / 720 + s2 * (1.0 / 40320 + s2 * (-1.0 / 3628800 + s2 * (1.0 / 479001600 + s2 * (-1.0 / 87178291200.0)))))));
            const int q = ((int)kq) & 3;
            const double cv = q == 0 ? cs : q == 1 ? -sn : q == 2 ? -cs : sn;
            const double sv = q == 0 ? sn : q == 1 ? cs : q == 2 ? -sn : -cs;
            F.ROPE[(size_t)m * 16 + j] = (float)cv; F.ROPE[(size_t)m * 16 + 8 + j] = (float)sv;
        }
    }
    constexpr int I_IN = (DM / 64) * (NP / 32);
    for (int it = gw; it < I_IN; it += NGW) { const int kb = it / (NP / 32), nb = it % (NP / 32); p0_transpose_item(F.w_in, IN_WIDTH, F.WTIN, DM, 0, 64 * kb, proj_src_col(32 * nb), 32 * nb, scr, F.lane); }
}
__device__ __forceinline__ void p3_outw_convert(Frame& F, int bx0, int nb) {
    LAS float* scr = (LAS float*)(F.lds + F.wave * 16384);
    const int gw = ((int)blockIdx.x - bx0) * NWAVES + F.wave, NGW = nb * NWAVES;
    constexpr int I_OS = (DM / 64) * (DM / 32), I_OD = (4096 / 64) * (DM / 32), I_OUT = (DM / 64) * (DM / 32);
    for (int it = gw; it < I_OS + I_OD + I_OUT; it += NGW) {
        int r = it;
        if (r < I_OS) { const int kb = r / (DM / 32), nb = r % (DM / 32); p0_transpose_item(F.w_o_swa, DM, F.WOCAT, KCAT, 0, 64 * kb, 32 * nb, 32 * nb, scr, F.lane); continue; } r -= I_OS;
        if (r < I_OD) { const int kb = r / (DM / 32), nb = r % (DM / 32); p0_transpose_item(F.w_o_dn, DM, F.WOCAT, KCAT, 2048, 64 * kb, 32 * nb, 32 * nb, scr, F.lane); continue; } r -= I_OD;
        { const int kb = r / (DM / 32), nb = r % (DM / 32); p0_transpose_item(F.w_out, DM, F.WOUT, DM, 0, 64 * kb, 32 * nb, 32 * nb, scr, F.lane); }
    }
}

__device__ __forceinline__ void p1_hrows(Frame& F) {
    const int gw = F.vcu * NWAVES + F.wave, NGW = F.G * NWAVES;
    {
        unsigned spins = 0;
        while ((unsigned)__builtin_amdgcn_readfirstlane((int)__hip_atomic_load((unsigned*)(F.ctl + CW_MODCNT), __ATOMIC_RELAXED, __HIP_MEMORY_SCOPE_AGENT)) < 64u * 24u) {
            __builtin_amdgcn_s_sleep(4); if (++spins > (1u << 22)) { if (F.lane == 0) atomicAdd((unsigned*)(F.ctl + CW_BAR) + XB_TMO, 1u); break; } }
        asm volatile("" ::: "memory");
    }
    for (int m = gw; m < MTOK; m += NGW) {
        const int b = m / SEQ;
        const GAS f32x4* xr = (const GAS f32x4*)(F.x + (size_t)m * DM) + F.lane;
        f32x4 v[8]; float s = 0.f;
#pragma unroll
        for (int j = 0; j < 8; ++j) { v[j] = xr[64 * j]; s += (v[j].x * v[j].x + v[j].y * v[j].y) + (v[j].z * v[j].z + v[j].w * v[j].w); }
        const float rstd = rsqrtf(wave_sum(s) * (1.f / DM) + EPS);
        GAS unsigned long long* o8 = (GAS unsigned long long*)(F.H + (size_t)m * DM) + F.lane;
#pragma unroll
        for (int j = 0; j < 8; ++j) {
            const int col = 4 * F.lane + 256 * j;
            const f32x4 nw = *(const f32x4*)(F.norm_w + col);
            f32x4 sh, sc;
#pragma unroll
            for (int e = 0; e < 4; ++e) { sh[e] = __hip_atomic_load(F.modacc + (size_t)b * 6144 + col + e, __ATOMIC_RELAXED, __HIP_MEMORY_SCOPE_AGENT); sc[e] = __hip_atomic_load(F.modacc + (size_t)b * 6144 + DM + col + e, __ATOMIC_RELAXED, __HIP_MEMORY_SCOPE_AGENT); }
            sh += *(const f32x4*)(F.b_ada + col); sc += *(const f32x4*)(F.b_ada + DM + col);
            const f32x4 hv = (v[j] * rstd * nw) * (1.0f + sc) + sh;
            o8[64 * j] = (unsigned long long)pk2(hv.x, hv.y) | ((unsigned long long)pk2(hv.z, hv.w) << 32);
        }
    }
}

__device__ __forceinline__ void p3_attn_item_simple(Frame& F, int b, int n, int hk) {
    LAS float* Kl = (LAS float*)F.lds; LAS float* Vl = Kl + 256 * 64;
    const int tid = F.tid;
    {
        const int key = tid >> 1, half = tid & 1; const int tok = n * 128 - 128 + key;
        float kv[32], vv[32];
        if (tok >= 0) {
            const size_t row = (size_t)b * SEQ + tok;
            const v4u* kp = (const v4u*)(F.PROJ + row * NP + C_AK + hk * 64 + half * 32);
            const v4u* vp = (const v4u*)(F.PROJ + row * NP + C_AV + hk * 64 + half * 32);
#pragma unroll
            for (int i = 0; i < 4; ++i) { const v4u a = kp[i], c = vp[i];
                kv[8 * i + 0] = blo(a.x); kv[8 * i + 1] = bhi(a.x); kv[8 * i + 2] = blo(a.y); kv[8 * i + 3] = bhi(a.y); kv[8 * i + 4] = blo(a.z); kv[8 * i + 5] = bhi(a.z); kv[8 * i + 6] = blo(a.w); kv[8 * i + 7] = bhi(a.w);
                vv[8 * i + 0] = blo(c.x); vv[8 * i + 1] = bhi(c.x); vv[8 * i + 2] = blo(c.y); vv[8 * i + 3] = bhi(c.y); vv[8 * i + 4] = blo(c.z); vv[8 * i + 5] = bhi(c.z); vv[8 * i + 6] = blo(c.w); vv[8 * i + 7] = bhi(c.w); }
            float ss = 0.f;
#pragma unroll
            for (int d = 0; d < 32; ++d) ss += kv[d] * kv[d];
            ss += __shfl_xor(ss, 1);
            const float rs = rsqrtf(ss * (1.f / 64.f) + EPS);
#pragma unroll
            for (int d = 0; d < 32; ++d) kv[d] = kv[d] * rs * F.k_norm_w[half * 32 + d];
            if (half == 0) {
                const float* cs = F.ROPE + row * 16;
#pragma unroll
                for (int d = 0; d < 8; ++d) { const float x1 = kv[d], x2 = kv[8 + d], c = cs[d], s = cs[8 + d]; kv[d] = x1 * c - x2 * s; kv[8 + d] = x2 * c + x1 * s; }
            }
        } else {
#pragma unroll
            for (int d = 0; d < 32; ++d) { kv[d] = 0.f; vv[d] = 0.f; }
        }
#pragma unroll
        for (int d = 0; d < 32; d += 4) { *(LAS f32x4*)(Kl + key * 64 + half * 32 + d) = (f32x4){kv[d], kv[d + 1], kv[d + 2], kv[d + 3]}; *(LAS f32x4*)(Vl + key * 64 + half * 32 + d) = (f32x4){vv[d], vv[d + 1], vv[d + 2], vv[d + 3]}; }
    }
    __syncthreads();
    for (int pass = 0; pass < 2; ++pass) {
        const int g = (tid >> 7) + 4 * pass, i = tid & 127, h = hk * 8 + g;
        const size_t row = (size_t)b * SEQ + n * 128 + i;
        float q[64], o[64];
        {
            const v4u* qp = (const v4u*)(F.PROJ + row * NP + C_AQ + h * 64);
#pragma unroll
            for (int k = 0; k < 8; ++k) { const v4u a = qp[k];
                q[8 * k + 0] = blo(a.x); q[8 * k + 1] = bhi(a.x); q[8 * k + 2] = blo(a.y); q[8 * k + 3] = bhi(a.y); q[8 * k + 4] = blo(a.z); q[8 * k + 5] = bhi(a.z); q[8 * k + 6] = blo(a.w); q[8 * k + 7] = bhi(a.w); }
            float ss = 0.f;
#pragma unroll
            for (int d = 0; d < 64; ++d) ss += q[d] * q[d];
            const float rs = rsqrtf(ss * (1.f / 64.f) + EPS);
#pragma unroll
            for (int d = 0; d < 64; ++d) q[d] = q[d] * rs * F.q_norm_w[d];
            const float* cs = F.ROPE + row * 16;
#pragma unroll
            for (int d = 0; d < 8; ++d) { const float x1 = q[d], x2 = q[8 + d], c = cs[d], s = cs[8 + d]; q[d] = x1 * c - x2 * s; q[8 + d] = x2 * c + x1 * s; }
#pragma unroll
            for (int d = 0; d < 64; ++d) { q[d] *= 0.125f; o[d] = 0.f; }
        }
        float m = F.sinks[h], l = 1.0f;
        const int i0 = i & ~63;
        int jlo = i0 + 1, jhi = i0 + 63 + 128; if (n == 0 && jlo < 128) jlo = 128;
        for (int jj = jlo; jj <= jhi; ++jj) {
            const bool valid = (jj > i) && (jj <= i + 128);
            if (valid) {
                float s = 0.f;
#pragma unroll
                for (int d = 0; d < 64; d += 4) { const f32x4 kk = *(const LAS f32x4*)(Kl + jj * 64 + d); s += q[d] * kk.x + q[d + 1] * kk.y + q[d + 2] * kk.z + q[d + 3] * kk.w; }
                if (s > m) { const float sc = __expf(m - s); l *= sc;
#pragma unroll
                    for (int d = 0; d < 64; ++d) o[d] *= sc;
                    m = s; }
                const float p = __expf(s - m); l += p;
#pragma unroll
                for (int d = 0; d < 64; d += 4) { const f32x4 vv = *(const LAS f32x4*)(Vl + jj * 64 + d); o[d] += p * vv.x; o[d + 1] += p * vv.y; o[d + 2] += p * vv.z; o[d + 3] += p * vv.w; }
            }
        }
        const float inv = __builtin_amdgcn_rcpf(l);
        const v4u* gp = (const v4u*)(F.PROJ + row * NP + C_AG + h * 64);
        v4u* op = (v4u*)(F.A2 + row * KCAT + h * 64);
#pragma unroll
        for (int k = 0; k < 8; ++k) { const v4u a = gp[k]; v4u w;
            w.x = pk2(o[8 * k + 0] * inv * blo(a.x), o[8 * k + 1] * inv * bhi(a.x));
            w.y = pk2(o[8 * k + 2] * inv * blo(a.y), o[8 * k + 3] * inv * bhi(a.y));
            w.z = pk2(o[8 * k + 4] * inv * blo(a.z), o[8 * k + 5] * inv * bhi(a.z));
            w.w = pk2(o[8 * k + 6] * inv * blo(a.w), o[8 * k + 7] * inv * bhi(a.w));
            op[k] = w; }
    }
    __syncthreads();
}


typedef short bf16x8_t __attribute__((ext_vector_type(8)));
typedef short s16x4_t __attribute__((ext_vector_type(4)));
typedef float f32x16 __attribute__((ext_vector_type(16)));
typedef unsigned u32x2_t __attribute__((ext_vector_type(2)));
#define ACC_FRAG(X, s) __builtin_bit_cast(bf16x8_t, (v4u){cvtpk((X)[8 * (s) + 0], (X)[8 * (s) + 1]), cvtpk((X)[8 * (s) + 2], (X)[8 * (s) + 3]), cvtpk((X)[8 * (s) + 4], (X)[8 * (s) + 5]), cvtpk((X)[8 * (s) + 6], (X)[8 * (s) + 7])})
__device__ __forceinline__ s16x4_t lds_tr16(const LAS unsigned char* p) { typedef short v4i16_t __attribute__((ext_vector_type(4))); return __builtin_bit_cast(s16x4_t, __builtin_amdgcn_ds_read_tr16_b64_v4i16((LAS v4i16_t*)p)); }
#define MFMA32(A, B, C) __builtin_amdgcn_mfma_f32_32x32x16_bf16((A), (B), (C), 0, 0, 0)
struct TrAddr { unsigned a0, a1; };
__device__ __forceinline__ TrAddr tr_addr(int lane) {
    const int g16 = lane >> 4, dhalf = g16 & 1, hh = g16 >> 1, q = (lane & 15) >> 2, p = lane & 3;
    TrAddr t;
    const int cl0 = 4 * hh + q, cl1 = 8 + 4 * hh + q, sw = 4 * (p & 1) + 8 * dhalf;
    t.a0 = (unsigned)((dhalf * 64 + (p & 1) * 32 + (cl0 ^ sw)) * 16 + (p >> 1) * 8);
    t.a1 = (unsigned)((dhalf * 64 + (p & 1) * 32 + (cl1 ^ sw)) * 16 + (p >> 1) * 8);
    return t;
}
__device__ __forceinline__ bf16x8_t tr_frag(const LAS unsigned char* tile, const TrAddr& t, int ct, int s) {
    const s16x4_t lo = lds_tr16(tile + t.a0 + ct * 2048 + s * 256), hi = lds_tr16(tile + t.a1 + ct * 2048 + s * 256);
    return (bf16x8_t){lo[0], lo[1], lo[2], lo[3], hi[0], hi[1], hi[2], hi[3]};
}

__device__ __forceinline__ void p3_attn_item(Frame& F, int b, int n, int hk) {
    LAS unsigned char* Kimg = F.lds; LAS unsigned char* Vimg = F.lds + 32768;
    const int tid = F.tid, lane = F.lane;
    {
        const int key = tid >> 1, half = tid & 1; const int tok = n * 128 - 128 + key;
        const int kt = key >> 5, r = key & 31;
        float kv[32]; v4u vraw[4];
        if (tok >= 0) {
            const size_t row = (size_t)b * SEQ + tok;
            const v4u* kp = (const v4u*)(F.PROJ + row * NP + C_AK + hk * 64 + half * 32);
            const v4u* vp = (const v4u*)(F.PROJ + row * NP + C_AV + hk * 64 + half * 32);
#pragma unroll
            for (int i = 0; i < 4; ++i) { const v4u a = kp[i]; vraw[i] = vp[i];
                kv[8 * i + 0] = blo(a.x); kv[8 * i + 1] = bhi(a.x); kv[8 * i + 2] = blo(a.y); kv[8 * i + 3] = bhi(a.y); kv[8 * i + 4] = blo(a.z); kv[8 * i + 5] = bhi(a.z); kv[8 * i + 6] = blo(a.w); kv[8 * i + 7] = bhi(a.w); }
            float ss = 0.f;
#pragma unroll
            for (int d = 0; d < 32; ++d) ss += kv[d] * kv[d];
            ss += __shfl_xor(ss, 1);
            const float rs = rsqrtf(ss * (1.f / 64.f) + EPS);
#pragma unroll
            for (int d = 0; d < 32; ++d) kv[d] = kv[d] * rs * F.k_norm_w[half * 32 + d];
            if (half == 0) {
                const float* cs = F.ROPE + row * 16;
#pragma unroll
                for (int d = 0; d < 8; ++d) { const float x1 = kv[d], x2 = kv[8 + d], c = cs[d], s = cs[8 + d]; kv[d] = x1 * c - x2 * s; kv[8 + d] = x2 * c + x1 * s; }
            }
        } else {
#pragma unroll
            for (int d = 0; d < 32; ++d) kv[d] = 0.f;
#pragma unroll
            for (int i = 0; i < 4; ++i) vraw[i] = (v4u){0u, 0u, 0u, 0u};
        }
#pragma unroll
        for (int ck = 0; ck < 4; ++ck) {
            const int ks = half * 2 + (ck >> 1), h = ck & 1, e = ck & 1;
            v4u w; w.x = pk2(kv[8 * ck + 0], kv[8 * ck + 1]); w.y = pk2(kv[8 * ck + 2], kv[8 * ck + 3]); w.z = pk2(kv[8 * ck + 4], kv[8 * ck + 5]); w.w = pk2(kv[8 * ck + 6], kv[8 * ck + 7]);
            *(LAS v4u*)(Kimg + ((kt * 4 + ks) * 64 + h * 32 + r) * 16) = w;
            const int sw = 8 * (ks & 1);
            *(LAS u32x2_t*)(Vimg + ((kt * 4 + ks) * 64 + 0 * 32 + (r ^ (0 + sw))) * 16 + e * 8) = (u32x2_t){vraw[ck].x, vraw[ck].y};
            *(LAS u32x2_t*)(Vimg + ((kt * 4 + ks) * 64 + 1 * 32 + (r ^ (4 + sw))) * 16 + e * 8) = (u32x2_t){vraw[ck].z, vraw[ck].w};
        }
    }
    __syncthreads();
    const int r = lane & 31, hh = lane >> 5, g = F.wave, h = hk * 8 + g;
    const TrAddr tra = tr_addr(lane);
    const float sink = F.sinks[h];
    for (int qi = 0; qi < 4; ++qi) {
        const size_t row = (size_t)b * SEQ + n * 128 + 32 * qi + r;
        bf16x8_t qf[4];
        {
            float q[32];
#pragma unroll
            for (int ks = 0; ks < 4; ++ks) { const v4u a = *(const v4u*)(F.PROJ + row * NP + C_AQ + h * 64 + 16 * ks + 8 * hh);
                q[8 * ks + 0] = blo(a.x); q[8 * ks + 1] = bhi(a.x); q[8 * ks + 2] = blo(a.y); q[8 * ks + 3] = bhi(a.y); q[8 * ks + 4] = blo(a.z); q[8 * ks + 5] = bhi(a.z); q[8 * ks + 6] = blo(a.w); q[8 * ks + 7] = bhi(a.w); }
            float ss = 0.f;
#pragma unroll
            for (int d = 0; d < 32; ++d) ss += q[d] * q[d];
            ss += __shfl_xor(ss, 32);
            const float rs = rsqrtf(ss * (1.f / 64.f) + EPS);
#pragma unroll
            for (int ks = 0; ks < 4; ++ks)
#pragma unroll
                for (int j = 0; j < 8; ++j) q[8 * ks + j] = q[8 * ks + j] * rs * F.q_norm_w[16 * ks + 8 * hh + j];
            const float* cs = F.ROPE + row * 16;
#pragma unroll
            for (int j = 0; j < 8; ++j) { const float own = q[j], oth = __shfl_xor(own, 32), c = cs[j], s = cs[8 + j]; q[j] = own * c + (hh ? oth * s : -oth * s); }
#pragma unroll
            for (int ks = 0; ks < 4; ++ks) { v4u w; w.x = pk2(q[8 * ks + 0] * 0.125f, q[8 * ks + 1] * 0.125f); w.y = pk2(q[8 * ks + 2] * 0.125f, q[8 * ks + 3] * 0.125f); w.z = pk2(q[8 * ks + 4] * 0.125f, q[8 * ks + 5] * 0.125f); w.w = pk2(q[8 * ks + 6] * 0.125f, q[8 * ks + 7] * 0.125f);
                qf[ks] = __builtin_bit_cast(bf16x8_t, w); }
        }
        f32x16 st[5];
#pragma unroll
        for (int kp = 0; kp < 5; ++kp) {
            const int kt = qi + kp; f32x16 acc = {};
#pragma unroll
            for (int ks = 0; ks < 4; ++ks) { const bf16x8_t kf = *(const LAS bf16x8_t*)(Kimg + ((kt * 4 + ks) * 64 + lane) * 16); acc = MFMA32(kf, qf[ks], acc); }
            st[kp] = acc;
        }
        const int iq = 32 * qi + r;
        float m = sink;
#pragma unroll
        for (int kp = 0; kp < 5; ++kp)
#pragma unroll
            for (int reg = 0; reg < 16; ++reg) { const int j = 32 * (qi + kp) + (reg & 3) + 8 * (reg >> 2) + 4 * hh;
                const bool valid = (j > iq) && (j <= iq + 128) && (n > 0 || j >= 128);
                const float s = valid ? st[kp][reg] : -1e30f; st[kp][reg] = s; m = fmaxf(m, s); }
        m = fmaxf(m, __shfl_xor(m, 32));
        float l = 0.f;
#pragma unroll
        for (int kp = 0; kp < 5; ++kp)
#pragma unroll
            for (int reg = 0; reg < 16; ++reg) { const float p = __expf(st[kp][reg] - m); st[kp][reg] = p; l += p; }
        l += __shfl_xor(l, 32);
        l += __expf(sink - m);
        f32x16 ot[2];
#pragma unroll
        for (int mt = 0; mt < 2; ++mt) { f32x16 acc = {};
#pragma unroll
            for (int kp = 0; kp < 5; ++kp)
#pragma unroll
                for (int s = 0; s < 2; ++s) { const bf16x8_t vf = tr_frag(Vimg + (qi + kp) * 4096, tra, mt, s); acc = MFMA32(vf, ACC_FRAG(st[kp], s), acc); }
            ot[mt] = acc; }
        const float inv = __builtin_amdgcn_rcpf(l);
#pragma unroll
        for (int mt = 0; mt < 2; ++mt)
#pragma unroll
            for (int gg = 0; gg < 4; ++gg) { const int d = 32 * mt + 8 * gg + 4 * hh;
                const u32x2_t gw = *(const u32x2_t*)(F.PROJ + row * NP + C_AG + h * 64 + d);
                u32x2_t w; w.x = pk2(ot[mt][4 * gg + 0] * inv * blo(gw.x), ot[mt][4 * gg + 1] * inv * bhi(gw.x));
                w.y = pk2(ot[mt][4 * gg + 2] * inv * blo(gw.y), ot[mt][4 * gg + 3] * inv * bhi(gw.y));
                *(u32x2_t*)(F.A2 + row * KCAT + h * 64 + d) = w; }
    }
    __syncthreads();
}


__device__ __forceinline__ unsigned char* tqv_rec(const Frame& F, int b, int h, int n) {
    const int bh = b * 32 + h, reg = bh >> 4;
    const size_t base = reg == 0 ? WS_TQV0 : (reg == 1 ? WS_TQV1 : (reg == 2 ? WS_TQV2 : WS_TQV3));
    return F.ws + base + ((size_t)(bh & 15) * 64 + n) * 29696;
}
__device__ __forceinline__ void st16_wt(void* p, v4u v) { asm volatile("global_store_dwordx4 %0, %1, off sc0 sc1\n\ts_nop 1" :: "v"(p), "v"(v) : "memory"); }
__device__ __forceinline__ void st4_wt(float* p, float v) { __hip_atomic_store(p, v, __ATOMIC_RELAXED, __HIP_MEMORY_SCOPE_AGENT); }
constexpr int KQ_BYTES = 32768, TQV_BYTES = 29696, TQV_TB = 0, TQV_QK = 6144, TQV_VT = 12288, TQV_VEC = 28672;
constexpr int STAGE_BYTES_DN = KQ_BYTES + TQV_BYTES;
constexpr int OBUF_OFF = 2 * STAGE_BYTES_DN, OBUF_PITCH = 272, OBUF_BYTES = 64 * OBUF_PITCH;

__host__ __device__ constexpr int lt_rowoff(int s) { const int j = (s + 1) >> 2; return j == 0 ? 64 * s : (192 + 256 * (j - 1) - 8 * j * (j - 1)) + (s - (4 * j - 1)) * (64 - 4 * j); }
constexpr int LT_FLOATS = 2112;
static_assert(lt_rowoff(62) + 4 <= LT_FLOATS && lt_rowoff(3) == 192 && lt_rowoff(2) == 128, "packed LT layout");

__device__ __forceinline__ void fnma_(float& acc, float a, float b) { asm("v_fma_f32 %0, -%1, %2, %0" : "+v"(acc) : "v"(a), "v"(b)); }
template <int S_> struct SubstRow {
    static __device__ __forceinline__ void run(float (&X)[64], const LAS float* LT, int lane) {
        constexpr int C0 = ((S_ + 1) / 4) * 4;
        constexpr int NG = (64 - C0) / 4;
        float a0 = (lane == S_) ? 1.0f : 0.0f, a1 = 0.f, a2 = 0.f, a3 = 0.f;
#pragma unroll
        for (int i0 = 0; i0 < NG; i0 += 8) {
            f32x4 l4[8];
#pragma unroll
            for (int i = 0; i < 8; ++i) if (i0 + i < NG) l4[i] = *(const LAS f32x4*)(LT + lt_rowoff(S_) + 4 * (i0 + i));
            __builtin_amdgcn_sched_barrier(0);
#pragma unroll
            for (int i = 0; i < 8; ++i) if (i0 + i < NG) { const int c4 = C0 + 4 * (i0 + i);
                if (c4 + 0 > S_) fnma_(a0, X[c4 + 0], l4[i].x);
                if (c4 + 1 > S_) fnma_(a1, X[c4 + 1], l4[i].y);
                if (c4 + 2 > S_) fnma_(a2, X[c4 + 2], l4[i].z);
                if (c4 + 3 > S_) fnma_(a3, X[c4 + 3], l4[i].w);
            }
        }
        X[S_] = (a0 + a1) + (a2 + a3);
        if constexpr (S_ > 0) SubstRow<S_ - 1>::run(X, LT, lane);
    }
};

constexpr int P3A_VT = 32768, P3A_LT = 65536, P3A_VEC = P3A_LT + 8 * LT_FLOATS * 4;
static_assert(P3A_VEC + 4096 <= 159744, "P3a LDS map");
__device__ __forceinline__ void p3a_phase(Frame& F, int jblk, int nblk) {
    LAS unsigned char* KNimg = F.lds; LAS unsigned char* QNimg = F.lds + 16384; LAS unsigned char* VTst = F.lds + P3A_VT;
    LAS float* LTall = (LAS float*)(F.lds + P3A_LT);
    LAS float* betaL = (LAS float*)(F.lds + P3A_VEC);
    LAS float* gcL = betaL + 512;
    const int w = F.wave;
    const int nunits = (512 - jblk + nblk - 1) / nblk;
    v4u raw[11];
#define P3A_LOADRAW(u_, kk_) do { const int b_ = ((u_) >> 2) & 1, n_ = (u_) >> 3, kh_ = ((u_) & 3) * 4 + (kk_); int ln_ = F.lane; asm volatile("" : "+v"(ln_)); \
        const int wch_ = ln_ < 16 ? kh_ * 128 + ln_ * 8 : (ln_ < 32 ? 2048 + kh_ * 128 + (ln_ - 16) * 8 : 4096 + kh_ * 256 + (ln_ - 32) * 8); \
        _Pragma("unroll") for (int i_ = 0; i_ < 11; ++i_) { const int tt_ = n_ * 64 + 8 * w - 3 + i_; \
            raw[i_] = tt_ >= 0 ? *(const v4u*)(F.PROJ + ((size_t)b_ * SEQ + tt_) * NP + C_DQKV + wch_) : (v4u){0u, 0u, 0u, 0u}; } } while (0)
    if (nunits > 0) P3A_LOADRAW(jblk, 0);
    for (int ui = 0; ui < nunits; ++ui) {
        const int u = jblk + ui * nblk, b = (u >> 2) & 1, n = u >> 3, kq = u & 3;
        const int t0 = n * 64;
        for (int kk = 0; kk < 4; ++kk) {
            int lane = F.lane; asm volatile("" : "+v"(lane));
            const int r = lane & 31, hh = lane >> 5;
            const int kh = kq * 4 + kk;
            {
                const int wch = lane < 16 ? kh * 128 + lane * 8 : (lane < 32 ? 2048 + kh * 128 + (lane - 16) * 8 : 4096 + kh * 256 + (lane - 32) * 8);
                float cw[4][8];
#pragma unroll
                for (int j = 0; j < 4; ++j) { const f32x4 a = *(const f32x4*)(F.conv_w + j * 8192 + wch), c = *(const f32x4*)(F.conv_w + j * 8192 + wch + 4);
                    cw[j][0] = a.x; cw[j][1] = a.y; cw[j][2] = a.z; cw[j][3] = a.w; cw[j][4] = c.x; cw[j][5] = c.y; cw[j][6] = c.z; cw[j][7] = c.w; }
                const float qs = lane < 16 ? 0.08838834764831845f : 1.0f;
                const int l16 = lane & 15, ks = l16 >> 1, odd = l16 & 1, mi = w >> 2;
                const bool isk = lane >= 16;
                LAS unsigned char* img = isk ? KNimg : QNimg;
                unsigned vpk[4][8];
#pragma unroll
                for (int tp = 0; tp < 4; ++tp) {
                    float y[2][8];
#pragma unroll
                    for (int uu = 0; uu < 2; ++uu) { const int t = 2 * tp + uu;
#pragma unroll
                        for (int e = 0; e < 8; ++e) y[uu][e] = 0.f;
#pragma unroll
                        for (int j = 0; j < 4; ++j) { const v4u a = raw[t + j];
                            y[uu][0] += cw[j][0] * blo(a.x); y[uu][1] += cw[j][1] * bhi(a.x); y[uu][2] += cw[j][2] * blo(a.y); y[uu][3] += cw[j][3] * bhi(a.y);
                            y[uu][4] += cw[j][4] * blo(a.z); y[uu][5] += cw[j][5] * bhi(a.z); y[uu][6] += cw[j][6] * blo(a.w); y[uu][7] += cw[j][7] * bhi(a.w); }
                        float ss = 0.f;
#pragma unroll
                        for (int e = 0; e < 8; ++e) { y[uu][e] = siluf_(y[uu][e]); ss += y[uu][e] * y[uu][e]; }
                        ss += __shfl_xor(ss, 1); ss += __shfl_xor(ss, 2); ss += __shfl_xor(ss, 4); ss += __shfl_xor(ss, 8);
                        const float sc = lane < 32 ? rsqrtf(ss + EPS) * qs : 1.0f;
#pragma unroll
                        for (int e = 0; e < 8; ++e) y[uu][e] *= sc;
                        if (lane < 32) {
                            const int rr = 8 * (w & 3) + t;
                            const u32x2_t p0 = {pk2(y[uu][0], y[uu][1]), pk2(y[uu][2], y[uu][3])}, p1 = {pk2(y[uu][4], y[uu][5]), pk2(y[uu][6], y[uu][7])};
                            const int sw = isk ? 8 * (ks & 1) : 0;
                            const int o0 = ((mi * 8 + ks) * 64 + 0 * 32 + (rr ^ sw)) * 16 + 8 * odd, o1 = ((mi * 8 + ks) * 64 + 1 * 32 + (rr ^ (isk ? 4 + sw : 0))) * 16 + 8 * odd;
                            *(LAS u32x2_t*)(img + o0) = p0; *(LAS u32x2_t*)(img + o1) = p1;
                        }
                    }
#pragma unroll
                    for (int e = 0; e < 8; ++e) vpk[tp][e] = pk2(y[0][e], y[1][e]);
                    asm volatile("" ::: "memory");
                }
                if (lane >= 32) {
                    LAS unsigned char* vt = VTst + ((lane - 32) >> 4) * 16384 + (w * 128 + ((lane - 32) & 15) * 8) * 16;
#pragma unroll
                    for (int e = 0; e < 8; ++e) *(LAS v4u*)(vt + e * 16) = (v4u){vpk[0][e], vpk[1][e], vpk[2][e], vpk[3][e]};
                }
            }
            if (kk < 3) P3A_LOADRAW(u, kk + 1); else if (ui + 1 < nunits) P3A_LOADRAW(u + nblk, 0);
            if (w < 2) {
                const int hv = 2 * kh + w, hs = kk * 2 + w; const size_t row = (size_t)b * SEQ + t0 + lane;
                const float db = F.DBA[row * 64 + hv], da = F.DBA[row * 64 + 32 + hv];
                const float xx = da + F.dt_bias[hv]; const float sp = xx > 20.f ? xx : log1pf(__expf(xx));
                float gc = -__expf(F.a_log[hv]) * sp;
#pragma unroll
                for (int off = 1; off < 64; off <<= 1) { const float t = __shfl_up(gc, off); if (lane >= off) gc += t; }
                const float gl = __shfl(gc, 63);
                betaL[hs * 64 + lane] = sigm_(db); gcL[hs * 64 + lane] = gc;
                float* vec = (float*)(tqv_rec(F, b, hv, n) + TQV_VEC);
                st4_wt(vec + lane, __expf(gc)); st4_wt(vec + 64 + lane, __expf(gl - gc));
            }
            __syncthreads();
            if ((w & 3) < 3) {
                const int tsel = w & 3;
                const bool isqk = w >= 4;
                const int rt = isqk ? (tsel == 2 ? 1 : 0) : (tsel == 0 ? 0 : 1);
                const int ct = isqk ? (tsel == 0 ? 0 : 1) : (tsel == 2 ? 1 : 0);
                f32x16 acc = {};
                const int posE = hh * 32 + (r ^ (4 * hh)), posO = hh * 32 + (r ^ (4 * hh + 8));
#pragma unroll
                for (int ks = 0; ks < 8; ++ks) {
                    const bf16x8_t a = *(const LAS bf16x8_t*)(KNimg + ((rt * 8 + ks) * 64 + ((ks & 1) ? posO : posE)) * 16);
                    const bf16x8_t bb = isqk ? *(const LAS bf16x8_t*)(QNimg + ((ct * 8 + ks) * 64 + lane) * 16) : *(const LAS bf16x8_t*)(KNimg + ((ct * 8 + ks) * 64 + ((ks & 1) ? posO : posE)) * 16);
                    acc = MFMA32(a, bb, acc);
                }
#pragma unroll
                for (int h2 = 0; h2 < 2; ++h2) {
                    const int hs = kk * 2 + h2, hv = 2 * kh + h2;
                    const float gcol = gcL[hs * 64 + 32 * ct + r];
                    if (!isqk) {
                        const int s = 32 * ct + r, c0s = 4 * ((s + 1) >> 2); LAS float* ltrow = LTall + hs * LT_FLOATS + lt_rowoff(s) - c0s;
#pragma unroll
                        for (int g = 0; g < 4; ++g) { const int c0 = 32 * rt + 8 * g + 4 * hh;
                            const f32x4 gr = *(const LAS f32x4*)(gcL + hs * 64 + c0), br = *(const LAS f32x4*)(betaL + hs * 64 + c0); f32x4 o;
                            o.x = (c0 + 0 > s) ? br.x * acc[4 * g + 0] * __expf(gr.x - gcol) : 0.f; o.y = (c0 + 1 > s) ? br.y * acc[4 * g + 1] * __expf(gr.y - gcol) : 0.f;
                            o.z = (c0 + 2 > s) ? br.z * acc[4 * g + 2] * __expf(gr.z - gcol) : 0.f; o.w = (c0 + 3 > s) ? br.w * acc[4 * g + 3] * __expf(gr.w - gcol) : 0.f;
                            if (c0 >= c0s) *(LAS f32x4*)(ltrow + c0) = o; }
                    } else {
                        const int c = 32 * ct + r; f32x16 m;
#pragma unroll
                        for (int g = 0; g < 4; ++g) { const int s0 = 32 * rt + 8 * g + 4 * hh; const f32x4 gr = *(const LAS f32x4*)(gcL + hs * 64 + s0);
                            m[4 * g + 0] = (s0 + 0 <= c) ? acc[4 * g + 0] * __expf(gcol - gr.x) : 0.f; m[4 * g + 1] = (s0 + 1 <= c) ? acc[4 * g + 1] * __expf(gcol - gr.y) : 0.f;
                            m[4 * g + 2] = (s0 + 2 <= c) ? acc[4 * g + 2] * __expf(gcol - gr.z) : 0.f; m[4 * g + 3] = (s0 + 3 <= c) ? acc[4 * g + 3] * __expf(gcol - gr.w) : 0.f; }
                        unsigned char* qk = tqv_rec(F, b, hv, n) + TQV_QK;
                        const int blk0 = (ct == 0 ? 0 : 2) + 2 * rt;
                        st16_wt(qk + ((blk0 + 0) * 64 + lane) * 16, __builtin_bit_cast(v4u, ACC_FRAG(m, 0)));
                        st16_wt(qk + ((blk0 + 1) * 64 + lane) * 16, __builtin_bit_cast(v4u, ACC_FRAG(m, 1)));
                    }
                }
            } else if (w == 3) {
                unsigned char* kqrec = F.KQ + ((size_t)(b * 16 + kh) * 64 + n) * KQ_BYTES;
#pragma unroll 8
                for (int i = 0; i < 32; ++i) st16_wt(kqrec + (i * 64 + lane) * 16, *(const LAS v4u*)(F.lds + (i * 64 + lane) * 16));
            } else {
#pragma unroll
                for (int h2 = 0; h2 < 2; ++h2) { unsigned char* vt = tqv_rec(F, b, 2 * kh + h2, n) + TQV_VT;
#pragma unroll 8
                    for (int i = 0; i < 16; ++i) st16_wt(vt + (i * 64 + lane) * 16, *(const LAS v4u*)(VTst + h2 * 16384 + (i * 64 + lane) * 16)); }
            }
            __syncthreads();
        }
        {
            int lane = F.lane; asm volatile("" : "+v"(lane));
            const int r = lane & 31;
            const int hs = w, hv = 2 * (kq * 4 + (w >> 1)) + (w & 1);
            float X[64];
            SubstRow<63>::run(X, LTall + hs * LT_FLOATS, lane);
            unsigned char* tb = tqv_rec(F, b, hv, n) + TQV_TB;
            const int mi2 = lane >> 5;
#pragma unroll
            for (int ks2 = 0; ks2 < 4; ++ks2) {
                if (mi2 == 1 || ks2 < 2) {
#pragma unroll
                    for (int h2 = 0; h2 < 2; ++h2) { const int c0 = 16 * ks2 + 4 * h2;
                        const f32x4 b0 = *(const LAS f32x4*)(betaL + hs * 64 + c0), b1 = *(const LAS f32x4*)(betaL + hs * 64 + c0 + 8);
                        v4u c; c.x = pk2(X[c0 + 0] * b0.x, X[c0 + 1] * b0.y); c.y = pk2(X[c0 + 2] * b0.z, X[c0 + 3] * b0.w); c.z = pk2(X[c0 + 8] * b1.x, X[c0 + 9] * b1.y); c.w = pk2(X[c0 + 10] * b1.z, X[c0 + 11] * b1.w);
                        st16_wt(tb + (((mi2 == 0 ? 0 : 2) + ks2) * 64 + h2 * 32 + r) * 16, c); }
                }
            }
        }
        asm volatile("s_waitcnt vmcnt(0)" ::: "memory");
        __syncthreads();
        if (F.tid == 0) __hip_atomic_store((unsigned*)(F.ctl + CW_FLAGS) + (b * 64 + n) * 4 + kq, 1u, __ATOMIC_RELAXED, __HIP_MEMORY_SCOPE_AGENT);
    }
#undef P3A_LOADRAW
}

__device__ __forceinline__ void glds16(const unsigned char* gsrc, LAS unsigned char* ldst) { __builtin_amdgcn_global_load_lds((const unsigned*)gsrc, (LAS unsigned*)ldst, 16, 0, 16); }

__device__ __forceinline__ void p3b_scan(Frame& F, int b, int h) {
    const int lane = F.lane, w = F.wave, r = lane & 31, hh = lane >> 5, kh = h >> 1;
    const unsigned char* kqbase = F.KQ + (size_t)(b * 16 + kh) * 64 * KQ_BYTES;
    const unsigned char* tqvbase = tqv_rec(F, b, h, 0);
    constexpr int NCH = SEQ / 64;
    if (w >= 4) {
        __builtin_amdgcn_s_setprio(3);
        const int hw = w - 4, row = 16 * hw + (lane >> 2), q4 = lane & 3;
        const size_t grow0 = (size_t)b * SEQ + row;
        const bf16* gzp = F.PROJ + grow0 * NP + C_DZ + h * 128 + q4 * 32;
        bf16* outp = F.A2 + grow0 * KCAT + 2048 + h * 128 + q4 * 32;
#define DN_ISSUE(nn) do { LAS unsigned char* dst_ = F.lds + ((nn) & 1) * STAGE_BYTES_DN + hw * 1024; \
            const unsigned char* s0_ = kqbase + (size_t)(nn) * KQ_BYTES + hw * 1024 + lane * 16; const unsigned char* s1_ = tqvbase + (size_t)(nn) * TQV_BYTES + hw * 1024 + lane * 16; \
            _Pragma("unroll") for (int i_ = 0; i_ < 8; ++i_) glds16(s0_ + i_ * 4096, dst_ + i_ * 4096); \
            _Pragma("unroll") for (int i_ = 0; i_ < 8; ++i_) if (hw + 4 * i_ < 29) glds16(s1_ + i_ * 4096, dst_ + 32768 + i_ * 4096); } while (0)
#define DN_GZLOAD(G, nn) do { const bf16* gp_ = gzp + (size_t)(nn) * 64 * NP; \
            asm volatile("global_load_dwordx4 %0, %4, off\n\tglobal_load_dwordx4 %1, %4, off offset:16\n\tglobal_load_dwordx4 %2, %4, off offset:32\n\tglobal_load_dwordx4 %3, %4, off offset:48" \
                : "=&v"(G[0]), "=&v"(G[1]), "=&v"(G[2]), "=&v"(G[3]) : "v"(gp_) : "memory"); } while (0)
#define DN_OUT(G, nn) do { const LAS unsigned char* ob_ = F.lds + OBUF_OFF + ((nn) & 1) * OBUF_BYTES + row * OBUF_PITCH + q4 * 64; \
            v4u ov_[4]; float ss_ = 0.f; \
            _Pragma("unroll") for (int i_ = 0; i_ < 4; ++i_) { ov_[i_] = *(const LAS v4u*)(ob_ + i_ * 16); \
                const float a0_ = blo(ov_[i_].x), a1_ = bhi(ov_[i_].x), a2_ = blo(ov_[i_].y), a3_ = bhi(ov_[i_].y), a4_ = blo(ov_[i_].z), a5_ = bhi(ov_[i_].z), a6_ = blo(ov_[i_].w), a7_ = bhi(ov_[i_].w); \
                ss_ += (a0_ * a0_ + a1_ * a1_) + (a2_ * a2_ + a3_ * a3_) + (a4_ * a4_ + a5_ * a5_) + (a6_ * a6_ + a7_ * a7_); } \
            ss_ += __shfl_xor(ss_, 1); ss_ += __shfl_xor(ss_, 2); \
            const float rs_ = rsqrtf(ss_ * (1.f / 128.f) + EPS); \
            v4u* op_ = (v4u*)(outp + (size_t)(nn) * 64 * KCAT); \
            _Pragma("unroll") for (int i_ = 0; i_ < 4; ++i_) { const v4u a_ = ov_[i_], g_ = G[i_]; v4u o_; \
                o_.x = pk2(blo(a_.x) * rs_ * blo(g_.x), bhi(a_.x) * rs_ * bhi(g_.x)); o_.y = pk2(blo(a_.y) * rs_ * blo(g_.y), bhi(a_.y) * rs_ * bhi(g_.y)); \
                o_.z = pk2(blo(a_.z) * rs_ * blo(g_.z), bhi(a_.z) * rs_ * bhi(g_.z)); o_.w = pk2(blo(a_.w) * rs_ * blo(g_.w), bhi(a_.w) * rs_ * bhi(g_.w)); op_[i_] = o_; } } while (0)
#define DN_ENDSTEP(G, WAITSTR) do { asm volatile(WAITSTR : "+v"(G[0]), "+v"(G[1]), "+v"(G[2]), "+v"(G[3]) :: "memory"); \
            __builtin_amdgcn_s_barrier(); asm volatile("" ::: "memory"); } while (0)
        v4u gA[4], gB[4];
#pragma unroll
        for (int i = 0; i < 4; ++i) { gA[i] = (v4u){0u, 0u, 0u, 0u}; gB[i] = (v4u){0u, 0u, 0u, 0u}; }
        {
            const unsigned* fl = (const unsigned*)(F.ctl + CW_FLAGS) + (b * 64 + lane) * 4 + (h >> 3); unsigned sp = 0;
            while (!__all(__hip_atomic_load(fl, __ATOMIC_RELAXED, __HIP_MEMORY_SCOPE_AGENT) != 0u)) { __builtin_amdgcn_s_sleep(16); if (++sp > (1u << 19)) { if (lane == 0) atomicAdd((unsigned*)(F.ctl + CW_BAR) + XB_TMO, 1u); break; } }
            asm volatile("" ::: "memory");
        }
        DN_ISSUE(0);
        DN_ENDSTEP(gA, "s_waitcnt vmcnt(0) lgkmcnt(0)");
        DN_ISSUE(1); DN_GZLOAD(gA, 0); DN_ENDSTEP(gA, "s_waitcnt vmcnt(0) lgkmcnt(0)");
        for (int n = 1; n + 1 < NCH; n += 2) {
            DN_ISSUE(n + 1); DN_GZLOAD(gB, n); DN_OUT(gA, n - 1); DN_ENDSTEP(gB, "s_waitcnt vmcnt(4) lgkmcnt(0)");
            if (n + 2 < NCH) DN_ISSUE(n + 2); DN_GZLOAD(gA, n + 1); DN_OUT(gB, n); DN_ENDSTEP(gA, "s_waitcnt vmcnt(4) lgkmcnt(0)");
        }
        DN_GZLOAD(gB, NCH - 1); DN_OUT(gA, NCH - 2); DN_ENDSTEP(gB, "s_waitcnt vmcnt(4) lgkmcnt(0)");
        DN_OUT(gB, NCH - 1);
        __builtin_amdgcn_s_setprio(0);
#undef DN_ISSUE
#undef DN_GZLOAD
#undef DN_OUT
#undef DN_ENDSTEP
    } else {
        const int n0 = 32 * w;
        f32x16 S[4];
#pragma unroll
        for (int d = 0; d < 4; ++d) S[d] = (f32x16){};
        __builtin_amdgcn_s_barrier(); asm volatile("" ::: "memory");
#define SB_() __builtin_amdgcn_sched_barrier(0)
        for (int n = 0; n < NCH; ++n) {
            int lane = F.lane; asm volatile("" : "+v"(lane));
            const int r = lane & 31, hh = lane >> 5;
            const int posE = (hh * 32 + (r ^ (4 * hh))) * 16, posO = (hh * 32 + (r ^ (4 * hh + 8))) * 16;
            const LAS unsigned char* st = F.lds + (n & 1) * STAGE_BYTES_DN;
            const LAS unsigned char* tq = st + KQ_BYTES;
            const LAS float* egp = (const LAS float*)(tq + TQV_VEC);
            const LAS unsigned char* vtp = tq + TQV_VT + (n0 + r) * 16 + hh * 8;
#define KNF(i) (*(const LAS bf16x8_t*)(st + (i) * 1024 + (((i) & 1) ? posO : posE)))
#define QNF(i) (*(const LAS bf16x8_t*)(st + 16384 + (i) * 1024 + lane * 16))
#define TBF(i) (*(const LAS bf16x8_t*)(tq + TQV_TB + ((i) * 64 + lane) * 16))
#define QKF(i) (*(const LAS bf16x8_t*)(tq + TQV_QK + ((i) * 64 + lane) * 16))
            bf16x8_t W[8];
#pragma unroll
            for (int i = 0; i < 8; ++i) W[i] = KNF(i);
            bf16x8_t Sb[4][2];
#pragma unroll
            for (int d = 0; d < 4; ++d) { Sb[d][0] = ACC_FRAG(S[d], 0); Sb[d][1] = ACC_FRAG(S[d], 1); }
            SB_();
            f32x16 x[2] = {(f32x16){}, (f32x16){}}, o[2] = {(f32x16){}, (f32x16){}};
            f32x4 e4q[4]; u32x2_t vvq[4];
#pragma unroll
            for (int i = 0; i < 16; ++i) {
                x[i >> 3] = MFMA32(W[i & 7], Sb[(i & 7) >> 1][i & 1], x[i >> 3]);
                W[i & 7] = i < 8 ? KNF(i + 8) : QNF(i - 8);
                if (i >= 12) { const int g = i - 12; e4q[g] = *(const LAS f32x4*)(egp + 8 * g + 4 * hh); vvq[g] = *(const LAS u32x2_t*)(vtp + (g * 128) * 16); }
                SB_();
            }
            bf16x8_t Xb[2][2], T[6];
#pragma unroll
            for (int i = 0; i < 16; ++i) {
                o[i >> 3] = MFMA32(W[i & 7], Sb[(i & 7) >> 1][i & 1], o[i >> 3]);
                if (i < 8) W[i & 7] = QNF(i + 8); else if (i < 14) T[i - 8] = TBF(i - 8);
                if (i < 8) { const int mi = i >> 2, g = i & 3; const f32x4 e4 = e4q[g]; const u32x2_t vv = vvq[g];
                    if (i < 4) { e4q[g] = *(const LAS f32x4*)(egp + 32 + 8 * g + 4 * hh); vvq[g] = *(const LAS u32x2_t*)(vtp + ((4 + g) * 128) * 16); }
                    x[mi][4 * g + 0] = blo(vv.x) - e4.x * x[mi][4 * g + 0]; x[mi][4 * g + 1] = bhi(vv.x) - e4.y * x[mi][4 * g + 1];
                    x[mi][4 * g + 2] = blo(vv.y) - e4.z * x[mi][4 * g + 2]; x[mi][4 * g + 3] = bhi(vv.y) - e4.w * x[mi][4 * g + 3]; }
                else if (i < 12) { const int mi = (i - 8) >> 1, s_ = (i - 8) & 1; Xb[mi][s_] = ACC_FRAG(x[mi], s_); }
                else { const int g = i - 12; e4q[g] = *(const LAS f32x4*)(egp + 8 * g + 4 * hh); }
                SB_();
            }
            f32x16 vn[2] = {(f32x16){}, (f32x16){}};
            bf16x8_t Kq[6];
#pragma unroll
            for (int i = 0; i < 6; ++i) {
                const int mo = i < 2 ? 0 : 1, mi = i < 2 ? 0 : ((i - 2) >> 1), s_ = i & 1;
                vn[mo] = MFMA32(T[i], Xb[mi][s_], vn[mo]);
                Kq[i] = QKF(i);
                if (i < 4) { const int g = i; const f32x4 e4 = e4q[g]; e4q[g] = *(const LAS f32x4*)(egp + 32 + 8 * g + 4 * hh);
                    o[0][4 * g + 0] *= e4.x; o[0][4 * g + 1] *= e4.y; o[0][4 * g + 2] *= e4.z; o[0][4 * g + 3] *= e4.w; }
                else {
#pragma unroll
                    for (int k = 0; k < 2; ++k) { const int g = 2 * (i - 4) + k; const f32x4 e4 = e4q[g];
                        o[1][4 * g + 0] *= e4.x; o[1][4 * g + 1] *= e4.y; o[1][4 * g + 2] *= e4.z; o[1][4 * g + 3] *= e4.w; } }
                SB_();
            }
            bf16x8_t Vb[2][2], Vd[2][2];
            const float egl = egp[63];
            int lane2 = F.lane; asm volatile("" : "+v"(lane2));
            const TrAddr tra = tr_addr(lane2);
            bf16x8_t Kt[4];
#pragma unroll
            for (int g = 0; g < 4; ++g) e4q[g] = *(const LAS f32x4*)(egp + 64 + 8 * g + 4 * hh);
            Vb[0][0] = ACC_FRAG(vn[0], 0); Vb[0][1] = ACC_FRAG(vn[0], 1);
            SB_();
            o[0] = MFMA32(Kq[0], Vb[0][0], o[0]); Vb[1][0] = ACC_FRAG(vn[1], 0); SB_();
            o[0] = MFMA32(Kq[1], Vb[0][1], o[0]); Vb[1][1] = ACC_FRAG(vn[1], 1); SB_();
#pragma unroll
            for (int i = 2; i < 6; ++i) {
                o[1] = MFMA32(Kq[i], Vb[(i - 2) >> 1][i & 1], o[1]);
                Kt[i - 2] = tr_frag(st + ((i - 2) >> 1) * 8192, tra, 0, (i - 2) & 1);
                { const int mi = (i - 2) >> 1, gb = 2 * ((i - 2) & 1);
#pragma unroll
                  for (int k = 0; k < 2; ++k) { const int g = gb + k; const f32x4 d4 = e4q[g];
                      if (mi == 0) e4q[g] = *(const LAS f32x4*)(egp + 64 + 32 + 8 * g + 4 * hh);
                      vn[mi][4 * g + 0] *= d4.x; vn[mi][4 * g + 1] *= d4.y; vn[mi][4 * g + 2] *= d4.z; vn[mi][4 * g + 3] *= d4.w; } }
                if (i == 3) { Vd[0][0] = ACC_FRAG(vn[0], 0); Vd[0][1] = ACC_FRAG(vn[0], 1); }
                SB_();
            }
            Vd[1][0] = ACC_FRAG(vn[1], 0); Vd[1][1] = ACC_FRAG(vn[1], 1);
            S[0] = S[0] * egl;
            SB_();
            LAS unsigned char* ob = F.lds + OBUF_OFF + (n & 1) * OBUF_BYTES + (n0 + r) * 2 + 4 * hh * OBUF_PITCH;
#pragma unroll
            for (int d = 0; d < 4; ++d) {
                bf16x8_t Kn[4];
                if (d < 3) S[d + 1] = S[d + 1] * egl;
#pragma unroll
                for (int j = 0; j < 4; ++j) {
                    S[d] = MFMA32(Kt[j], Vd[j >> 1][j & 1], S[d]);
                    if (d < 3) Kn[j] = tr_frag(st + (j >> 1) * 8192, tra, d + 1, j & 1);
                    { const int q_ = d * 4 + j, mi = q_ >> 3, g = (q_ >> 1) & 3, pr = q_ & 1;
                      const unsigned pk = cvtpk(o[mi][4 * g + 2 * pr], o[mi][4 * g + 2 * pr + 1]);
                      LAS unsigned char* p = ob + (32 * mi + 8 * g + 2 * pr) * OBUF_PITCH;
                      *(LAS unsigned short*)p = (unsigned short)pk; *(LAS unsigned short*)(p + OBUF_PITCH) = (unsigned short)(pk >> 16); }
                    SB_();
                }
                if (d < 3) {
#pragma unroll
                    for (int j = 0; j < 4; ++j) Kt[j] = Kn[j];
                }
            }
#undef KNF
#undef QNF
#undef TBF
#undef QKF
            asm volatile("s_waitcnt lgkmcnt(0)" ::: "memory");
            __builtin_amdgcn_s_barrier(); asm volatile("" ::: "memory");
        }
#undef SB_
    }
}

__device__ __forceinline__ void p3_scan_item_simple(Frame& F, int b, int h) {
    LAS float* Qs = (LAS float*)F.lds; LAS float* Ks = Qs + 8192; LAS float* Vs = Ks + 8192; LAS float* Os = Vs + 8192;
    LAS float* bet = (LAS float*)(F.lds + SMALL_OFF); LAS float* eg = bet + 64;
    const int tid = F.tid, j = tid >> 2, dq = tid & 3, kh = h >> 1;
    float S[32];
#pragma unroll
    for (int d = 0; d < 32; ++d) S[d] = 0.f;
    const float aexp = __expf(F.a_log[h]), dtb = F.dt_bias[h];
    for (int ch = 0; ch < SEQ / 64; ++ch) {
        const int t0 = ch * 64;
        for (int idx = tid; idx < 64 * 384; idx += 512) {
            const int tok = idx / 384, c = idx - tok * 384;
            const int wch = c < 128 ? kh * 128 + c : (c < 256 ? 2048 + kh * 128 + (c - 128) : 4096 + h * 128 + (c - 256));
            float acc = 0.f;
#pragma unroll
            for (int jj = 0; jj < 4; ++jj) { const int tt = t0 + tok - 3 + jj; if (tt >= 0) acc += bf2f(F.PROJ[((size_t)b * SEQ + tt) * NP + C_DQKV + wch]) * F.conv_w[jj * 8192 + wch]; }
            const float y = siluf_(acc);
            LAS float* dst = c < 128 ? Qs : (c < 256 ? Ks : Vs);
            dst[tok * 128 + (c & 127)] = y;
        }
        if (tid < 64) { const size_t row = (size_t)b * SEQ + t0 + tid; const float db = F.DBA[row * 64 + h], da = F.DBA[row * 64 + 32 + h];
            bet[tid] = sigm_(db); const float xx = da + dtb; const float sp = xx > 20.f ? xx : log1pf(__expf(xx)); eg[tid] = __expf(-aexp * sp); }
        __syncthreads();
        for (int r = 0; r < 16; ++r) { const int row = F.wave * 16 + r; LAS float* p = row < 64 ? Qs + row * 128 : Ks + (row - 64) * 128;
            const float a = p[F.lane], bb = p[F.lane + 64]; const float ss = wave_sum(a * a + bb * bb);
            const float sc = rsqrtf(ss + EPS) * (row < 64 ? 0.08838834764831845f : 1.0f); p[F.lane] = a * sc; p[F.lane + 64] = bb * sc; }
        __syncthreads();
        for (int t = 0; t < 64; ++t) {
            const float e = eg[t], be = bet[t];
            float kk[32]; float part = 0.f;
#pragma unroll
            for (int d = 0; d < 32; d += 4) { const f32x4 k4 = *(const LAS f32x4*)(Ks + t * 128 + dq * 32 + d); kk[d] = k4.x; kk[d + 1] = k4.y; kk[d + 2] = k4.z; kk[d + 3] = k4.w; }
#pragma unroll
            for (int d = 0; d < 32; ++d) part += S[d] * kk[d];
            part += __shfl_xor(part, 1); part += __shfl_xor(part, 2);
            const float vn = be * (Vs[t * 128 + j] - e * part);
#pragma unroll
            for (int d = 0; d < 32; ++d) S[d] = e * S[d] + kk[d] * vn;
            float po = 0.f;
#pragma unroll
            for (int d = 0; d < 32; d += 4) { const f32x4 q4 = *(const LAS f32x4*)(Qs + t * 128 + dq * 32 + d); po += S[d] * q4.x + S[d + 1] * q4.y + S[d + 2] * q4.z + S[d + 3] * q4.w; }
            po += __shfl_xor(po, 1); po += __shfl_xor(po, 2);
            if (dq == 0) Os[t * 128 + j] = po;
        }
        __syncthreads();
        for (int r = 0; r < 8; ++r) { const int tok = F.wave * 8 + r; const size_t row = (size_t)b * SEQ + t0 + tok;
            const float a = Os[tok * 128 + F.lane], bb = Os[tok * 128 + F.lane + 64]; const float ss = wave_sum(a * a + bb * bb);
            const float rs = rsqrtf(ss * (1.f / 128.f) + EPS);
            const float z0 = bf2f(F.PROJ[row * NP + C_DZ + h * 128 + F.lane]), z1 = bf2f(F.PROJ[row * NP + C_DZ + h * 128 + F.lane + 64]);
            F.A2[row * KCAT + 2048 + h * 128 + F.lane] = (bf16)f2bf(a * rs * z0);
            F.A2[row * KCAT + 2048 + h * 128 + F.lane + 64] = (bf16)f2bf(bb * rs * z1); }
        __syncthreads();
    }
}

#ifndef DN_SIMPLE
#define DN_SIMPLE 0
#endif
#ifndef MK_N_LAUNCHES
#define MK_N_LAUNCHES 1
#endif
constexpr int PER_PHASE = 6;
constexpr int N_LAUNCHES = MK_N_LAUNCHES;
struct Args { const void* in[17]; float* out; unsigned char* ws; int ph_lo, ph_hi, li, pad; };

__global__ void __launch_bounds__(NWAVES * 64, 2) skel_fwd(Args args) {
    extern __shared__ __attribute__((aligned(16))) unsigned char lds[];
    Frame F;
    F.lds = (LAS unsigned char*)lds;
    F.MISC = (volatile LAS unsigned*)(F.lds + MISC_OFF);
    F.tid = threadIdx.x; F.lane = F.tid & 63; F.wave = __builtin_amdgcn_readfirstlane(F.tid >> 6);
    F.G = gridDim.x; { const int bx = blockIdx.x; F.vcu = (F.G % 8 == 0) ? (bx % 8) * (F.G / 8) + bx / 8 : bx; }
    unsigned char* ws = args.ws;
    F.ctl = (gu32*)(ws + WS_CTL);
    F.x = (const float*)args.in[0]; F.c = (const float*)args.in[1]; F.positions = (const int*)args.in[2]; F.w_ada = (const float*)args.in[3]; F.b_ada = (const float*)args.in[4];
    F.norm_w = (const float*)args.in[5]; F.w_in = (const float*)args.in[6]; F.q_norm_w = (const float*)args.in[7]; F.k_norm_w = (const float*)args.in[8]; F.sinks = (const float*)args.in[9];
    F.conv_w = (const float*)args.in[10]; F.a_log = (const float*)args.in[11]; F.dt_bias = (const float*)args.in[12]; F.dn_norm_w = (const float*)args.in[13];
    F.w_o_swa = (const float*)args.in[14]; F.w_o_dn = (const float*)args.in[15]; F.w_out = (const float*)args.in[16]; F.out = args.out;
    F.modacc = (float*)(ws + WS_MODACC); F.WTIN = (bf16*)(ws + WS_WTIN); F.WOCAT = (bf16*)(ws + WS_WOCAT); F.WOUT = (bf16*)(ws + WS_WOUT); F.H = (bf16*)(ws + WS_H);
    F.PROJ = (bf16*)(ws + WS_PROJ); F.A2 = (bf16*)(ws + WS_A2); F.Y = (bf16*)(ws + WS_Y); F.ROPE = (float*)(ws + WS_ROPE); F.DBA = (float*)(ws + WS_DBA); F.KQ = (unsigned char*)args.out; F.ws = ws;
    for (int u = F.tid; u < (LDS_BYTES - LDSCTL_OFF) / 4; u += NWAVES * 64) ((LAS unsigned*)(F.lds + LDSCTL_OFF))[u] = 0u;
    __syncthreads();
    XcdBarrier bar; bar.bar = (unsigned*)(F.ctl + CW_BAR) + args.li * XCD_BAR_WORDS; bar.x = 0; bar.st = nullptr;
    if (N_LAUNCHES != PER_PHASE) bar = xcd_barrier_post((unsigned*)(F.ctl + CW_BAR) + args.li * XCD_BAR_WORDS, F.MISC + 8);
#define GRID_BAR() do { if (N_LAUNCHES != PER_PHASE) xcd_barrier(bar); } while (0)
    const int lo = args.ph_lo, hi = args.ph_hi;
#define IN(k) (lo <= (k) && (k) < hi)
#define BOTH(k) (IN(k) && IN((k) + 1))

    if (IN(0)) { p0_prologue(F); if (BOTH(0) && N_LAUNCHES == PER_PHASE) GRID_BAR(); }
    if (IN(1)) { p1_hrows(F); if (BOTH(1)) GRID_BAR(); }
    if (IN(2)) {
        pg8::Gemm g{F.H, F.WTIN, MTOK, NP, DM, DM, DM}; pg8::ListOrder S{0, (int)blockIdx.x, NT1, NT2};
        pg8::EpiProj E{F.PROJ, NP, F.DBA, PN_DBA, F.dn_norm_w};
        pg8::gemm_phase<pg8::EpiProj, pg8::ListOrder, true, true>(F.lds, g, S, E);
        if (BOTH(2)) GRID_BAR();
    }
    if (IN(3)) {
#if DN_SIMPLE
#error "the simple path is not wired to the split in-projection"
#else
        p3a_phase(F, (int)blockIdx.x, F.G);
        if (blockIdx.x < 64) { const int it = ((int)blockIdx.x & 7) * 8 + ((int)blockIdx.x >> 3); p3b_scan(F, it >> 5, it & 31); }
        else {
            { const int a = (int)blockIdx.x - 64; p3_attn_item(F, a >> 7, (a >> 2) & 31, a & 3); }
            if (blockIdx.x >= 224) { for (int j = 0; j < 2; ++j) { const int a = 192 + 2 * ((int)blockIdx.x - 224) + j; p3_attn_item(F, a >> 7, (a >> 2) & 31, a & 3); } }
            else p3_outw_convert(F, 64, 160);
            __syncthreads();
            pg8::Gemm g{F.H, F.WTIN, MTOK, NP, DM, DM, DM}; pg8::EpiProj E{F.PROJ, NP, F.DBA, PN_DBA, F.dn_norm_w};
            pg8::ListOrder S{1, (int)blockIdx.x - 64, NT1, NT2}; pg8::gemm_phase<pg8::EpiProj, pg8::ListOrder, true, true>(F.lds, g, S, E); }
#endif
        if (BOTH(3)) GRID_BAR();
    }
    if (IN(4)) {
        pg8::Gemm g{F.A2, F.WOCAT, MTOK, DM, KCAT, KCAT, KCAT}; pg8::StaticOrder S; S.init(MTOK, DM, F.G, (int)blockIdx.x);
        pg8::EpiMerge E{F.Y, DM, F.PROJ + C_MGA, F.PROJ + C_MGB, NP};
        pg8::gemm_phase<pg8::EpiMerge, pg8::StaticOrder, true, true>(F.lds, g, S, E);
        if (BOTH(4)) GRID_BAR();
    }
    if (IN(5)) {
        pg8::Gemm g{F.Y, F.WOUT, MTOK, DM, DM, DM, DM}; pg8::StaticOrder S; S.init(MTOK, DM, F.G, (int)blockIdx.x);
        pg8::EpiResid E{F.out, F.x, DM, F.modacc, F.b_ada, 2 * DM, 6144, SEQ};
        pg8::gemm_phase<pg8::EpiResid, pg8::StaticOrder, true, true>(F.lds, g, S, E);
    }
#undef IN
#undef BOTH
}

extern "C" void kernel_launch(void* const* d_in, const int* in_sizes, int n_in, void* d_out, int out_size, void* d_ws, size_t ws_size, hipStream_t stream) {
    static int grid = 0;
    if (grid == 0) {
        if (n_in != 17 || in_sizes[0] != MTOK * DM || out_size != MTOK * DM || ws_size < WS_END) { fprintf(stderr, "kernel_launch: unexpected shapes / workspace (n_in %d, in0 %d, out %d, ws %zu, need %zu); nothing launched\n", n_in, n_in > 0 ? in_sizes[0] : -1, out_size, ws_size, (size_t)WS_END); grid = -1; return; }
        int dev = 0, cus = 0, per_cu = 0;
        if (hipGetDevice(&dev) != hipSuccess || hipDeviceGetAttribute(&cus, hipDeviceAttributeMultiprocessorCount, dev) != hipSuccess) { grid = -1; return; }
        if (hipFuncSetAttribute((const void*)skel_fwd, hipFuncAttributeMaxDynamicSharedMemorySize, LDS_BYTES) != hipSuccess) { fprintf(stderr, "kernel_launch: hipFuncSetAttribute failed\n"); grid = -1; return; }
        if (hipOccupancyMaxActiveBlocksPerMultiprocessor(&per_cu, (const void*)skel_fwd, NWAVES * 64, LDS_BYTES) != hipSuccess || per_cu < 1) { fprintf(stderr, "kernel_launch: occupancy query says %d blocks per CU\n", per_cu); per_cu = 1; }
        (void)hipGetLastError();
        grid = cus;
    }
    if (grid < 0) return;
    (void)hipMemsetAsync((char*)d_ws + WS_CTL, 0, CTL_ZERO_BYTES, stream);
    Args a{};
    for (int i = 0; i < 17; ++i) a.in[i] = d_in[i];
    a.out = (float*)d_out; a.ws = (unsigned char*)d_ws;
    for (int li = 0; li < N_LAUNCHES; ++li) {
        a.ph_lo = (N_LAUNCHES == PER_PHASE) ? li : 0; a.ph_hi = (N_LAUNCHES == PER_PHASE) ? li + 1 : PER_PHASE; a.li = (N_LAUNCHES == PER_PHASE) ? 0 : li;
        hipLaunchKernelGGL(skel_fwd, dim3(grid), dim3(NWAVES * 64), LDS_BYTES, stream, a);
    }
}
```

```cpp
#include <hip/hip_runtime.h>
#include <cstdio>
#include <cstdint>

namespace pg8 {
#define PG8_LAS __attribute__((address_space(3)))
typedef unsigned short bf16_t;
typedef short bf16x8 __attribute__((ext_vector_type(8)));
typedef float f32x4 __attribute__((ext_vector_type(4)));
typedef unsigned u32x4 __attribute__((ext_vector_type(4)));
typedef unsigned u32x2 __attribute__((ext_vector_type(2)));
constexpr int BM = 256, BK = 64, HALF = 128, HTB = HALF * BK * 2  , STAGE_BYTES = 8 * HTB, NXCD = 8, WGM = 4;

__host__ __device__ __forceinline__ int lds_byte(int r, int c) { const int st = (r >> 4) * 2 + (c >> 5), rr = r & 15, cc = c & 31, ob = rr * 64 + cc * 2; return st * 1024 + (ob ^ (((ob >> 9) & 1) << 5)); }
__host__ __device__ __forceinline__ void stage_rc(int b, int& R, int& C) { const int st = b / 1024, sb = b % 1024, swz = sb ^ (((sb >> 9) & 1) << 5); R = (st >> 1) * 16 + swz / 64; C = (st & 1) * 32 + (swz % 64) / 2; }
__host__ __device__ __forceinline__ int perm32(int rho) { const int n = rho >> 4, i = rho & 15; return 8 * (i >> 2) + 4 * n + (i & 3); }

struct Unit { int pm, pn; };
struct Gemm { const bf16_t* A; const bf16_t* Bt; int M, N, K, lda, ldb; };

struct StaticOrder {
    int nM, nN, nwg, G, c;
    __host__ __device__ void init(int M, int N, int G_, int c_) { nM = M / BM; nN = N / BM; nwg = nM * nN; G = G_; c = c_; }
    __host__ __device__ bool next(int i, Unit& u) const {
        const long L = (long)i * G + c; if (L >= nwg) return false;
        int wgid = (int)L; { const int q = nwg / NXCD, r = nwg % NXCD, xcd = wgid % NXCD, off = wgid / NXCD; wgid = (xcd < r ? xcd * (q + 1) : r * (q + 1) + (xcd - r) * q) + off; }
        const int nig = WGM * nN, gid = wgid / nig, fm = gid * WGM, gsz = (nM - fm) < WGM ? (nM - fm) : WGM;
        u.pm = fm + ((wgid % nig) % gsz); u.pn = (wgid % nig) / gsz; return true;
    }
    __device__ __forceinline__ void a_ready(const Unit&) const {}
    __device__ __forceinline__ void done(const Unit&) const {}
    __device__ __forceinline__ void poll_issue(const Unit&, unsigned&, unsigned&) const {}
    __device__ __forceinline__ void a_ready2(const Unit&, unsigned, unsigned) const {}
};

struct TeamOrder {
    int x, p, j; const unsigned* hcnt; const unsigned* wcnt; unsigned* tmo;
    __device__ __forceinline__ bool next(int i, Unit& u) const {
        if (i < 8) { u.pm = 4 * x + p; u.pn = 8 * i + j; return true; }
        if (i == 8 && p < 2) {
            if (j < 3) { u.pm = 4 * x + p; u.pn = 64 + j; }
            else if (j < 6) { u.pm = 4 * x + p + 2; u.pn = 64 + (j - 3); }
            else { u.pm = 4 * x + p; u.pn = 67 + (j - 6); }
            return true;
        }
        return false;
    }
    __device__ __forceinline__ void wait_slow(const Unit& u) const {
        unsigned sp = 0;
        while ((unsigned)__builtin_amdgcn_readfirstlane((int)__hip_atomic_load(hcnt + u.pm, __ATOMIC_RELAXED, __HIP_MEMORY_SCOPE_AGENT)) < 8u ||
               (unsigned)__builtin_amdgcn_readfirstlane((int)__hip_atomic_load(wcnt + (u.pn >> 3), __ATOMIC_RELAXED, __HIP_MEMORY_SCOPE_AGENT)) < 128u) {
            __builtin_amdgcn_s_sleep(8); if (++sp > (1u << 21)) { if ((threadIdx.x & 63) == 0) atomicAdd(tmo, 1u); break; } }
    }
    __device__ __forceinline__ void a_ready(const Unit& u) const { if (threadIdx.x < 64) wait_slow(u); __syncthreads(); __builtin_amdgcn_fence(__ATOMIC_ACQUIRE, "agent"); asm volatile("s_waitcnt vmcnt(0)" ::: "memory"); }
    __device__ __forceinline__ void done(const Unit&) const {}
    __device__ __forceinline__ void poll_issue(const Unit& u, unsigned& ph, unsigned& pw) const {
        if (threadIdx.x >= 64) return;
        const unsigned* a = hcnt + u.pm; const unsigned* b = wcnt + (u.pn >> 3);
        asm volatile("global_load_dword %0, %2, off sc1\n\tglobal_load_dword %1, %3, off sc1" : "=&v"(ph), "=&v"(pw) : "v"(a), "v"(b) : "memory");
    }
    __device__ __forceinline__ void a_ready2(const Unit& u, unsigned ph, unsigned pw) const {
        if (threadIdx.x >= 64) return;
        asm volatile("" : "+v"(ph), "+v"(pw) :: "memory");
        if ((unsigned)__builtin_amdgcn_readfirstlane((int)ph) < 8u || (unsigned)__builtin_amdgcn_readfirstlane((int)pw) < 128u) wait_slow(u);
    }
};
struct P3List {
    int x, e0, n;
    __device__ __forceinline__ bool next(int i, Unit& u) const {
        if (i >= n) return false;
        const int e = e0 + i;
        if (e < 14) { u.pm = 4 * x; u.pn = 69 + e; } else if (e < 28) { u.pm = 4 * x + 1; u.pn = 69 + (e - 14); } else if (e < 44) { u.pm = 4 * x + 2; u.pn = 67 + (e - 28); } else { u.pm = 4 * x + 3; u.pn = 67 + (e - 44); }
        return true;
    }
    __device__ __forceinline__ void a_ready(const Unit&) const {}
    __device__ __forceinline__ void done(const Unit&) const {}
    __device__ __forceinline__ void poll_issue(const Unit&, unsigned&, unsigned&) const {}
    __device__ __forceinline__ void a_ready2(const Unit&, unsigned, unsigned) const {}
};

struct ListOrder {
    int mode, c, nt1, nt2;
    __host__ __device__ static void map(int nM, int nN, int L, Unit& u) {
        const int nwg = nM * nN; int wgid = L; { const int q = nwg / NXCD, r = nwg % NXCD, xcd = wgid % NXCD, off = wgid / NXCD; wgid = (xcd < r ? xcd * (q + 1) : r * (q + 1) + (xcd - r) * q) + off; }
        const int nig = WGM * nN, gid = wgid / nig, fm = gid * WGM, gsz = (nM - fm) < WGM ? (nM - fm) : WGM;
        u.pm = fm + ((wgid % nig) % gsz); u.pn = (wgid % nig) / gsz;
    }
    __host__ __device__ bool next(int i, Unit& u) const {
        int part, L;
        if (mode == 0) { if (i < 8) { part = 0; L = i * 256 + c; } else if (i == 8) { if (c < 96) { part = 0; L = 2048 + c; } else { part = 1; L = c - 96; } } else return false; }
        else { part = 1; L = 160 + i * 192 + c; if (i >= 2 || L >= 32 * nt2) return false; }
        if (part == 0) map(32, nt1, L, u); else { map(32, nt2, L, u); u.pn += nt1; }
        return true;
    }
    __device__ __forceinline__ void a_ready(const Unit&) const {}
    __device__ __forceinline__ void done(const Unit&) const {}
    __device__ __forceinline__ void poll_issue(const Unit&, unsigned&, unsigned&) const {}
    __device__ __forceinline__ void a_ready2(const Unit&, unsigned, unsigned) const {}
};

__device__ __forceinline__ unsigned cvt_pk_bf16(float lo, float hi) { unsigned r; asm volatile("v_cvt_pk_bf16_f32 %0, %1, %2" : "=v"(r) : "v"(lo), "v"(hi)); return r; }
__device__ __forceinline__ float bf_lo(unsigned w) { return __uint_as_float(w << 16); }
__device__ __forceinline__ float bf_hi(unsigned w) { return __uint_as_float(w & 0xffff0000u); }
__device__ __forceinline__ float sigmoidf_(float x) { return __builtin_amdgcn_rcpf(1.0f + __builtin_amdgcn_exp2f(-1.4426950408889634f * x)); }

struct EpiProj {
    static constexpr bool PERM = true, AFTER_DRAIN = false; static constexpr int MIDT = -1;
    bf16_t* O; int ldc; float* DBA; int pn_f32; const float* dnw;
    __device__ __forceinline__ void operator()(const f32x4 (&acc)[2][2][4][2], const Unit& u, int wr, int wc, int fr, int fq) const {
        const int row0 = u.pm * BM + wr * 64 + fr;
        if (u.pn == pn_f32) {
            if (wc < 2) {
#pragma unroll
                for (int ai = 0; ai < 2; ++ai)
#pragma unroll
                    for (int m = 0; m < 4; ++m) { float* p = DBA + (size_t)(row0 + ai * HALF + m * 16) * 64 + wc * 32 + 8 * fq;
                        *(f32x4*)p = acc[ai][0][m][0]; *(f32x4*)(p + 4) = acc[ai][0][m][1]; }
            }
            return;
        }
        const int mode = (u.pn >= 59 && u.pn < 67) ? 1 : ((u.pn >= 32 && u.pn < 48) ? 2 : (u.pn >= 67 ? 3 : 0));
        const int col0 = u.pn * BM + wc * 32 + 8 * fq;
        f32x4 w0 = {1.f, 1.f, 1.f, 1.f}, w1 = {1.f, 1.f, 1.f, 1.f};
        if (mode == 2) { w0 = *(const f32x4*)(dnw + wc * 32 + 8 * fq); w1 = *(const f32x4*)(dnw + wc * 32 + 8 * fq + 4); }
#pragma unroll
        for (int ai = 0; ai < 2; ++ai)
#pragma unroll
            for (int m = 0; m < 4; ++m) { bf16_t* rowp = O + (size_t)(row0 + ai * HALF + m * 16) * ldc + col0;
#pragma unroll
                for (int bj = 0; bj < 2; ++bj) { f32x4 v0 = acc[ai][bj][m][0], v1 = acc[ai][bj][m][1];
                    if (mode != 0) {
#pragma unroll
                        for (int e = 0; e < 4; ++e) { const float t0 = sigmoidf_(v0[e]), t1 = sigmoidf_(v1[e]);
                            v0[e] = mode == 3 ? t0 : v0[e] * t0 * w0[e]; v1[e] = mode == 3 ? t1 : v1[e] * t1 * w1[e]; }
                    }
                    u32x4 w; w.x = cvt_pk_bf16(v0[0], v0[1]); w.y = cvt_pk_bf16(v0[2], v0[3]); w.z = cvt_pk_bf16(v1[0], v1[1]); w.w = cvt_pk_bf16(v1[2], v1[3]);
                    __builtin_nontemporal_store(w, (u32x4*)(rowp + bj * HALF)); } }
    }
};
struct EpiGateF32 {
    static constexpr bool PERM = false, AFTER_DRAIN = false; static constexpr int MIDT = -1;
    float* C; int ldc; const bf16_t* G; int ldg;
    __device__ __forceinline__ void operator()(const f32x4 (&acc)[2][2][4][2], const Unit& u, int wr, int wc, int fr, int fq) const {
        const int row0 = u.pm * BM + wr * 64 + fr, col0 = u.pn * BM + wc * 32 + 4 * fq;
#pragma unroll
        for (int ai = 0; ai < 2; ++ai)
#pragma unroll
            for (int m = 0; m < 4; ++m) { const size_t r = (size_t)(row0 + ai * HALF + m * 16); float* rowp = C + r * ldc + col0; const bf16_t* gp = G + r * ldg + col0;
#pragma unroll
                for (int bj = 0; bj < 2; ++bj)
#pragma unroll
                    for (int n = 0; n < 2; ++n) { const u32x2 gw = *(const u32x2*)(gp + bj * HALF + n * 16); const f32x4 a = acc[ai][bj][m][n];
                        f32x4 o; o[0] = a[0] * bf_lo(gw.x); o[1] = a[1] * bf_hi(gw.x); o[2] = a[2] * bf_lo(gw.y); o[3] = a[3] * bf_hi(gw.y);
                        *(f32x4*)(rowp + bj * HALF + n * 16) = o; } }
    }
};
struct EpiGateAddBf16 {
    static constexpr bool PERM = true, AFTER_DRAIN = false; static constexpr int MIDT = -1;
    bf16_t* O; int ldc; const float* YA; int ldy; const bf16_t* G; int ldg;
    __device__ __forceinline__ void operator()(const f32x4 (&acc)[2][2][4][2], const Unit& u, int wr, int wc, int fr, int fq) const {
        const int row0 = u.pm * BM + wr * 64 + fr, col0 = u.pn * BM + wc * 32 + 8 * fq;
#pragma unroll
        for (int ai = 0; ai < 2; ++ai)
#pragma unroll
            for (int m = 0; m < 4; ++m) { const size_t r = (size_t)(row0 + ai * HALF + m * 16); bf16_t* rowp = O + r * ldc + col0; const float* yp = YA + r * ldy + col0; const bf16_t* gp = G + r * ldg + col0;
#pragma unroll
                for (int bj = 0; bj < 2; ++bj) { const f32x4 v0 = acc[ai][bj][m][0], v1 = acc[ai][bj][m][1];
                    const u32x4 gw = *(const u32x4*)(gp + bj * HALF); const f32x4 y0 = *(const f32x4*)(yp + bj * HALF), y1 = *(const f32x4*)(yp + bj * HALF + 4);
                    const float o0 = y0[0] + v0[0] * bf_lo(gw.x), o1 = y0[1] + v0[1] * bf_hi(gw.x), o2 = y0[2] + v0[2] * bf_lo(gw.y), o3 = y0[3] + v0[3] * bf_hi(gw.y);
                    const float o4 = y1[0] + v1[0] * bf_lo(gw.z), o5 = y1[1] + v1[1] * bf_hi(gw.z), o6 = y1[2] + v1[2] * bf_lo(gw.w), o7 = y1[3] + v1[3] * bf_hi(gw.w);
                    u32x4 w; w.x = cvt_pk_bf16(o0, o1); w.y = cvt_pk_bf16(o2, o3); w.z = cvt_pk_bf16(o4, o5); w.w = cvt_pk_bf16(o6, o7);
                    *(u32x4*)(rowp + bj * HALF) = w; } }
    }
};
struct EpiMerge {
    static constexpr bool PERM = true, AFTER_DRAIN = false; static constexpr int MIDT = 32;
    bf16_t* O; int ldc; const bf16_t* GA; const bf16_t* GB; int ldg;
    __device__ __forceinline__ void mid(f32x4 (&acc)[2][2][4][2], const Unit& u, int wr, int wc, int fr, int fq) const {
        asm volatile("" : "+v"(fr), "+v"(fq));
        const int row0 = u.pm * BM + wr * 64 + fr, col0 = u.pn * BM + wc * 32 + 8 * fq;
#pragma unroll
        for (int ai = 0; ai < 2; ++ai)
#pragma unroll
            for (int m = 0; m < 4; ++m) { const size_t r = (size_t)(row0 + ai * HALF + m * 16);
#pragma unroll
                for (int bj = 0; bj < 2; ++bj) { const u32x4 ga = *(const u32x4*)(GA + r * ldg + col0 + bj * HALF), gb = *(const u32x4*)(GB + r * ldg + col0 + bj * HALF);
                    f32x4& v0 = acc[ai][bj][m][0]; f32x4& v1 = acc[ai][bj][m][1];
                    v0[0] *= bf_lo(ga.x) * __builtin_amdgcn_rcpf(fmaxf(bf_lo(gb.x), 1e-30f)); v0[1] *= bf_hi(ga.x) * __builtin_amdgcn_rcpf(fmaxf(bf_hi(gb.x), 1e-30f));
                    v0[2] *= bf_lo(ga.y) * __builtin_amdgcn_rcpf(fmaxf(bf_lo(gb.y), 1e-30f)); v0[3] *= bf_hi(ga.y) * __builtin_amdgcn_rcpf(fmaxf(bf_hi(gb.y), 1e-30f));
                    v1[0] *= bf_lo(ga.z) * __builtin_amdgcn_rcpf(fmaxf(bf_lo(gb.z), 1e-30f)); v1[1] *= bf_hi(ga.z) * __builtin_amdgcn_rcpf(fmaxf(bf_hi(gb.z), 1e-30f));
                    v1[2] *= bf_lo(ga.w) * __builtin_amdgcn_rcpf(fmaxf(bf_lo(gb.w), 1e-30f)); v1[3] *= bf_hi(ga.w) * __builtin_amdgcn_rcpf(fmaxf(bf_hi(gb.w), 1e-30f)); }
                __builtin_amdgcn_sched_barrier(0); }
    }
    __device__ __forceinline__ void operator()(const f32x4 (&acc)[2][2][4][2], const Unit& u, int wr, int wc, int fr, int fq) const {
        const int row0 = u.pm * BM + wr * 64 + fr, col0 = u.pn * BM + wc * 32 + 8 * fq;
#pragma unroll
        for (int ai = 0; ai < 2; ++ai)
#pragma unroll
            for (int m = 0; m < 4; ++m) { const size_t r = (size_t)(row0 + ai * HALF + m * 16); bf16_t* rowp = O + r * ldc + col0;
#pragma unroll
                for (int bj = 0; bj < 2; ++bj) { const f32x4 v0 = acc[ai][bj][m][0], v1 = acc[ai][bj][m][1]; const u32x4 gb = *(const u32x4*)(GB + r * ldg + col0 + bj * HALF);
                    u32x4 w; w.x = cvt_pk_bf16(v0[0] * bf_lo(gb.x), v0[1] * bf_hi(gb.x)); w.y = cvt_pk_bf16(v0[2] * bf_lo(gb.y), v0[3] * bf_hi(gb.y));
                    w.z = cvt_pk_bf16(v1[0] * bf_lo(gb.z), v1[1] * bf_hi(gb.z)); w.w = cvt_pk_bf16(v1[2] * bf_lo(gb.w), v1[3] * bf_hi(gb.w));
                    *(u32x4*)(rowp + bj * HALF) = w; } }
    }
};
struct EpiResid {
    static constexpr bool PERM = false, AFTER_DRAIN = false; static constexpr int MIDT = -1;
    float* C; const float* X; int ldc; const float* modacc; const float* bias; int goff, modld, rows_per_batch;
    __device__ __forceinline__ void operator()(const f32x4 (&acc)[2][2][4][2], const Unit& u, int wr, int wc, int fr, int fq) const {
        const int row0 = u.pm * BM + wr * 64 + fr, col0 = u.pn * BM + wc * 32 + 4 * fq;
        const int b = (u.pm * BM) / rows_per_batch;
        f32x4 gv[2][2];
#pragma unroll
        for (int bj = 0; bj < 2; ++bj)
#pragma unroll
            for (int n = 0; n < 2; ++n) gv[bj][n] = *(const f32x4*)(modacc + (size_t)b * modld + goff + col0 + bj * HALF + n * 16) + *(const f32x4*)(bias + goff + col0 + bj * HALF + n * 16);
#pragma unroll
        for (int ai = 0; ai < 2; ++ai)
#pragma unroll
            for (int m = 0; m < 4; ++m) { const size_t off = (size_t)(row0 + ai * HALF + m * 16) * ldc + col0;
#pragma unroll
                for (int bj = 0; bj < 2; ++bj)
#pragma unroll
                    for (int n = 0; n < 2; ++n) { const f32x4 xv = __builtin_nontemporal_load((const f32x4*)(X + off + bj * HALF + n * 16)); __builtin_nontemporal_store(xv + gv[bj][n] * acc[ai][bj][m][n], (f32x4*)(C + off + bj * HALF + n * 16)); } }
    }
};

template <class Epi, class Sched, bool ALIGN_EPI = false, bool SP2 = false>
__device__ __forceinline__ void gemm_phase(PG8_LAS unsigned char* lds, const Gemm g, const Sched& S, const Epi& E) {
    const int tid = threadIdx.x, wid = __builtin_amdgcn_readfirstlane(tid >> 6), lane = tid & 63, wr = wid >> 2, wc = wid & 3, fr = lane & 15, fq = lane >> 4;
    const int K = g.K, nt = K / BK;
    unsigned voffA[2], voffB[2];
#pragma unroll
    for (int i = 0; i < 2; ++i) { int R, C; stage_rc(tid * 16 + i * 8192, R, C); const int Rb = Epi::PERM ? ((R & ~31) + perm32(R & 31)) : R;
        voffA[i] = (unsigned)(R * g.lda + C) * 2u; voffB[i] = (unsigned)(Rb * g.ldb + C) * 2u; }
    const size_t kstep = (size_t)(BK * 2);
    const size_t hstepA = (size_t)HALF * g.lda * 2, hstepB = (size_t)HALF * g.ldb * 2;
    const size_t tstepA = 2 * hstepA, tstepB = 2 * hstepB;
    const unsigned ldsw = (unsigned)wid * 1024u;
    const int aoff = lds_byte(wr * 64 + fr, fq * 8), boff = lds_byte(wc * 32 + fr, fq * 8);
#define PG8_SA(b, h) (((b) * 2 + (h)) * HTB)
#define PG8_SB(b, h) ((4 + (b) * 2 + (h)) * HTB)
#define PG8_STAGE(bufoff, gbase, voff) do { _Pragma("unroll") for (int _i = 0; _i < 2; ++_i) \
        __builtin_amdgcn_global_load_lds((const unsigned*)((const char*)(gbase) + (voff)[_i]), (PG8_LAS unsigned*)(lds + (bufoff) + ldsw + _i * 8192), 16, 0, 0); } while (0)
#define PG8_LDA(dst, b, h) do { _Pragma("unroll") for (int m = 0; m < 4; ++m) _Pragma("unroll") for (int k = 0; k < 2; ++k) dst[m][k] = *(const PG8_LAS bf16x8*)(lds + PG8_SA(b, h) + aoff + m * 2048 + k * 1024); } while (0)
#define PG8_LDB(dst, b, h) do { _Pragma("unroll") for (int n = 0; n < 2; ++n) _Pragma("unroll") for (int k = 0; k < 2; ++k) dst[n][k] = *(const PG8_LAS bf16x8*)(lds + PG8_SB(b, h) + boff + n * 2048 + k * 1024); } while (0)
#define PG8_MMA(ai, bj, At, Bt) do { __builtin_amdgcn_s_setprio(1); _Pragma("unroll") for (int m = 0; m < 4; ++m) _Pragma("unroll") for (int n = 0; n < 2; ++n) _Pragma("unroll") for (int k = 0; k < 2; ++k) \
        acc[ai][bj][m][n] = __builtin_amdgcn_mfma_f32_16x16x32_bf16(Bt[n][k], At[m][k], acc[ai][bj][m][n], 0, 0, 0); __builtin_amdgcn_s_setprio(0); } while (0)
#define PG8_WAIT_V(n) asm volatile("s_waitcnt vmcnt(" #n ")" ::: "memory")
#define PG8_WAIT_L(n) asm volatile("s_waitcnt lgkmcnt(" #n ")" ::: "memory")
#define PG8_BAR __builtin_amdgcn_s_barrier()
#define PG8_SCHED __builtin_amdgcn_sched_barrier(0)
    Unit cur, nxt; int ui = 0; unsigned pv0 = 0, pv1 = 0;
    if (!S.next(0, cur)) return;
    f32x4 acc[2][2][4][2];
#pragma unroll
    for (int a = 0; a < 2; ++a)
#pragma unroll
        for (int b = 0; b < 2; ++b)
#pragma unroll
            for (int m = 0; m < 4; ++m)
#pragma unroll
                for (int n = 0; n < 2; ++n) acc[a][b][m][n] = (f32x4){0.f, 0.f, 0.f, 0.f};
    bf16x8 At[4][2], B0[2][2], B1[2][2];
    const char* cA = (const char*)g.A + (size_t)cur.pm * tstepA; const char* cB = (const char*)g.Bt + (size_t)cur.pn * tstepB;
    S.a_ready(cur);
    if constexpr (SP2) {
        PG8_STAGE(PG8_SB(0, 0), cB, voffB); PG8_STAGE(PG8_SB(0, 1), cB + hstepB, voffB); PG8_STAGE(PG8_SA(0, 0), cA, voffA); PG8_STAGE(PG8_SA(0, 1), cA + hstepA, voffA);
        if (wr == 1) PG8_BAR;
        PG8_WAIT_V(2); PG8_BAR;
        PG8_STAGE(PG8_SB(1, 0), cB + kstep, voffB); PG8_STAGE(PG8_SA(1, 0), cA + kstep, voffA); PG8_STAGE(PG8_SB(1, 1), cB + hstepB + kstep, voffB);
        PG8_WAIT_V(6); PG8_BAR;
    } else {
        PG8_STAGE(PG8_SB(0, 0), cB, voffB); PG8_STAGE(PG8_SA(0, 0), cA, voffA); PG8_STAGE(PG8_SB(0, 1), cB + hstepB, voffB); PG8_STAGE(PG8_SA(0, 1), cA + hstepA, voffA);
        if (wr == 1) PG8_BAR;
        PG8_WAIT_V(4); PG8_BAR;
        PG8_STAGE(PG8_SB(1, 0), cB + kstep, voffB); PG8_STAGE(PG8_SA(1, 0), cA + kstep, voffA); PG8_STAGE(PG8_SB(1, 1), cB + hstepB + kstep, voffB);
        PG8_WAIT_V(6); PG8_BAR;
    }
    for (;;) {
        const bool has_next = S.next(ui + 1, nxt);
        if (has_next) S.poll_issue(nxt, pv0, pv1);
        const char* nA = has_next ? (const char*)g.A + (size_t)nxt.pm * tstepA : cA; const char* nB = has_next ? (const char*)g.Bt + (size_t)nxt.pn * tstepB : cB;
        for (int t = 0; t < nt; t += 2) {
            if constexpr (Epi::MIDT >= 0) { if (t == Epi::MIDT) E.mid(acc, cur, wr, wc, fr, fq); }
            const bool last = (t == nt - 2);
            const char* a1 = cA + (size_t)(t + 1) * kstep;
            const char* a2 = last ? nA : cA + (size_t)(t + 2) * kstep; const char* b2 = last ? nB : cB + (size_t)(t + 2) * kstep;
            const char* a3 = a2 + kstep; const char* b3 = b2 + kstep;
            if (last && has_next) S.a_ready2(nxt, pv0, pv1);
            if constexpr (SP2) {
            PG8_LDB(B0, 0, 0); PG8_LDB(B1, 0, 1); PG8_SCHED; PG8_LDA(At, 0, 0); PG8_STAGE(PG8_SA(1, 1), a1 + hstepA, voffA);
            PG8_WAIT_V(8); PG8_WAIT_L(0); PG8_BAR; PG8_MMA(0, 0, At, B0); PG8_MMA(0, 1, At, B1); PG8_BAR; PG8_SCHED;
            PG8_LDA(At, 0, 1); PG8_STAGE(PG8_SB(0, 0), b2, voffB); PG8_STAGE(PG8_SB(0, 1), b2 + hstepB, voffB); PG8_STAGE(PG8_SA(0, 0), a2, voffA);
            PG8_WAIT_V(8); PG8_WAIT_L(0); PG8_BAR; PG8_MMA(1, 0, At, B0); PG8_MMA(1, 1, At, B1); PG8_BAR; PG8_SCHED;
            PG8_LDB(B0, 1, 0); PG8_LDB(B1, 1, 1); PG8_SCHED; PG8_LDA(At, 1, 0); PG8_STAGE(PG8_SA(0, 1), a2 + hstepA, voffA);
            PG8_WAIT_V(8); PG8_WAIT_L(0); PG8_BAR; PG8_MMA(0, 0, At, B0); PG8_MMA(0, 1, At, B1); PG8_BAR; PG8_SCHED;
            PG8_LDA(At, 1, 1); PG8_STAGE(PG8_SB(1, 0), b3, voffB); PG8_STAGE(PG8_SB(1, 1), b3 + hstepB, voffB); PG8_STAGE(PG8_SA(1, 0), a3, voffA);
            PG8_WAIT_V(8); PG8_WAIT_L(0); PG8_BAR; PG8_MMA(1, 0, At, B0); PG8_MMA(1, 1, At, B1); PG8_BAR; PG8_SCHED;
            } else {
            PG8_LDB(B0, 0, 0); PG8_SCHED; PG8_LDA(At, 0, 0); PG8_STAGE(PG8_SA(1, 1), a1 + hstepA, voffA);
            PG8_WAIT_L(8); PG8_BAR; PG8_WAIT_L(0); PG8_MMA(0, 0, At, B0); PG8_BAR; PG8_SCHED;
            PG8_LDB(B1, 0, 1); PG8_STAGE(PG8_SB(0, 0), b2, voffB);
            PG8_BAR; PG8_WAIT_L(0); PG8_MMA(0, 1, At, B1); PG8_BAR;
            PG8_LDA(At, 0, 1); PG8_STAGE(PG8_SA(0, 0), a2, voffA);
            PG8_BAR; PG8_WAIT_L(0); PG8_MMA(1, 0, At, B0); PG8_BAR; PG8_SCHED;
            PG8_STAGE(PG8_SB(0, 1), b2 + hstepB, voffB);
            PG8_WAIT_V(6); PG8_BAR; PG8_MMA(1, 1, At, B1); PG8_BAR;
            PG8_LDB(B0, 1, 0); PG8_SCHED; PG8_LDA(At, 1, 0); PG8_STAGE(PG8_SA(0, 1), a2 + hstepA, voffA);
            PG8_WAIT_L(8); PG8_BAR; PG8_WAIT_L(0); PG8_MMA(0, 0, At, B0); PG8_BAR; PG8_SCHED;
            PG8_LDB(B1, 1, 1); PG8_STAGE(PG8_SB(1, 0), b3, voffB);
            PG8_BAR; PG8_WAIT_L(0); PG8_MMA(0, 1, At, B1); PG8_BAR;
            PG8_LDA(At, 1, 1); PG8_STAGE(PG8_SA(1, 0), a3, voffA);
            PG8_BAR; PG8_WAIT_L(0); PG8_MMA(1, 0, At, B0); PG8_BAR; PG8_SCHED;
            PG8_STAGE(PG8_SB(1, 1), b3 + hstepB, voffB);
            PG8_WAIT_V(6); PG8_BAR; PG8_MMA(1, 1, At, B1); PG8_BAR;
            }
        }
        if constexpr (ALIGN_EPI) { if (wr == 0) PG8_BAR; }
        if constexpr (!Epi::AFTER_DRAIN) { E(acc, cur, wr, wc, fr, fq); S.done(cur); }
        if (!has_next) break;
#pragma unroll
        for (int a = 0; a < 2; ++a)
#pragma unroll
            for (int b = 0; b < 2; ++b)
#pragma unroll
                for (int m = 0; m < 4; ++m)
#pragma unroll
                    for (int n = 0; n < 2; ++n) acc[a][b][m][n] = (f32x4){0.f, 0.f, 0.f, 0.f};
        cur = nxt; cA = nA; cB = nB; ++ui;
        if constexpr (ALIGN_EPI) { if (wr == 1) PG8_BAR; }
    }
    PG8_WAIT_V(0);
    if constexpr (!ALIGN_EPI) { if (wr == 0) PG8_BAR; }
    PG8_BAR;
    if constexpr (Epi::AFTER_DRAIN) { E.fused(acc, cur, wr, wc, fr, fq, lds, wid, lane); S.done(cur); }
#undef PG8_SA
#undef PG8_SB
#undef PG8_STAGE
#undef PG8_LDA
#undef PG8_LDB
#undef PG8_MMA
#undef PG8_WAIT_V
#undef PG8_WAIT_L
#undef PG8_BAR
#undef PG8_SCHED
}
}

constexpr int NWAVES = 8;
constexpr int DM = 2048, NBATCH = 2, SEQ = 4096, MTOK = NBATCH * SEQ;
constexpr int IN_WIDTH = 21056, NP = 21248;
constexpr int C_DQKV = 0, C_DZ = 8192, C_DBA = 12288, C_AQ = 12544, C_AK = 14592, C_AV = 14848, C_AG = 15104, C_MGA = 17152, C_MGB = 19200;
constexpr int PN_DBA = C_DBA / 256;
constexpr int NT1 = 67, NT2 = 16;
static_assert(C_MGB + 2048 == NP && (NT1 + NT2) * 256 == NP && C_MGA == NT1 * 256, "proj column layout");
constexpr int KCAT = 6144;
constexpr float EPS = 1e-6f;

constexpr size_t MiB = 1u << 20;
constexpr size_t WS_CTL = 0, CTL_ZERO_BYTES = 128 * 1024;
constexpr size_t WS_MODACC = 64 * 1024;
constexpr size_t WS_WOCAT = 1 * MiB;
constexpr size_t WS_WOUT = 25 * MiB;
constexpr size_t WS_ROPE = 33 * MiB;
constexpr size_t WS_DBA = 34 * MiB;
constexpr size_t WS_PROJ = 36 * MiB;
constexpr size_t WS_A2 = 368 * MiB;
constexpr size_t WS_WTIN = 464 * MiB;
constexpr size_t WS_H = 547 * MiB;
constexpr size_t WS_Y = 579 * MiB;
constexpr size_t WS_TQV0 = 493 * MiB, WS_TQV1 = 464 * MiB, WS_TQV2 = 579 * MiB, WS_TQV3 = 608 * MiB, TQV_REGION = (size_t)1024 * 29696;
constexpr size_t WS_END = 644 * MiB;
static_assert(WS_PROJ + (size_t)MTOK * NP * 2 <= WS_A2 && WS_WTIN + (size_t)NP * DM * 2 <= WS_H && WS_TQV1 + TQV_REGION <= WS_TQV0 && WS_TQV0 + TQV_REGION <= WS_WTIN + (size_t)67 * 256 * DM * 2 && WS_TQV2 + TQV_REGION <= WS_TQV3 && WS_TQV3 + TQV_REGION <= WS_END, "d_ws map");
constexpr int CW_HCNT = 520, CW_WCNT = 560;
constexpr int CW_BAR = 1024, CW_MODCNT = 512, CW_FLAGS = 8192;

constexpr int RING_BYTES = 131072;
constexpr int LDS_BYTES = 163840;
constexpr int SMALL_OFF = 159744;
constexpr int LDSCTL_OFF = 162816, MISC_OFF = LDSCTL_OFF + 320;

#define GAS __attribute__((address_space(1)))
#define LAS __attribute__((address_space(3)))
typedef unsigned short bf16;
typedef unsigned v4u __attribute__((ext_vector_type(4)));
typedef float f32x4 __attribute__((ext_vector_type(4)));
typedef GAS unsigned gu32;
#define RLX_AGENT __ATOMIC_RELAXED, __HIP_MEMORY_SCOPE_AGENT
#define LDS_WAIT() asm volatile("s_waitcnt lgkmcnt(0)" ::: "memory")
#define VM_WAIT() asm volatile("s_waitcnt vmcnt(0)" ::: "memory")
__device__ __forceinline__ unsigned f2bf(float f) { unsigned u = __builtin_bit_cast(unsigned, f); return (u + 0x7fffu + ((u >> 16) & 1u)) >> 16; }
typedef float f32x2_t_ __attribute__((ext_vector_type(2))); typedef __bf16 bf16x2_t_ __attribute__((ext_vector_type(2)));
__device__ __forceinline__ unsigned cvtpk(float lo, float hi) { f32x2_t_ v = {lo, hi}; bf16x2_t_ b = __builtin_convertvector(v, bf16x2_t_); return __builtin_bit_cast(unsigned, b); }
__device__ __forceinline__ unsigned pk2(float lo, float hi) { return cvtpk(lo, hi); }
__device__ __forceinline__ float bf2f(bf16 v) { return __uint_as_float((unsigned)v << 16); }
__device__ __forceinline__ float blo(unsigned w) { return __uint_as_float(w << 16); }
__device__ __forceinline__ float bhi(unsigned w) { return __uint_as_float(w & 0xffff0000u); }
__device__ __forceinline__ float siluf_(float x) { return x * __builtin_amdgcn_rcpf(1.0f + __builtin_amdgcn_exp2f(-1.4426950408889634f * x)); }
__device__ __forceinline__ float sigm_(float x) { return __builtin_amdgcn_rcpf(1.0f + __builtin_amdgcn_exp2f(-1.4426950408889634f * x)); }

#define XB_TMO      128
#define XB_XCNT(j)  (256  + 64 * (j))
#define XB_XSUB(j)  (1280 + 64 * (j))
#define XB_XGEN(j)  (2304 + 64 * (j))
#define XB_TOP      3328
#define XB_TOPGEN   3392
#define XCD_BAR_WORDS 3456
#define XB_SPIN_CAP (1u << 18)

__device__ __forceinline__ unsigned xb_ld(unsigned* p)              { return __hip_atomic_load(p, __ATOMIC_RELAXED, __HIP_MEMORY_SCOPE_AGENT); }
__device__ __forceinline__ unsigned xb_add(unsigned* p, unsigned v) { return __hip_atomic_fetch_add(p, v, __ATOMIC_RELAXED, __HIP_MEMORY_SCOPE_AGENT); }
__device__ __forceinline__ unsigned xb_xcc_id() { return (unsigned)__builtin_amdgcn_s_getreg((3 << 11) | 20) & 0xFu; }
#define XB_SPIN(cond, bar) do { unsigned _sp = 0; while (cond) { __builtin_amdgcn_s_sleep(8); \
    if ((++_sp & 255u) == 0u) { if (xb_ld(&(bar)[XB_TMO])) break; if (_sp > XB_SPIN_CAP) { atomicAdd(&(bar)[XB_TMO], 1u); break; } } } } while (0)

struct XcdBarrier {
    unsigned* bar; unsigned x;
    volatile LAS unsigned* st;
};

__device__ __forceinline__ XcdBarrier xcd_barrier_post(unsigned* bar, volatile LAS unsigned* st) {
    XcdBarrier b; b.bar = bar; b.x = xb_xcc_id(); b.st = st;
    if (threadIdx.x == 0) (void)xb_add(&bar[XB_XCNT(b.x)], 1u);
    return b;
}
__device__ __forceinline__ void xcd_barrier_complete(unsigned* bar, unsigned x, unsigned& nloc, unsigned& nx) {
    const unsigned G = gridDim.x * gridDim.y * gridDim.z;
    unsigned sum, cnt, mine, sp = 0u;
    for (;;) {
        sum = 0u; cnt = 0u; mine = 0u;
#pragma unroll
        for (unsigned j = 0; j < 16; ++j) { const unsigned c = xb_ld(&bar[XB_XCNT(j)]); sum += c; cnt += (c > 0u) ? 1u : 0u; mine = (j == x) ? c : mine; }
        if (sum == G) break;
        __builtin_amdgcn_s_sleep(1);
        if ((++sp & 255u) == 0u) { if (xb_ld(&bar[XB_TMO])) break; if (sp > XB_SPIN_CAP) { atomicAdd(&bar[XB_TMO], 1u); break; } }
    }
    nloc = mine > 0u ? mine : 1u; nx = cnt > 0u ? cnt : 1u;
}

__device__ __forceinline__ void xcd_barrier(const XcdBarrier& b) {
    asm volatile("s_waitcnt vmcnt(0)" ::: "memory");
    __syncthreads();
    if (threadIdx.x == 0) {
        unsigned* bar = b.bar;
        __builtin_amdgcn_s_waitcnt(0);
        unsigned nloc = b.st[0], nx = b.st[1];
        if (nloc == 0u) { xcd_barrier_complete(bar, b.x, nloc, nx); b.st[0] = nloc; b.st[1] = nx; }
        const unsigned old = xb_add(&bar[XB_XSUB(b.x)], 1u);
        const unsigned gen = old / nloc;
        if (old + 1u == (gen + 1u) * nloc) {
            __builtin_amdgcn_fence(__ATOMIC_RELEASE, "agent");
            asm volatile("s_waitcnt vmcnt(0)" ::: "memory");
            const unsigned og = xb_add(&bar[XB_TOP], 1u);
            const unsigned tg = og / nx;
            if (og + 1u == (tg + 1u) * nx) xb_add(&bar[XB_TOPGEN], 1u);
            else XB_SPIN(xb_ld(&bar[XB_TOPGEN]) == tg, bar);
            __builtin_amdgcn_fence(__ATOMIC_ACQUIRE, "agent");
            xb_add(&bar[XB_XGEN(b.x)], 1u);
            asm volatile("s_waitcnt vmcnt(0)" ::: "memory");
        } else {
            XB_SPIN(xb_ld(&bar[XB_XGEN(b.x)]) == gen, bar);
            __builtin_amdgcn_fence(__ATOMIC_ACQUIRE, "agent");
            asm volatile("s_waitcnt vmcnt(0)" ::: "memory");
        }
    }
    __syncthreads();
}

struct Frame {
    LAS unsigned char* lds;
    volatile LAS unsigned* MISC;
    gu32* ctl;
    int tid, lane, wave;
    int vcu, G;
    const float *x, *c; const int* positions; const float *w_ada, *b_ada, *norm_w, *w_in, *q_norm_w, *k_norm_w, *sinks, *conv_w, *a_log, *dt_bias, *dn_norm_w, *w_o_swa, *w_o_dn, *w_out;
    float* out;
    float* modacc; bf16 *WTIN, *WOCAT, *WOUT, *H, *PROJ, *A2, *Y; float *ROPE, *DBA; unsigned char *KQ; unsigned char* ws;
};

__device__ __forceinline__ float wave_sum(float v) {
#pragma unroll
    for (int o = 1; o < 64; o <<= 1) v += __shfl_xor(v, o);
    return v;
}

__device__ __forceinline__ void st16_wt0(void* p, v4u v) { asm volatile("global_store_dwordx4 %0, %1, off sc0 sc1\n\ts_nop 1" :: "v"(p), "v"(v) : "memory"); }
__device__ __forceinline__ void p0_transpose_item(const float* W, int ldw, bf16* WT, int ldo, int k_off, int k0, int n_src0, int n_dst0, LAS float* scr, int lane, const bool wt = false) {
    const int c = lane & 7;
    if (n_src0 < 0) {
#pragma unroll
        for (int j = 0; j < 4; ++j) { const int n = (lane >> 3) + 8 * j; bf16* dp = WT + (size_t)(n_dst0 + n) * ldo + k_off + k0 + 8 * c;
            if (wt) st16_wt0(dp, (v4u){0u, 0u, 0u, 0u}); else *(GAS v4u*)dp = (v4u){0u, 0u, 0u, 0u}; }
        return;
    }
    {
        f32x4 v[8];
#pragma unroll
        for (int i = 0; i < 8; ++i) { const int kk = 8 * i + (lane >> 3); v[i] = __builtin_nontemporal_load((const f32x4*)(W + (size_t)(k0 + kk) * ldw + n_src0 + 4 * c)); }
#pragma unroll
        for (int i = 0; i < 8; ++i) { const int kk = 8 * i + (lane >> 3); LAS float* d = scr + kk * 33 + 4 * c; d[0] = v[i].x; d[1] = v[i].y; d[2] = v[i].z; d[3] = v[i].w; }
    }
    LDS_WAIT(); asm volatile("" ::: "memory");
#pragma unroll
    for (int j = 0; j < 4; ++j) { const int n = (lane >> 3) + 8 * j; const LAS float* s = scr + (8 * c) * 33 + n;
        v4u o; o.x = pk2(s[0 * 33], s[1 * 33]); o.y = pk2(s[2 * 33], s[3 * 33]); o.z = pk2(s[4 * 33], s[5 * 33]); o.w = pk2(s[6 * 33], s[7 * 33]);
        bf16* dp = WT + (size_t)(n_dst0 + n) * ldo + k_off + k0 + 8 * c;
        if (wt) st16_wt0(dp, o); else *(GAS v4u*)dp = o; }
    LDS_WAIT(); asm volatile("" ::: "memory");
}
__device__ __forceinline__ int proj_src_col(int n) {
    if (n < C_DZ) return 4608 + n;
    if (n < C_DBA) return 12800 + (n - C_DZ);
    if (n < C_DBA + 64) return 16896 + (n - C_DBA);
    if (n < C_AQ) return -1;
    if (n < C_AG) return n - C_AQ;
    if (n < C_MGA) return 2560 + (n - C_AG);
    return 16960 + (n - C_MGA);
}

__device__ __forceinline__ void p0_prologue(Frame& F) {
    LAS float* scr = (LAS float*)(F.lds + F.wave * 16384);
    const int gw = F.vcu * NWAVES + F.wave, NGW = F.G * NWAVES;
    int nmod = 0;
    for (int bi = F.vcu; bi < 8 * 24; bi += F.G) {
        const int kc = (bi / 24) * 8 + F.wave, cg = bi % 24;
        f32x4 a0 = {0.f, 0.f, 0.f, 0.f}, a1 = {0.f, 0.f, 0.f, 0.f};
        const float* wp = F.w_ada + (size_t)(kc * 32) * 6144 + cg * 256 + F.lane * 4;
#pragma unroll 8
        for (int r = 0; r < 32; ++r) { const int k = kc * 32 + r; const float s0 = siluf_(F.c[k]), s1 = siluf_(F.c[DM + k]); const f32x4 w = __builtin_nontemporal_load((const f32x4*)(wp + (size_t)r * 6144)); a0 += s0 * w; a1 += s1 * w; }
        LAS float* red = (LAS float*)F.lds;
        *(LAS f32x4*)(red + (F.wave * 2 + 0) * 256 + F.lane * 4) = a0; *(LAS f32x4*)(red + (F.wave * 2 + 1) * 256 + F.lane * 4) = a1;
        __syncthreads();
        { const int bt = F.tid >> 8, col = F.tid & 255; float sum = 0.f;
#pragma unroll
          for (int w = 0; w < 8; ++w) sum += red[(w * 2 + bt) * 256 + col];
          atomicAdd(F.modacc + bt * 6144 + cg * 256 + col, sum); }
        __syncthreads();
        ++nmod;
    }
    if (nmod) { asm volatile("s_waitcnt vmcnt(0)" ::: "memory"); __syncthreads(); if (F.tid == 0) __hip_atomic_fetch_add((unsigned*)(F.ctl + CW_MODCNT), (unsigned)nmod, __ATOMIC_RELAXED, __HIP_MEMORY_SCOPE_AGENT); }
    {
        const int gt = (F.vcu * NWAVES + F.wave) * 64 + F.lane, NGT = NGW * 64;
        for (int idx = gt; idx < MTOK * 8; idx += NGT) {
            const int m = idx >> 3, j = idx & 7;
            const unsigned fb = j == 0 ? 0x3f800000u : j == 1 ? 0x3e4693afu : j == 2 ? 0x3d1a08c8u : j == 3 ? 0x3beef74eu : j == 4 ? 0x3ab95d22u : j == 5 ? 0x398fc8f8u : j == 6 ? 0x385f10c5u : 0x372d07a8u;
            const float ang = (float)F.positions[m] * __uint_as_float(fb);
            const double a = (double)ang;
            const double kq = __builtin_rint(a * 0.63661977236758134308);
            const double s = (a - kq * 1.57079632679489655800) - kq * 6.12323399573676603587e-17;
            const double s2 = s * s;
            const double sn = s * (1.0 + s2 * (-1.0 / 6 + s2 * (1.0 / 120 + s2 * (-1.0 / 5040 + s2 * (1.0 / 362880 + s2 * (-1.0 / 39916800 + s2 * (1.0 / 6227020800.0)))))));
            const double cs = 1.0 + s2 * (-0.5 + s2 * (1.0 / 24 + s2 * (-1.0 / 720 + s2 * (1.0 / 40320 + s2 * (-1.0 / 3628800 + s2 * (1.0 / 479001600 + s2 * (-1.0 / 87178291200.0)))))));
            const int q = ((int)kq) & 3;
            const double cv = q == 0 ? cs : q == 1 ? -sn : q == 2 ? -cs : sn;
            const double sv = q == 0 ? sn : q == 1 ? cs : q == 2 ? -sn : -cs;
            F.ROPE[(size_t)m * 16 + j] = (float)cv; F.ROPE[(size_t)m * 16 + 8 + j] = (float)sv;
        }
    }
}
__device__ __forceinline__ void p3_outw_convert(Frame& F, int rank, int nb) {
    LAS float* scr = (LAS float*)(F.lds + F.wave * 16384);
    const int gw = rank * NWAVES + F.wave, NGW = nb * NWAVES;
    constexpr int I_OS = (DM / 64) * (DM / 32), I_OD = (4096 / 64) * (DM / 32), I_OUT = (DM / 64) * (DM / 32);
    for (int it = gw; it < I_OS + I_OD + I_OUT; it += NGW) {
        int r = it;
        if (r < I_OS) { const int kb = r / (DM / 32), nb = r % (DM / 32); p0_transpose_item(F.w_o_swa, DM, F.WOCAT, KCAT, 0, 64 * kb, 32 * nb, 32 * nb, scr, F.lane); continue; } r -= I_OS;
        if (r < I_OD) { const int kb = r / (DM / 32), nb = r % (DM / 32); p0_transpose_item(F.w_o_dn, DM, F.WOCAT, KCAT, 2048, 64 * kb, 32 * nb, 32 * nb, scr, F.lane); continue; } r -= I_OD;
        { const int kb = r / (DM / 32), nb = r % (DM / 32); p0_transpose_item(F.w_out, DM, F.WOUT, DM, 0, 64 * kb, 32 * nb, 32 * nb, scr, F.lane); }
    }
}

__device__ __forceinline__ void cv_load(const float* W, int ldw, int k0, int n_src0, int lane, f32x4 (&v)[8]) {
    if (n_src0 < 0) return;
#pragma unroll
    for (int i = 0; i < 8; ++i) { const int kk = 8 * i + (lane >> 3); v[i] = __builtin_nontemporal_load((const f32x4*)(W + (size_t)(k0 + kk) * ldw + n_src0 + 4 * (lane & 7))); }
}
__device__ __forceinline__ void cv_finish(const f32x4 (&v)[8], bf16* WT, int ldo, int k_off, int k0, int n_src0, int n_dst0, LAS float* scr, int lane, const bool wt) {
    const int c = lane & 7;
    if (n_src0 < 0) {
#pragma unroll
        for (int j = 0; j < 4; ++j) { const int n = (lane >> 3) + 8 * j; bf16* dp = WT + (size_t)(n_dst0 + n) * ldo + k_off + k0 + 8 * c;
            if (wt) st16_wt0(dp, (v4u){0u, 0u, 0u, 0u}); else *(GAS v4u*)dp = (v4u){0u, 0u, 0u, 0u}; }
        return;
    }
#pragma unroll
    for (int i = 0; i < 8; ++i) { const int kk = 8 * i + (lane >> 3); LAS float* d = scr + kk * 33 + 4 * c; d[0] = v[i].x; d[1] = v[i].y; d[2] = v[i].z; d[3] = v[i].w; }
    LDS_WAIT(); asm volatile("" ::: "memory");
#pragma unroll
    for (int j = 0; j < 4; ++j) { const int n = (lane >> 3) + 8 * j; const LAS float* sp = scr + (8 * c) * 33 + n;
        v4u o; o.x = pk2(sp[0 * 33], sp[1 * 33]); o.y = pk2(sp[2 * 33], sp[3 * 33]); o.z = pk2(sp[4 * 33], sp[5 * 33]); o.w = pk2(sp[6 * 33], sp[7 * 33]);
        bf16* dp = WT + (size_t)(n_dst0 + n) * ldo + k_off + k0 + 8 * c;
        if (wt) st16_wt0(dp, o); else *(GAS v4u*)dp = o; }
    LDS_WAIT(); asm volatile("" ::: "memory");
}
__device__ __forceinline__ void p0_win_convert_teamB(Frame& F, int q, int bt0, int bt1) {
    LAS float* scr = (LAS float*)(F.lds + F.wave * 16384);
    const int gw = q * NWAVES + F.wave;
#pragma unroll 1
    for (int bt = bt0; bt < bt1; ++bt) {
        const int ga = bt == 0 ? 0 : (bt == 1 ? 1 : (bt == 2 ? 3 : 9)), gb = bt == 0 ? 1 : (bt == 1 ? 3 : (bt == 2 ? 9 : 11));
        const int gmid = gb < 10 ? gb : 10, T = (gmid - ga) * 2048 + (gb > 10 ? 768 : 0);
        auto decode = [&](int t, int& k0, int& nsrc, int& ndst) {
            int g, li; if (t < (gmid - ga) * 2048) { g = ga + (t >> 11); li = t & 2047; } else { g = 10; li = t - (10 - ga) * 2048; }
            const int nbg = g < 10 ? 64 : 24, kb = li / nbg, nb = 64 * g + li % nbg; k0 = 64 * kb; ndst = 32 * nb; nsrc = proj_src_col(32 * nb); };
        f32x4 va[8], vb[8]; int k0a = 0, nsa = 0, nda = 0, k0b = 0, nsb = 0, ndb = 0;
        int t = gw;
        if (t < T) { decode(t, k0a, nsa, nda); cv_load(F.w_in, IN_WIDTH, k0a, nsa, F.lane, va); }
#pragma unroll 1
        while (t < T) {
            const int t2 = t + 128 * NWAVES; const bool hb = t2 < T;
            if (hb) { decode(t2, k0b, nsb, ndb); cv_load(F.w_in, IN_WIDTH, k0b, nsb, F.lane, vb); }
            cv_finish(va, F.WTIN, DM, 0, k0a, nsa, nda, scr, F.lane, true);
            if (!hb) break;
            const int t3 = t2 + 128 * NWAVES; const bool ha = t3 < T;
            if (ha) { decode(t3, k0a, nsa, nda); cv_load(F.w_in, IN_WIDTH, k0a, nsa, F.lane, va); }
            cv_finish(vb, F.WTIN, DM, 0, k0b, nsb, ndb, scr, F.lane, true);
            if (!ha) break;
            t = t3;
        }
        asm volatile("s_waitcnt vmcnt(0)" ::: "memory");
        __syncthreads();
        if (F.tid == 0) for (int gg = ga; gg < gb; ++gg) __hip_atomic_fetch_add((unsigned*)(F.ctl + CW_WCNT) + gg, 1u, RLX_AGENT);
    }
}

__device__ __forceinline__ void p1_hrows(Frame& F, int pm, int tj) {
    const int m0 = pm * 256 + tj * 32 + F.wave * 4;
    f32x4 xv[4][8]; float rs[4];
    {
        const GAS f32x4* x0 = (const GAS f32x4*)(F.x + (size_t)m0 * DM) + F.lane;
#pragma unroll
        for (int r = 0; r < 4; ++r)
#pragma unroll
            for (int j = 0; j < 8; ++j) xv[r][j] = x0[(size_t)r * (DM / 4) + 64 * j];
#pragma unroll
        for (int r = 0; r < 4; ++r) { float s = 0.f;
#pragma unroll
            for (int j = 0; j < 8; ++j) s += (xv[r][j].x * xv[r][j].x + xv[r][j].y * xv[r][j].y) + (xv[r][j].z * xv[r][j].z + xv[r][j].w * xv[r][j].w);
            rs[r] = rsqrtf(wave_sum(s) * (1.f / DM) + EPS); }
    }
    {
        unsigned spins = 0;
        if (F.wave == 0) {
            while ((unsigned)__builtin_amdgcn_readfirstlane((int)__hip_atomic_load((unsigned*)(F.ctl + CW_MODCNT), __ATOMIC_RELAXED, __HIP_MEMORY_SCOPE_AGENT)) < 8u * 24u) {
                __builtin_amdgcn_s_sleep(16); if (++spins > (1u << 21)) { if (F.lane == 0) atomicAdd((unsigned*)(F.ctl + CW_BAR) + XB_TMO, 1u); break; } } }
        __syncthreads();
        asm volatile("" ::: "memory");
    }
    __builtin_amdgcn_fence(__ATOMIC_ACQUIRE, "agent");
    const int b = (pm * 256) / SEQ;
#pragma unroll
    for (int j = 0; j < 8; ++j) { const int col = 4 * F.lane + 256 * j;
        const f32x4 sh = *(const f32x4*)(F.modacc + (size_t)b * 6144 + col) + *(const f32x4*)(F.b_ada + col);
        const f32x4 sc = *(const f32x4*)(F.modacc + (size_t)b * 6144 + DM + col) + *(const f32x4*)(F.b_ada + DM + col);
        const f32x4 mulv = *(const f32x4*)(F.norm_w + col) * (1.0f + sc);
#pragma unroll
        for (int r = 0; r < 4; ++r) { const f32x4 hv = (xv[r][j] * rs[r]) * mulv + sh;
            __hip_atomic_store((unsigned long long*)((GAS unsigned long long*)(F.H + (size_t)(m0 + r) * DM) + F.lane + 64 * j), (unsigned long long)pk2(hv.x, hv.y) | ((unsigned long long)pk2(hv.z, hv.w) << 32), RLX_AGENT); }
    }
    asm volatile("s_waitcnt vmcnt(0)" ::: "memory");
    __syncthreads();
    if (F.tid == 0) __hip_atomic_fetch_add((unsigned*)(F.ctl + CW_HCNT) + pm, 1u, RLX_AGENT);
}

__device__ __forceinline__ void p3_attn_item_simple(Frame& F, int b, int n, int hk) {
    LAS float* Kl = (LAS float*)F.lds; LAS float* Vl = Kl + 256 * 64;
    const int tid = F.tid;
    {
        const int key = tid >> 1, half = tid & 1; const int tok = n * 128 - 128 + key;
        float kv[32], vv[32];
        if (tok >= 0) {
            const size_t row = (size_t)b * SEQ + tok;
            const v4u* kp = (const v4u*)(F.PROJ + row * NP + C_AK + hk * 64 + half * 32);
            const v4u* vp = (const v4u*)(F.PROJ + row * NP + C_AV + hk * 64 + half * 32);
#pragma unroll
            for (int i = 0; i < 4; ++i) { const v4u a = kp[i], c = vp[i];
                kv[8 * i + 0] = blo(a.x); kv[8 * i + 1] = bhi(a.x); kv[8 * i + 2] = blo(a.y); kv[8 * i + 3] = bhi(a.y); kv[8 * i + 4] = blo(a.z); kv[8 * i + 5] = bhi(a.z); kv[8 * i + 6] = blo(a.w); kv[8 * i + 7] = bhi(a.w);
                vv[8 * i + 0] = blo(c.x); vv[8 * i + 1] = bhi(c.x); vv[8 * i + 2] = blo(c.y); vv[8 * i + 3] = bhi(c.y); vv[8 * i + 4] = blo(c.z); vv[8 * i + 5] = bhi(c.z); vv[8 * i + 6] = blo(c.w); vv[8 * i + 7] = bhi(c.w); }
            float ss = 0.f;
#pragma unroll
            for (int d = 0; d < 32; ++d) ss += kv[d] * kv[d];
            ss += __shfl_xor(ss, 1);
            const float rs = rsqrtf(ss * (1.f / 64.f) + EPS);
#pragma unroll
            for (int d = 0; d < 32; ++d) kv[d] = kv[d] * rs * F.k_norm_w[half * 32 + d];
            if (half == 0) {
                const float* cs = F.ROPE + row * 16;
#pragma unroll
                for (int d = 0; d < 8; ++d) { const float x1 = kv[d], x2 = kv[8 + d], c = cs[d], s = cs[8 + d]; kv[d] = x1 * c - x2 * s; kv[8 + d] = x2 * c + x1 * s; }
            }
        } else {
#pragma unroll
            for (int d = 0; d < 32; ++d) { kv[d] = 0.f; vv[d] = 0.f; }
        }
#pragma unroll
        for (int d = 0; d < 32; d += 4) { *(LAS f32x4*)(Kl + key * 64 + half * 32 + d) = (f32x4){kv[d], kv[d + 1], kv[d + 2], kv[d + 3]}; *(LAS f32x4*)(Vl + key * 64 + half * 32 + d) = (f32x4){vv[d], vv[d + 1], vv[d + 2], vv[d + 3]}; }
    }
    __syncthreads();
    for (int pass = 0; pass < 2; ++pass) {
        const int g = (tid >> 7) + 4 * pass, i = tid & 127, h = hk * 8 + g;
        const size_t row = (size_t)b * SEQ + n * 128 + i;
        float q[64], o[64];
        {
            const v4u* qp = (const v4u*)(F.PROJ + row * NP + C_AQ + h * 64);
#pragma unroll
            for (int k = 0; k < 8; ++k) { const v4u a = qp[k];
                q[8 * k + 0] = blo(a.x); q[8 * k + 1] = bhi(a.x); q[8 * k + 2] = blo(a.y); q[8 * k + 3] = bhi(a.y); q[8 * k + 4] = blo(a.z); q[8 * k + 5] = bhi(a.z); q[8 * k + 6] = blo(a.w); q[8 * k + 7] = bhi(a.w); }
            float ss = 0.f;
#pragma unroll
            for (int d = 0; d < 64; ++d) ss += q[d] * q[d];
            const float rs = rsqrtf(ss * (1.f / 64.f) + EPS);
#pragma unroll
            for (int d = 0; d < 64; ++d) q[d] = q[d] * rs * F.q_norm_w[d];
            const float* cs = F.ROPE + row * 16;
#pragma unroll
            for (int d = 0; d < 8; ++d) { const float x1 = q[d], x2 = q[8 + d], c = cs[d], s = cs[8 + d]; q[d] = x1 * c - x2 * s; q[8 + d] = x2 * c + x1 * s; }
#pragma unroll
            for (int d = 0; d < 64; ++d) { q[d] *= 0.125f; o[d] = 0.f; }
        }
        float m = F.sinks[h], l = 1.0f;
        const int i0 = i & ~63;
        int jlo = i0 + 1, jhi = i0 + 63 + 128; if (n == 0 && jlo < 128) jlo = 128;
        for (int jj = jlo; jj <= jhi; ++jj) {
            const bool valid = (jj > i) && (jj <= i + 128);
            if (valid) {
                float s = 0.f;
#pragma unroll
                for (int d = 0; d < 64; d += 4) { const f32x4 kk = *(const LAS f32x4*)(Kl + jj * 64 + d); s += q[d] * kk.x + q[d + 1] * kk.y + q[d + 2] * kk.z + q[d + 3] * kk.w; }
                if (s > m) { const float sc = __expf(m - s); l *= sc;
#pragma unroll
                    for (int d = 0; d < 64; ++d) o[d] *= sc;
                    m = s; }
                const float p = __expf(s - m); l += p;
#pragma unroll
                for (int d = 0; d < 64; d += 4) { const f32x4 vv = *(const LAS f32x4*)(Vl + jj * 64 + d); o[d] += p * vv.x; o[d + 1] += p * vv.y; o[d + 2] += p * vv.z; o[d + 3] += p * vv.w; }
            }
        }
        const float inv = __builtin_amdgcn_rcpf(l);
        const v4u* gp = (const v4u*)(F.PROJ + row * NP + C_AG + h * 64);
        v4u* op = (v4u*)(F.A2 + row * KCAT + h * 64);
#pragma unroll
        for (int k = 0; k < 8; ++k) { const v4u a = gp[k]; v4u w;
            w.x = pk2(o[8 * k + 0] * inv * blo(a.x), o[8 * k + 1] * inv * bhi(a.x));
            w.y = pk2(o[8 * k + 2] * inv * blo(a.y), o[8 * k + 3] * inv * bhi(a.y));
            w.z = pk2(o[8 * k + 4] * inv * blo(a.z), o[8 * k + 5] * inv * bhi(a.z));
            w.w = pk2(o[8 * k + 6] * inv * blo(a.w), o[8 * k + 7] * inv * bhi(a.w));
            op[k] = w; }
    }
    __syncthreads();
}


typedef short bf16x8_t __attribute__((ext_vector_type(8)));
typedef short s16x4_t __attribute__((ext_vector_type(4)));
typedef float f32x16 __attribute__((ext_vector_type(16)));
typedef unsigned u32x2_t __attribute__((ext_vector_type(2)));
#define ACC_FRAG(X, s) __builtin_bit_cast(bf16x8_t, (v4u){cvtpk((X)[8 * (s) + 0], (X)[8 * (s) + 1]), cvtpk((X)[8 * (s) + 2], (X)[8 * (s) + 3]), cvtpk((X)[8 * (s) + 4], (X)[8 * (s) + 5]), cvtpk((X)[8 * (s) + 6], (X)[8 * (s) + 7])})
__device__ __forceinline__ s16x4_t lds_tr16(const LAS unsigned char* p) { typedef short v4i16_t __attribute__((ext_vector_type(4))); return __builtin_bit_cast(s16x4_t, __builtin_amdgcn_ds_read_tr16_b64_v4i16((LAS v4i16_t*)p)); }
#define MFMA32(A, B, C) __builtin_amdgcn_mfma_f32_32x32x16_bf16((A), (B), (C), 0, 0, 0)
struct TrAddr { unsigned a0, a1; };
__device__ __forceinline__ TrAddr tr_addr(int lane) {
    const int g16 = lane >> 4, dhalf = g16 & 1, hh = g16 >> 1, q = (lane & 15) >> 2, p = lane & 3;
    TrAddr t;
    const int cl0 = 4 * hh + q, cl1 = 8 + 4 * hh + q, sw = 4 * (p & 1) + 8 * dhalf;
    t.a0 = (unsigned)((dhalf * 64 + (p & 1) * 32 + (cl0 ^ sw)) * 16 + (p >> 1) * 8);
    t.a1 = (unsigned)((dhalf * 64 + (p & 1) * 32 + (cl1 ^ sw)) * 16 + (p >> 1) * 8);
    return t;
}
__device__ __forceinline__ bf16x8_t tr_frag(const LAS unsigned char* tile, const TrAddr& t, int ct, int s) {
    const s16x4_t lo = lds_tr16(tile + t.a0 + ct * 2048 + s * 256), hi = lds_tr16(tile + t.a1 + ct * 2048 + s * 256);
    return (bf16x8_t){lo[0], lo[1], lo[2], lo[3], hi[0], hi[1], hi[2], hi[3]};
}

__device__ __forceinline__ void p3_attn_item(Frame& F, int b, int n, int hk) {
    LAS unsigned char* Kimg = F.lds; LAS unsigned char* Vimg = F.lds + 32768;
    LAS float* qnwL = (LAS float*)(F.lds + 65536);
    const int tid = F.tid, lane = F.lane;
    const int r = lane & 31, hh = lane >> 5, g = F.wave, h = hk * 8 + g;
    v4u qraw[4]; f32x4 qcs[4];
#define ATT_LOADQ(qi_) do { const size_t row_ = (size_t)b * SEQ + n * 128 + 32 * (qi_) + r; \
        _Pragma("unroll") for (int ks = 0; ks < 4; ++ks) qraw[ks] = *(const v4u*)(F.PROJ + row_ * NP + C_AQ + h * 64 + 16 * ks + 8 * hh); \
        _Pragma("unroll") for (int i = 0; i < 4; ++i) qcs[i] = *(const f32x4*)(F.ROPE + row_ * 16 + 4 * i); } while (0)
    {
        const int key = tid >> 1, half = tid & 1; const int tok = n * 128 - 128 + key;
        const int kt = key >> 5, rk = key & 31;
        float kv[32]; v4u vraw[4]; v4u kraw[4]; f32x4 kcs[4];
        const bool have = tok >= 0;
        {
            const size_t row = (size_t)b * SEQ + (have ? tok : 0);
            const v4u* kp = (const v4u*)(F.PROJ + row * NP + C_AK + hk * 64 + half * 32);
            const v4u* vp = (const v4u*)(F.PROJ + row * NP + C_AV + hk * 64 + half * 32);
#pragma unroll
            for (int i = 0; i < 4; ++i) { kraw[i] = kp[i]; vraw[i] = vp[i]; kcs[i] = *(const f32x4*)(F.ROPE + row * 16 + 4 * i); }
        }
        ATT_LOADQ(0);
        if (tid < 64) qnwL[tid] = F.q_norm_w[tid];
        if (have) {
#pragma unroll
            for (int i = 0; i < 4; ++i) { const v4u a = kraw[i];
                kv[8 * i + 0] = blo(a.x); kv[8 * i + 1] = bhi(a.x); kv[8 * i + 2] = blo(a.y); kv[8 * i + 3] = bhi(a.y); kv[8 * i + 4] = blo(a.z); kv[8 * i + 5] = bhi(a.z); kv[8 * i + 6] = blo(a.w); kv[8 * i + 7] = bhi(a.w); }
            float ss = 0.f;
#pragma unroll
            for (int d = 0; d < 32; ++d) ss += kv[d] * kv[d];
            ss += __shfl_xor(ss, 1);
            const float rs = rsqrtf(ss * (1.f / 64.f) + EPS);
#pragma unroll
            for (int d = 0; d < 32; ++d) kv[d] = kv[d] * rs * F.k_norm_w[half * 32 + d];
            if (half == 0) {
                const float cs[16] = {kcs[0].x, kcs[0].y, kcs[0].z, kcs[0].w, kcs[1].x, kcs[1].y, kcs[1].z, kcs[1].w, kcs[2].x, kcs[2].y, kcs[2].z, kcs[2].w, kcs[3].x, kcs[3].y, kcs[3].z, kcs[3].w};
#pragma unroll
                for (int d = 0; d < 8; ++d) { const float x1 = kv[d], x2 = kv[8 + d], c = cs[d], s = cs[8 + d]; kv[d] = x1 * c - x2 * s; kv[8 + d] = x2 * c + x1 * s; }
            }
        } else {
#pragma unroll
            for (int d = 0; d < 32; ++d) kv[d] = 0.f;
#pragma unroll
            for (int i = 0; i < 4; ++i) vraw[i] = (v4u){0u, 0u, 0u, 0u};
        }
#pragma unroll
        for (int ck = 0; ck < 4; ++ck) {
            const int ks = half * 2 + (ck >> 1), h2 = ck & 1, e = ck & 1;
            v4u w; w.x = pk2(kv[8 * ck + 0], kv[8 * ck + 1]); w.y = pk2(kv[8 * ck + 2], kv[8 * ck + 3]); w.z = pk2(kv[8 * ck + 4], kv[8 * ck + 5]); w.w = pk2(kv[8 * ck + 6], kv[8 * ck + 7]);
            *(LAS v4u*)(Kimg + ((kt * 4 + ks) * 64 + h2 * 32 + rk) * 16) = w;
            const int sw = 8 * (ks & 1);
            *(LAS u32x2_t*)(Vimg + ((kt * 4 + ks) * 64 + 0 * 32 + (rk ^ (0 + sw))) * 16 + e * 8) = (u32x2_t){vraw[ck].x, vraw[ck].y};
            *(LAS u32x2_t*)(Vimg + ((kt * 4 + ks) * 64 + 1 * 32 + (rk ^ (4 + sw))) * 16 + e * 8) = (u32x2_t){vraw[ck].z, vraw[ck].w};
        }
    }
    __syncthreads();
    const TrAddr tra = tr_addr(lane);
    const float sink = F.sinks[h];
    for (int qi = 0; qi < 4; ++qi) {
        const size_t row = (size_t)b * SEQ + n * 128 + 32 * qi + r;
        u32x2_t gq[8];
#pragma unroll
        for (int mt = 0; mt < 2; ++mt)
#pragma unroll
            for (int gg = 0; gg < 4; ++gg) gq[mt * 4 + gg] = *(const u32x2_t*)(F.PROJ + row * NP + C_AG + h * 64 + 32 * mt + 8 * gg + 4 * hh);
        bf16x8_t qf[4];
        {
            float q[32];
#pragma unroll
            for (int ks = 0; ks < 4; ++ks) { const v4u a = qraw[ks];
                q[8 * ks + 0] = blo(a.x); q[8 * ks + 1] = bhi(a.x); q[8 * ks + 2] = blo(a.y); q[8 * ks + 3] = bhi(a.y); q[8 * ks + 4] = blo(a.z); q[8 * ks + 5] = bhi(a.z); q[8 * ks + 6] = blo(a.w); q[8 * ks + 7] = bhi(a.w); }
            float ss = 0.f;
#pragma unroll
            for (int d = 0; d < 32; ++d) ss += q[d] * q[d];
            ss += __shfl_xor(ss, 32);
            const float rs = rsqrtf(ss * (1.f / 64.f) + EPS);
#pragma unroll
            for (int ks = 0; ks < 4; ++ks)
#pragma unroll
                for (int j = 0; j < 8; ++j) q[8 * ks + j] = q[8 * ks + j] * rs * qnwL[16 * ks + 8 * hh + j];
            const float cs[16] = {qcs[0].x, qcs[0].y, qcs[0].z, qcs[0].w, qcs[1].x, qcs[1].y, qcs[1].z, qcs[1].w, qcs[2].x, qcs[2].y, qcs[2].z, qcs[2].w, qcs[3].x, qcs[3].y, qcs[3].z, qcs[3].w};
#pragma unroll
            for (int j = 0; j < 8; ++j) { const float own = q[j], oth = __shfl_xor(own, 32), c = cs[j], s = cs[8 + j]; q[j] = own * c + (hh ? oth * s : -oth * s); }
#pragma unroll
            for (int ks = 0; ks < 4; ++ks) { v4u w; w.x = pk2(q[8 * ks + 0] * 0.125f, q[8 * ks + 1] * 0.125f); w.y = pk2(q[8 * ks + 2] * 0.125f, q[8 * ks + 3] * 0.125f); w.z = pk2(q[8 * ks + 4] * 0.125f, q[8 * ks + 5] * 0.125f); w.w = pk2(q[8 * ks + 6] * 0.125f, q[8 * ks + 7] * 0.125f);
                qf[ks] = __builtin_bit_cast(bf16x8_t, w); }
        }
        if (qi < 3) ATT_LOADQ(qi + 1);
        f32x16 st[5];
#pragma unroll
        for (int kp = 0; kp < 5; ++kp) {
            const int kt = qi + kp; f32x16 acc = {};
#pragma unroll
            for (int ks = 0; ks < 4; ++ks) { const bf16x8_t kf = *(const LAS bf16x8_t*)(Kimg + ((kt * 4 + ks) * 64 + lane) * 16); acc = MFMA32(kf, qf[ks], acc); }
            st[kp] = acc;
        }
        const int iq = 32 * qi + r;
        float m = sink;
#pragma unroll
        for (int kp = 0; kp < 5; ++kp)
#pragma unroll
            for (int reg = 0; reg < 16; ++reg) { const int j = 32 * (qi + kp) + (reg & 3) + 8 * (reg >> 2) + 4 * hh;
                const bool valid = (j > iq) && (j <= iq + 128) && (n > 0 || j >= 128);
                const float s = valid ? st[kp][reg] : -1e30f; st[kp][reg] = s; m = fmaxf(m, s); }
        m = fmaxf(m, __shfl_xor(m, 32));
        float l = 0.f;
#pragma unroll
        for (int kp = 0; kp < 5; ++kp)
#pragma unroll
            for (int reg = 0; reg < 16; ++reg) { const float p = __expf(st[kp][reg] - m); st[kp][reg] = p; l += p; }
        l += __shfl_xor(l, 32);
        l += __expf(sink - m);
        f32x16 ot[2];
#pragma unroll
        for (int mt = 0; mt < 2; ++mt) { f32x16 acc = {};
#pragma unroll
            for (int kp = 0; kp < 5; ++kp)
#pragma unroll
                for (int s = 0; s < 2; ++s) { const bf16x8_t vf = tr_frag(Vimg + (qi + kp) * 4096, tra, mt, s); acc = MFMA32(vf, ACC_FRAG(st[kp], s), acc); }
            ot[mt] = acc; }
        const float inv = __builtin_amdgcn_rcpf(l);
#pragma unroll
        for (int mt = 0; mt < 2; ++mt)
#pragma unroll
            for (int gg = 0; gg < 4; ++gg) { const int d = 32 * mt + 8 * gg + 4 * hh;
                const u32x2_t gw = gq[mt * 4 + gg];
                u32x2_t w; w.x = pk2(ot[mt][4 * gg + 0] * inv * blo(gw.x), ot[mt][4 * gg + 1] * inv * bhi(gw.x));
                w.y = pk2(ot[mt][4 * gg + 2] * inv * blo(gw.y), ot[mt][4 * gg + 3] * inv * bhi(gw.y));
                *(u32x2_t*)(F.A2 + row * KCAT + h * 64 + d) = w; }
    }
    __syncthreads();
#undef ATT_LOADQ
}


__device__ __forceinline__ unsigned char* tqv_rec(const Frame& F, int b, int h, int n) {
    const int bh = b * 32 + h, reg = bh >> 4;
    const size_t base = reg == 0 ? WS_TQV0 : (reg == 1 ? WS_TQV1 : (reg == 2 ? WS_TQV2 : WS_TQV3));
    return F.ws + base + ((size_t)(bh & 15) * 64 + n) * 29696;
}
__device__ __forceinline__ void st16_wt(void* p, v4u v) { asm volatile("global_store_dwordx4 %0, %1, off sc0 sc1\n\ts_nop 1" :: "v"(p), "v"(v) : "memory"); }
__device__ __forceinline__ void st4_wt(float* p, float v) { __hip_atomic_store(p, v, __ATOMIC_RELAXED, __HIP_MEMORY_SCOPE_AGENT); }
constexpr int KQ_BYTES = 32768, TQV_BYTES = 29696, TQV_TB = 0, TQV_QK = 6144, TQV_VT = 12288, TQV_VEC = 28672;
constexpr int STAGE_BYTES_DN = KQ_BYTES + TQV_BYTES;
constexpr int OBUF_OFF = 2 * STAGE_BYTES_DN, OBUF_PITCH = 272, OBUF_BYTES = 64 * OBUF_PITCH;

__host__ __device__ constexpr int lt_rowoff(int s) { const int j = (s + 1) >> 2; return j == 0 ? 64 * s : (192 + 256 * (j - 1) - 8 * j * (j - 1)) + (s - (4 * j - 1)) * (64 - 4 * j); }
constexpr int LT_FLOATS = 2112;
static_assert(lt_rowoff(62) + 4 <= LT_FLOATS && lt_rowoff(3) == 192 && lt_rowoff(2) == 128, "packed LT layout");

__device__ __forceinline__ void fnma_(float& acc, float a, float b) { asm("v_fma_f32 %0, -%1, %2, %0" : "+v"(acc) : "v"(a), "v"(b)); }
template <int S_> struct SubstRow {
    static __device__ __forceinline__ void run(float (&X)[64], const LAS float* LT, int lane) {
        constexpr int C0 = ((S_ + 1) / 4) * 4;
        constexpr int NG = (64 - C0) / 4;
        float a0 = (lane == S_) ? 1.0f : 0.0f, a1 = 0.f, a2 = 0.f, a3 = 0.f;
#pragma unroll
        for (int i0 = 0; i0 < NG; i0 += 8) {
            f32x4 l4[8];
#pragma unroll
            for (int i = 0; i < 8; ++i) if (i0 + i < NG) l4[i] = *(const LAS f32x4*)(LT + lt_rowoff(S_) + 4 * (i0 + i));
            __builtin_amdgcn_sched_barrier(0);
#pragma unroll
            for (int i = 0; i < 8; ++i) if (i0 + i < NG) { const int c4 = C0 + 4 * (i0 + i);
                if (c4 + 0 > S_) fnma_(a0, X[c4 + 0], l4[i].x);
                if (c4 + 1 > S_) fnma_(a1, X[c4 + 1], l4[i].y);
                if (c4 + 2 > S_) fnma_(a2, X[c4 + 2], l4[i].z);
                if (c4 + 3 > S_) fnma_(a3, X[c4 + 3], l4[i].w);
            }
        }
        X[S_] = (a0 + a1) + (a2 + a3);
        if constexpr (S_ > 0) SubstRow<S_ - 1>::run(X, LT, lane);
    }
};

constexpr int P3A_VT = 32768, P3A_LT = 65536, P3A_VEC = P3A_LT + 8 * LT_FLOATS * 4;
static_assert(P3A_VEC + 4096 <= 159744, "P3a LDS map");
__device__ __forceinline__ void p3a_phase(Frame& F, int jblk, int nblk) {
    LAS unsigned char* KNimg = F.lds; LAS unsigned char* QNimg = F.lds + 16384; LAS unsigned char* VTst = F.lds + P3A_VT;
    LAS float* LTall = (LAS float*)(F.lds + P3A_LT);
    LAS float* betaL = (LAS float*)(F.lds + P3A_VEC);
    LAS float* gcL = betaL + 512;
    const int w = F.wave;
    const int nunits = (512 - jblk + nblk - 1) / nblk;
    v4u raw[11]; f32x4 cwv[8];
#define P3A_LOADRAW(u_, kk_) do { const int b_ = ((u_) >> 2) & 1, n_ = (u_) >> 3, kh_ = ((u_) & 3) * 4 + (kk_); int ln_ = F.lane; asm volatile("" : "+v"(ln_)); \
        const int wch_ = ln_ < 16 ? kh_ * 128 + ln_ * 8 : (ln_ < 32 ? 2048 + kh_ * 128 + (ln_ - 16) * 8 : 4096 + kh_ * 256 + (ln_ - 32) * 8); \
        _Pragma("unroll") for (int i_ = 0; i_ < 11; ++i_) { const int tt_ = n_ * 64 + 8 * w - 3 + i_; \
            raw[i_] = tt_ >= 0 ? *(const v4u*)(F.PROJ + ((size_t)b_ * SEQ + tt_) * NP + C_DQKV + wch_) : (v4u){0u, 0u, 0u, 0u}; } } while (0)
#define P3A_LOADCW(u_, kk_) do { const int kh_ = ((u_) & 3) * 4 + (kk_); int ln_ = F.lane; asm volatile("" : "+v"(ln_)); \
        const int wch_ = ln_ < 16 ? kh_ * 128 + ln_ * 8 : (ln_ < 32 ? 2048 + kh_ * 128 + (ln_ - 16) * 8 : 4096 + kh_ * 256 + (ln_ - 32) * 8); \
        _Pragma("unroll") for (int j_ = 0; j_ < 4; ++j_) { cwv[2 * j_] = *(const f32x4*)(F.conv_w + j_ * 8192 + wch_); cwv[2 * j_ + 1] = *(const f32x4*)(F.conv_w + j_ * 8192 + wch_ + 4); } } while (0)
    if (nunits > 0) P3A_LOADRAW(jblk, 0);
    for (int ui = 0; ui < nunits; ++ui) {
        const int u = jblk + ui * nblk, b = (u >> 2) & 1, n = u >> 3, kq = u & 3;
        const int t0 = n * 64;
        P3A_LOADCW(u, 0);
        for (int kk = 0; kk < 4; ++kk) {
            int lane = F.lane; asm volatile("" : "+v"(lane));
            const int r = lane & 31, hh = lane >> 5;
            const int kh = kq * 4 + kk;
            {
                const int wch = lane < 16 ? kh * 128 + lane * 8 : (lane < 32 ? 2048 + kh * 128 + (lane - 16) * 8 : 4096 + kh * 256 + (lane - 32) * 8);
                float cw[4][8];
#pragma unroll
                for (int j = 0; j < 4; ++j) { const f32x4 a = cwv[2 * j], c = cwv[2 * j + 1];
                    cw[j][0] = a.x; cw[j][1] = a.y; cw[j][2] = a.z; cw[j][3] = a.w; cw[j][4] = c.x; cw[j][5] = c.y; cw[j][6] = c.z; cw[j][7] = c.w; }
                const float qs = lane < 16 ? 0.08838834764831845f : 1.0f;
                const int l16 = lane & 15, ks = l16 >> 1, odd = l16 & 1, mi = w >> 2;
                const bool isk = lane >= 16;
                LAS unsigned char* img = isk ? KNimg : QNimg;
                unsigned vpk[4][8];
#pragma unroll
                for (int tp = 0; tp < 4; ++tp) {
                    float y[2][8];
#pragma unroll
                    for (int uu = 0; uu < 2; ++uu) { const int t = 2 * tp + uu;
#pragma unroll
                        for (int e = 0; e < 8; ++e) y[uu][e] = 0.f;
#pragma unroll
                        for (int j = 0; j < 4; ++j) { const v4u a = raw[t + j];
                            y[uu][0] += cw[j][0] * blo(a.x); y[uu][1] += cw[j][1] * bhi(a.x); y[uu][2] += cw[j][2] * blo(a.y); y[uu][3] += cw[j][3] * bhi(a.y);
                            y[uu][4] += cw[j][4] * blo(a.z); y[uu][5] += cw[j][5] * bhi(a.z); y[uu][6] += cw[j][6] * blo(a.w); y[uu][7] += cw[j][7] * bhi(a.w); }
                        float ss = 0.f;
#pragma unroll
                        for (int e = 0; e < 8; ++e) { y[uu][e] = siluf_(y[uu][e]); ss += y[uu][e] * y[uu][e]; }
                        ss += __shfl_xor(ss, 1); ss += __shfl_xor(ss, 2); ss += __shfl_xor(ss, 4); ss += __shfl_xor(ss, 8);
                        const float sc = lane < 32 ? rsqrtf(ss + EPS) * qs : 1.0f;
#pragma unroll
                        for (int e = 0; e < 8; ++e) y[uu][e] *= sc;
                        if (lane < 32) {
                            const int rr = 8 * (w & 3) + t;
                            const u32x2_t p0 = {pk2(y[uu][0], y[uu][1]), pk2(y[uu][2], y[uu][3])}, p1 = {pk2(y[uu][4], y[uu][5]), pk2(y[uu][6], y[uu][7])};
                            const int sw = isk ? 8 * (ks & 1) : 0;
                            const int o0 = ((mi * 8 + ks) * 64 + 0 * 32 + (rr ^ sw)) * 16 + 8 * odd, o1 = ((mi * 8 + ks) * 64 + 1 * 32 + (rr ^ (isk ? 4 + sw : 0))) * 16 + 8 * odd;
                            *(LAS u32x2_t*)(img + o0) = p0; *(LAS u32x2_t*)(img + o1) = p1;
                        }
                    }
#pragma unroll
                    for (int e = 0; e < 8; ++e) vpk[tp][e] = pk2(y[0][e], y[1][e]);
                    asm volatile("" ::: "memory");
                }
                if (lane >= 32) {
                    LAS unsigned char* vt = VTst + ((lane - 32) >> 4) * 16384 + (w * 128 + ((lane - 32) & 15) * 8) * 16;
#pragma unroll
                    for (int e = 0; e < 8; ++e) *(LAS v4u*)(vt + e * 16) = (v4u){vpk[0][e], vpk[1][e], vpk[2][e], vpk[3][e]};
                }
            }
            if (kk < 3) { P3A_LOADRAW(u, kk + 1); P3A_LOADCW(u, kk + 1); } else if (ui + 1 < nunits) P3A_LOADRAW(u + nblk, 0);
            if (w < 2) {
                const int hv = 2 * kh + w, hs = kk * 2 + w; const size_t row = (size_t)b * SEQ + t0 + lane;
                const float db = F.DBA[row * 64 + hv], da = F.DBA[row * 64 + 32 + hv];
                const float xx = da + F.dt_bias[hv]; const float sp = xx > 20.f ? xx : log1pf(__expf(xx));
                float gc = -__expf(F.a_log[hv]) * sp;
#pragma unroll
                for (int off = 1; off < 64; off <<= 1) { const float t = __shfl_up(gc, off); if (lane >= off) gc += t; }
                const float gl = __shfl(gc, 63);
                betaL[hs * 64 + lane] = sigm_(db); gcL[hs * 64 + lane] = gc;
                float* vec = (float*)(tqv_rec(F, b, hv, n) + TQV_VEC);
                st4_wt(vec + lane, __expf(gc)); st4_wt(vec + 64 + lane, __expf(gl - gc));
            }
            __syncthreads();
            if ((w & 3) < 3) {
                const int tsel = w & 3;
                const bool isqk = w >= 4;
                const int rt = isqk ? (tsel == 2 ? 1 : 0) : (tsel == 0 ? 0 : 1);
                const int ct = isqk ? (tsel == 0 ? 0 : 1) : (tsel == 2 ? 1 : 0);
                f32x16 acc = {};
                const int posE = hh * 32 + (r ^ (4 * hh)), posO = hh * 32 + (r ^ (4 * hh + 8));
#pragma unroll
                for (int ks = 0; ks < 8; ++ks) {
                    const bf16x8_t a = *(const LAS bf16x8_t*)(KNimg + ((rt * 8 + ks) * 64 + ((ks & 1) ? posO : posE)) * 16);
                    const bf16x8_t bb = isqk ? *(const LAS bf16x8_t*)(QNimg + ((ct * 8 + ks) * 64 + lane) * 16) : *(const LAS bf16x8_t*)(KNimg + ((ct * 8 + ks) * 64 + ((ks & 1) ? posO : posE)) * 16);
                    acc = MFMA32(a, bb, acc);
                }
#pragma unroll
                for (int h2 = 0; h2 < 2; ++h2) {
                    const int hs = kk * 2 + h2, hv = 2 * kh + h2;
                    const float gcol = gcL[hs * 64 + 32 * ct + r];
                    if (!isqk) {
                        const int s = 32 * ct + r, c0s = 4 * ((s + 1) >> 2); LAS float* ltrow = LTall + hs * LT_FLOATS + lt_rowoff(s) - c0s;
#pragma unroll
                        for (int g = 0; g < 4; ++g) { const int c0 = 32 * rt + 8 * g + 4 * hh;
                            const f32x4 gr = *(const LAS f32x4*)(gcL + hs * 64 + c0), br = *(const LAS f32x4*)(betaL + hs * 64 + c0); f32x4 o;
                            o.x = (c0 + 0 > s) ? br.x * acc[4 * g + 0] * __expf(gr.x - gcol) : 0.f; o.y = (c0 + 1 > s) ? br.y * acc[4 * g + 1] * __expf(gr.y - gcol) : 0.f;
                            o.z = (c0 + 2 > s) ? br.z * acc[4 * g + 2] * __expf(gr.z - gcol) : 0.f; o.w = (c0 + 3 > s) ? br.w * acc[4 * g + 3] * __expf(gr.w - gcol) : 0.f;
                            if (c0 >= c0s) *(LAS f32x4*)(ltrow + c0) = o; }
                    } else {
                        const int c = 32 * ct + r; f32x16 m;
#pragma unroll
                        for (int g = 0; g < 4; ++g) { const int s0 = 32 * rt + 8 * g + 4 * hh; const f32x4 gr = *(const LAS f32x4*)(gcL + hs * 64 + s0);
                            m[4 * g + 0] = (s0 + 0 <= c) ? acc[4 * g + 0] * __expf(gcol - gr.x) : 0.f; m[4 * g + 1] = (s0 + 1 <= c) ? acc[4 * g + 1] * __expf(gcol - gr.y) : 0.f;
                            m[4 * g + 2] = (s0 + 2 <= c) ? acc[4 * g + 2] * __expf(gcol - gr.z) : 0.f; m[4 * g + 3] = (s0 + 3 <= c) ? acc[4 * g + 3] * __expf(gcol - gr.w) : 0.f; }
                        unsigned char* qk = tqv_rec(F, b, hv, n) + TQV_QK;
                        const int blk0 = (ct == 0 ? 0 : 2) + 2 * rt;
                        st16_wt(qk + ((blk0 + 0) * 64 + lane) * 16, __builtin_bit_cast(v4u, ACC_FRAG(m, 0)));
                        st16_wt(qk + ((blk0 + 1) * 64 + lane) * 16, __builtin_bit_cast(v4u, ACC_FRAG(m, 1)));
                    }
                }
            } else if (w == 3) {
                unsigned char* kqrec = F.KQ + ((size_t)(b * 16 + kh) * 64 + n) * KQ_BYTES;
#pragma unroll 8
                for (int i = 0; i < 32; ++i) st16_wt(kqrec + (i * 64 + lane) * 16, *(const LAS v4u*)(F.lds + (i * 64 + lane) * 16));
            } else {
#pragma unroll
                for (int h2 = 0; h2 < 2; ++h2) { unsigned char* vt = tqv_rec(F, b, 2 * kh + h2, n) + TQV_VT;
#pragma unroll 8
                    for (int i = 0; i < 16; ++i) st16_wt(vt + (i * 64 + lane) * 16, *(const LAS v4u*)(VTst + h2 * 16384 + (i * 64 + lane) * 16)); }
            }
            __syncthreads();
        }
        {
            int lane = F.lane; asm volatile("" : "+v"(lane));
            const int r = lane & 31;
            const int hs = w, hv = 2 * (kq * 4 + (w >> 1)) + (w & 1);
            float X[64];
            SubstRow<63>::run(X, LTall + hs * LT_FLOATS, lane);
            unsigned char* tb = tqv_rec(F, b, hv, n) + TQV_TB;
            const int mi2 = lane >> 5;
#pragma unroll
            for (int ks2 = 0; ks2 < 4; ++ks2) {
                if (mi2 == 1 || ks2 < 2) {
#pragma unroll
                    for (int h2 = 0; h2 < 2; ++h2) { const int c0 = 16 * ks2 + 4 * h2;
                        const f32x4 b0 = *(const LAS f32x4*)(betaL + hs * 64 + c0), b1 = *(const LAS f32x4*)(betaL + hs * 64 + c0 + 8);
                        v4u c; c.x = pk2(X[c0 + 0] * b0.x, X[c0 + 1] * b0.y); c.y = pk2(X[c0 + 2] * b0.z, X[c0 + 3] * b0.w); c.z = pk2(X[c0 + 8] * b1.x, X[c0 + 9] * b1.y); c.w = pk2(X[c0 + 10] * b1.z, X[c0 + 11] * b1.w);
                        st16_wt(tb + (((mi2 == 0 ? 0 : 2) + ks2) * 64 + h2 * 32 + r) * 16, c); }
                }
            }
        }
        asm volatile("s_waitcnt vmcnt(0)" ::: "memory");
        __syncthreads();
        if (F.tid == 0) __hip_atomic_store((unsigned*)(F.ctl + CW_FLAGS) + (b * 64 + n) * 4 + kq, 1u, __ATOMIC_RELAXED, __HIP_MEMORY_SCOPE_AGENT);
    }
#undef P3A_LOADRAW
#undef P3A_LOADCW
}

__device__ __forceinline__ void glds16(const unsigned char* gsrc, LAS unsigned char* ldst) { __builtin_amdgcn_global_load_lds((const unsigned*)gsrc, (LAS unsigned*)ldst, 16, 0, 16); }

__device__ __forceinline__ void p3b_scan(Frame& F, int b, int h) {
    const int lane = F.lane, w = F.wave, r = lane & 31, hh = lane >> 5, kh = h >> 1;
    const unsigned char* kqbase = F.KQ + (size_t)(b * 16 + kh) * 64 * KQ_BYTES;
    const unsigned char* tqvbase = tqv_rec(F, b, h, 0);
    constexpr int NCH = SEQ / 64;
    if (w >= 4) {
        __builtin_amdgcn_s_setprio(3);
        const int hw = w - 4, row = 16 * hw + (lane >> 2), q4 = lane & 3;
        const size_t grow0 = (size_t)b * SEQ + row;
        const bf16* gzp = F.PROJ + grow0 * NP + C_DZ + h * 128 + q4 * 32;
        bf16* outp = F.A2 + grow0 * KCAT + 2048 + h * 128 + q4 * 32;
#define DN_ISSUE(nn) do { LAS unsigned char* dst_ = F.lds + ((nn) & 1) * STAGE_BYTES_DN + hw * 1024; \
            const unsigned char* s0_ = kqbase + (size_t)(nn) * KQ_BYTES + hw * 1024 + lane * 16; const unsigned char* s1_ = tqvbase + (size_t)(nn) * TQV_BYTES + hw * 1024 + lane * 16; \
            _Pragma("unroll") for (int i_ = 0; i_ < 8; ++i_) glds16(s0_ + i_ * 4096, dst_ + i_ * 4096); \
            _Pragma("unroll") for (int i_ = 0; i_ < 8; ++i_) if (hw + 4 * i_ < 29) glds16(s1_ + i_ * 4096, dst_ + 32768 + i_ * 4096); } while (0)
#define DN_GZLOAD(G, nn) do { const bf16* gp_ = gzp + (size_t)(nn) * 64 * NP; \
            asm volatile("global_load_dwordx4 %0, %4, off\n\tglobal_load_dwordx4 %1, %4, off offset:16\n\tglobal_load_dwordx4 %2, %4, off offset:32\n\tglobal_load_dwordx4 %3, %4, off offset:48" \
                : "=&v"(G[0]), "=&v"(G[1]), "=&v"(G[2]), "=&v"(G[3]) : "v"(gp_) : "memory"); } while (0)
#define DN_OUT(G, nn) do { __builtin_amdgcn_s_setprio(0); const LAS unsigned char* ob_ = F.lds + OBUF_OFF + ((nn) & 1) * OBUF_BYTES + row * OBUF_PITCH + q4 * 64; \
            v4u ov_[4]; float ss_ = 0.f; \
            _Pragma("unroll") for (int i_ = 0; i_ < 4; ++i_) { ov_[i_] = *(const LAS v4u*)(ob_ + i_ * 16); \
                const float a0_ = blo(ov_[i_].x), a1_ = bhi(ov_[i_].x), a2_ = blo(ov_[i_].y), a3_ = bhi(ov_[i_].y), a4_ = blo(ov_[i_].z), a5_ = bhi(ov_[i_].z), a6_ = blo(ov_[i_].w), a7_ = bhi(ov_[i_].w); \
                ss_ += (a0_ * a0_ + a1_ * a1_) + (a2_ * a2_ + a3_ * a3_) + (a4_ * a4_ + a5_ * a5_) + (a6_ * a6_ + a7_ * a7_); } \
            ss_ += __shfl_xor(ss_, 1); ss_ += __shfl_xor(ss_, 2); \
            const float rs_ = rsqrtf(ss_ * (1.f / 128.f) + EPS); \
            v4u* op_ = (v4u*)(outp + (size_t)(nn) * 64 * KCAT); \
            _Pragma("unroll") for (int i_ = 0; i_ < 4; ++i_) { const v4u a_ = ov_[i_], g_ = G[i_]; v4u o_; \
                o_.x = pk2(blo(a_.x) * rs_ * blo(g_.x), bhi(a_.x) * rs_ * bhi(g_.x)); o_.y = pk2(blo(a_.y) * rs_ * blo(g_.y), bhi(a_.y) * rs_ * bhi(g_.y)); \
                o_.z = pk2(blo(a_.z) * rs_ * blo(g_.z), bhi(a_.z) * rs_ * bhi(g_.z)); o_.w = pk2(blo(a_.w) * rs_ * blo(g_.w), bhi(a_.w) * rs_ * bhi(g_.w)); op_[i_] = o_; } __builtin_amdgcn_s_setprio(3); } while (0)
#define DN_ENDSTEP(G, WAITSTR) do { asm volatile(WAITSTR : "+v"(G[0]), "+v"(G[1]), "+v"(G[2]), "+v"(G[3]) :: "memory"); \
            __builtin_amdgcn_s_barrier(); asm volatile("" ::: "memory"); } while (0)
        v4u gA[4], gB[4];
#pragma unroll
        for (int i = 0; i < 4; ++i) { gA[i] = (v4u){0u, 0u, 0u, 0u}; gB[i] = (v4u){0u, 0u, 0u, 0u}; }
        {
            const unsigned* fl = (const unsigned*)(F.ctl + CW_FLAGS) + (b * 64 + lane) * 4 + (h >> 3); unsigned sp = 0;
            while (!__all(lane >= 32 || __hip_atomic_load(fl, __ATOMIC_RELAXED, __HIP_MEMORY_SCOPE_AGENT) != 0u)) { __builtin_amdgcn_s_sleep(16); if (++sp > (1u << 19)) { if (lane == 0) atomicAdd((unsigned*)(F.ctl + CW_BAR) + XB_TMO, 1u); break; } }
            asm volatile("" ::: "memory");
        }
        DN_ISSUE(0);
        DN_ENDSTEP(gA, "s_waitcnt vmcnt(0) lgkmcnt(0)");
        DN_ISSUE(1); DN_GZLOAD(gA, 0); DN_ENDSTEP(gA, "s_waitcnt vmcnt(0) lgkmcnt(0)");
        for (int n = 1; n + 1 < NCH; n += 2) {
            if (n == 31) {
                const unsigned* fl = (const unsigned*)(F.ctl + CW_FLAGS) + (b * 64 + lane) * 4 + (h >> 3); unsigned sp = 0;
                while (!__all(__hip_atomic_load(fl, __ATOMIC_RELAXED, __HIP_MEMORY_SCOPE_AGENT) != 0u)) { __builtin_amdgcn_s_sleep(16); if (++sp > (1u << 19)) { if (lane == 0) atomicAdd((unsigned*)(F.ctl + CW_BAR) + XB_TMO, 1u); break; } }
                asm volatile("" ::: "memory");
            }
            DN_ISSUE(n + 1); DN_GZLOAD(gB, n); DN_OUT(gA, n - 1); DN_ENDSTEP(gB, "s_waitcnt vmcnt(4) lgkmcnt(0)");
            if (n + 2 < NCH) DN_ISSUE(n + 2); DN_GZLOAD(gA, n + 1); DN_OUT(gB, n); DN_ENDSTEP(gA, "s_waitcnt vmcnt(4) lgkmcnt(0)");
        }
        DN_GZLOAD(gB, NCH - 1); DN_OUT(gA, NCH - 2); DN_ENDSTEP(gB, "s_waitcnt vmcnt(4) lgkmcnt(0)");
        DN_OUT(gB, NCH - 1);
        __builtin_amdgcn_s_setprio(0);
#undef DN_ISSUE
#undef DN_GZLOAD
#undef DN_OUT
#undef DN_ENDSTEP
    } else {
        const int n0 = 32 * w;
        f32x16 S[4];
#pragma unroll
        for (int d = 0; d < 4; ++d) S[d] = (f32x16){};
        __builtin_amdgcn_s_barrier(); asm volatile("" ::: "memory");
#define SB_() __builtin_amdgcn_sched_barrier(0)
        for (int n = 0; n < NCH; ++n) {
            int lane = F.lane; asm volatile("" : "+v"(lane));
            const int r = lane & 31, hh = lane >> 5;
            const int posE = (hh * 32 + (r ^ (4 * hh))) * 16, posO = (hh * 32 + (r ^ (4 * hh + 8))) * 16;
            const LAS unsigned char* st = F.lds + (n & 1) * STAGE_BYTES_DN;
            const LAS unsigned char* tq = st + KQ_BYTES;
            const LAS float* egp = (const LAS float*)(tq + TQV_VEC);
            const LAS unsigned char* vtp = tq + TQV_VT + (n0 + r) * 16 + hh * 8;
#define KNF(i) (*(const LAS bf16x8_t*)(st + (i) * 1024 + (((i) & 1) ? posO : posE)))
#define QNF(i) (*(const LAS bf16x8_t*)(st + 16384 + (i) * 1024 + lane * 16))
#define TBF(i) (*(const LAS bf16x8_t*)(tq + TQV_TB + ((i) * 64 + lane) * 16))
#define QKF(i) (*(const LAS bf16x8_t*)(tq + TQV_QK + ((i) * 64 + lane) * 16))
            bf16x8_t W[8];
#pragma unroll
            for (int i = 0; i < 8; ++i) W[i] = KNF(i);
            bf16x8_t Sb[4][2];
#pragma unroll
            for (int d = 0; d < 4; ++d) { Sb[d][0] = ACC_FRAG(S[d], 0); Sb[d][1] = ACC_FRAG(S[d], 1); }
            SB_();
            f32x16 x[2] = {(f32x16){}, (f32x16){}}, o[2] = {(f32x16){}, (f32x16){}};
            f32x4 e4q[4]; u32x2_t vvq[4];
#pragma unroll
            for (int i = 0; i < 16; ++i) {
                x[i >> 3] = MFMA32(W[i & 7], Sb[(i & 7) >> 1][i & 1], x[i >> 3]);
                W[i & 7] = i < 8 ? KNF(i + 8) : QNF(i - 8);
                if (i >= 12) { const int g = i - 12; e4q[g] = *(const LAS f32x4*)(egp + 8 * g + 4 * hh); vvq[g] = *(const LAS u32x2_t*)(vtp + (g * 128) * 16); }
                SB_();
            }
            bf16x8_t Xb[2][2], T[6];
#pragma unroll
            for (int i = 0; i < 16; ++i) {
                o[i >> 3] = MFMA32(W[i & 7], Sb[(i & 7) >> 1][i & 1], o[i >> 3]);
                if (i < 8) W[i & 7] = QNF(i + 8); else if (i < 14) T[i - 8] = TBF(i - 8);
                if (i < 8) { const int mi = i >> 2, g = i & 3; const f32x4 e4 = e4q[g]; const u32x2_t vv = vvq[g];
                    if (i < 4) { e4q[g] = *(const LAS f32x4*)(egp + 32 + 8 * g + 4 * hh); vvq[g] = *(const LAS u32x2_t*)(vtp + ((4 + g) * 128) * 16); }
                    x[mi][4 * g + 0] = blo(vv.x) - e4.x * x[mi][4 * g + 0]; x[mi][4 * g + 1] = bhi(vv.x) - e4.y * x[mi][4 * g + 1];
                    x[mi][4 * g + 2] = blo(vv.y) - e4.z * x[mi][4 * g + 2]; x[mi][4 * g + 3] = bhi(vv.y) - e4.w * x[mi][4 * g + 3]; }
                else if (i < 12) { const int mi = (i - 8) >> 1, s_ = (i - 8) & 1; Xb[mi][s_] = ACC_FRAG(x[mi], s_); }
                else { const int g = i - 12; e4q[g] = *(const LAS f32x4*)(egp + 8 * g + 4 * hh); }
                SB_();
            }
            f32x16 vn[2] = {(f32x16){}, (f32x16){}};
            bf16x8_t Kq[6];
#pragma unroll
            for (int i = 0; i < 6; ++i) {
                const int mo = i < 2 ? 0 : 1, mi = i < 2 ? 0 : ((i - 2) >> 1), s_ = i & 1;
                vn[mo] = MFMA32(T[i], Xb[mi][s_], vn[mo]);
                Kq[i] = QKF(i);
                if (i < 4) { const int g = i; const f32x4 e4 = e4q[g]; e4q[g] = *(const LAS f32x4*)(egp + 32 + 8 * g + 4 * hh);
                    o[0][4 * g + 0] *= e4.x; o[0][4 * g + 1] *= e4.y; o[0][4 * g + 2] *= e4.z; o[0][4 * g + 3] *= e4.w; }
                else {
#pragma unroll
                    for (int k = 0; k < 2; ++k) { const int g = 2 * (i - 4) + k; const f32x4 e4 = e4q[g];
                        o[1][4 * g + 0] *= e4.x; o[1][4 * g + 1] *= e4.y; o[1][4 * g + 2] *= e4.z; o[1][4 * g + 3] *= e4.w; } }
                SB_();
            }
            bf16x8_t Vb[2][2], Vd[2][2];
            const float egl = egp[63];
            int lane2 = F.lane; asm volatile("" : "+v"(lane2));
            const TrAddr tra = tr_addr(lane2);
            bf16x8_t Kt[4];
#pragma unroll
            for (int g = 0; g < 4; ++g) e4q[g] = *(const LAS f32x4*)(egp + 64 + 8 * g + 4 * hh);
            Vb[0][0] = ACC_FRAG(vn[0], 0); Vb[0][1] = ACC_FRAG(vn[0], 1);
            SB_();
            o[0] = MFMA32(Kq[0], Vb[0][0], o[0]); Vb[1][0] = ACC_FRAG(vn[1], 0); SB_();
            o[0] = MFMA32(Kq[1], Vb[0][1], o[0]); Vb[1][1] = ACC_FRAG(vn[1], 1); SB_();
#pragma unroll
            for (int i = 2; i < 6; ++i) {
                o[1] = MFMA32(Kq[i], Vb[(i - 2) >> 1][i & 1], o[1]);
                Kt[i - 2] = tr_frag(st + ((i - 2) >> 1) * 8192, tra, 0, (i - 2) & 1);
                { const int mi = (i - 2) >> 1, gb = 2 * ((i - 2) & 1);
#pragma unroll
                  for (int k = 0; k < 2; ++k) { const int g = gb + k; const f32x4 d4 = e4q[g];
                      if (mi == 0) e4q[g] = *(const LAS f32x4*)(egp + 64 + 32 + 8 * g + 4 * hh);
                      vn[mi][4 * g + 0] *= d4.x; vn[mi][4 * g + 1] *= d4.y; vn[mi][4 * g + 2] *= d4.z; vn[mi][4 * g + 3] *= d4.w; } }
                if (i == 3) { Vd[0][0] = ACC_FRAG(vn[0], 0); Vd[0][1] = ACC_FRAG(vn[0], 1); }
                SB_();
            }
            Vd[1][0] = ACC_FRAG(vn[1], 0); Vd[1][1] = ACC_FRAG(vn[1], 1);
            S[0] = S[0] * egl;
            SB_();
            LAS unsigned char* ob = F.lds + OBUF_OFF + (n & 1) * OBUF_BYTES + (n0 + r) * 2 + 4 * hh * OBUF_PITCH;
#pragma unroll
            for (int d = 0; d < 4; ++d) {
                bf16x8_t Kn[4];
                if (d < 3) S[d + 1] = S[d + 1] * egl;
#pragma unroll
                for (int j = 0; j < 4; ++j) {
                    S[d] = MFMA32(Kt[j], Vd[j >> 1][j & 1], S[d]);
                    if (d < 3) Kn[j] = tr_frag(st + (j >> 1) * 8192, tra, d + 1, j & 1);
                    { const int q_ = d * 4 + j, mi = q_ >> 3, g = (q_ >> 1) & 3, pr = q_ & 1;
                      const unsigned pk = cvtpk(o[mi][4 * g + 2 * pr], o[mi][4 * g + 2 * pr + 1]);
                      LAS unsigned char* p = ob + (32 * mi + 8 * g + 2 * pr) * OBUF_PITCH;
                      *(LAS unsigned short*)p = (unsigned short)pk; *(LAS unsigned short*)(p + OBUF_PITCH) = (unsigned short)(pk >> 16); }
                    SB_();
                }
                if (d < 3) {
#pragma unroll
                    for (int j = 0; j < 4; ++j) Kt[j] = Kn[j];
                }
            }
#undef KNF
#undef QNF
#undef TBF
#undef QKF
            asm volatile("s_waitcnt lgkmcnt(0)" ::: "memory");
            __builtin_amdgcn_s_barrier(); asm volatile("" ::: "memory");
        }
#undef SB_
    }
}

__device__ __forceinline__ void p3_scan_item_simple(Frame& F, int b, int h) {
    LAS float* Qs = (LAS float*)F.lds; LAS float* Ks = Qs + 8192; LAS float* Vs = Ks + 8192; LAS float* Os = Vs + 8192;
    LAS float* bet = (LAS float*)(F.lds + SMALL_OFF); LAS float* eg = bet + 64;
    const int tid = F.tid, j = tid >> 2, dq = tid & 3, kh = h >> 1;
    float S[32];
#pragma unroll
    for (int d = 0; d < 32; ++d) S[d] = 0.f;
    const float aexp = __expf(F.a_log[h]), dtb = F.dt_bias[h];
    for (int ch = 0; ch < SEQ / 64; ++ch) {
        const int t0 = ch * 64;
        for (int idx = tid; idx < 64 * 384; idx += 512) {
            const int tok = idx / 384, c = idx - tok * 384;
            const int wch = c < 128 ? kh * 128 + c : (c < 256 ? 2048 + kh * 128 + (c - 128) : 4096 + h * 128 + (c - 256));
            float acc = 0.f;
#pragma unroll
            for (int jj = 0; jj < 4; ++jj) { const int tt = t0 + tok - 3 + jj; if (tt >= 0) acc += bf2f(F.PROJ[((size_t)b * SEQ + tt) * NP + C_DQKV + wch]) * F.conv_w[jj * 8192 + wch]; }
            const float y = siluf_(acc);
            LAS float* dst = c < 128 ? Qs : (c < 256 ? Ks : Vs);
            dst[tok * 128 + (c & 127)] = y;
        }
        if (tid < 64) { const size_t row = (size_t)b * SEQ + t0 + tid; const float db = F.DBA[row * 64 + h], da = F.DBA[row * 64 + 32 + h];
            bet[tid] = sigm_(db); const float xx = da + dtb; const float sp = xx > 20.f ? xx : log1pf(__expf(xx)); eg[tid] = __expf(-aexp * sp); }
        __syncthreads();
        for (int r = 0; r < 16; ++r) { const int row = F.wave * 16 + r; LAS float* p = row < 64 ? Qs + row * 128 : Ks + (row - 64) * 128;
            const float a = p[F.lane], bb = p[F.lane + 64]; const float ss = wave_sum(a * a + bb * bb);
            const float sc = rsqrtf(ss + EPS) * (row < 64 ? 0.08838834764831845f : 1.0f); p[F.lane] = a * sc; p[F.lane + 64] = bb * sc; }
        __syncthreads();
        for (int t = 0; t < 64; ++t) {
            const float e = eg[t], be = bet[t];
            float kk[32]; float part = 0.f;
#pragma unroll
            for (int d = 0; d < 32; d += 4) { const f32x4 k4 = *(const LAS f32x4*)(Ks + t * 128 + dq * 32 + d); kk[d] = k4.x; kk[d + 1] = k4.y; kk[d + 2] = k4.z; kk[d + 3] = k4.w; }
#pragma unroll
            for (int d = 0; d < 32; ++d) part += S[d] * kk[d];
            part += __shfl_xor(part, 1); part += __shfl_xor(part, 2);
            const float vn = be * (Vs[t * 128 + j] - e * part);
#pragma unroll
            for (int d = 0; d < 32; ++d) S[d] = e * S[d] + kk[d] * vn;
            float po = 0.f;
#pragma unroll
            for (int d = 0; d < 32; d += 4) { const f32x4 q4 = *(const LAS f32x4*)(Qs + t * 128 + dq * 32 + d); po += S[d] * q4.x + S[d + 1] * q4.y + S[d + 2] * q4.z + S[d + 3] * q4.w; }
            po += __shfl_xor(po, 1); po += __shfl_xor(po, 2);
            if (dq == 0) Os[t * 128 + j] = po;
        }
        __syncthreads();
        for (int r = 0; r < 8; ++r) { const int tok = F.wave * 8 + r; const size_t row = (size_t)b * SEQ + t0 + tok;
            const float a = Os[tok * 128 + F.lane], bb = Os[tok * 128 + F.lane + 64]; const float ss = wave_sum(a * a + bb * bb);
            const float rs = rsqrtf(ss * (1.f / 128.f) + EPS);
            const float z0 = bf2f(F.PROJ[row * NP + C_DZ + h * 128 + F.lane]), z1 = bf2f(F.PROJ[row * NP + C_DZ + h * 128 + F.lane + 64]);
            F.A2[row * KCAT + 2048 + h * 128 + F.lane] = (bf16)f2bf(a * rs * z0);
            F.A2[row * KCAT + 2048 + h * 128 + F.lane + 64] = (bf16)f2bf(bb * rs * z1); }
        __syncthreads();
    }
}

#ifndef DN_SIMPLE
#define DN_SIMPLE 0
#endif
#ifndef MK_N_LAUNCHES
#define MK_N_LAUNCHES 1
#endif
constexpr int PER_PHASE = 6;
constexpr int N_LAUNCHES = MK_N_LAUNCHES;
struct Args { const void* in[17]; float* out; unsigned char* ws; int ph_lo, ph_hi, li, pad; };

__global__ void __launch_bounds__(NWAVES * 64, 2) skel_fwd(Args args) {
    extern __shared__ __attribute__((aligned(16))) unsigned char lds[];
    Frame F;
    F.lds = (LAS unsigned char*)lds;
    F.MISC = (volatile LAS unsigned*)(F.lds + MISC_OFF);
    F.tid = threadIdx.x; F.lane = F.tid & 63; F.wave = __builtin_amdgcn_readfirstlane(F.tid >> 6);
    F.G = gridDim.x; { const int bx = blockIdx.x; F.vcu = (F.G % 8 == 0) ? (bx % 8) * (F.G / 8) + bx / 8 : bx; }
    unsigned char* ws = args.ws;
    F.ctl = (gu32*)(ws + WS_CTL);
    F.x = (const float*)args.in[0]; F.c = (const float*)args.in[1]; F.positions = (const int*)args.in[2]; F.w_ada = (const float*)args.in[3]; F.b_ada = (const float*)args.in[4];
    F.norm_w = (const float*)args.in[5]; F.w_in = (const float*)args.in[6]; F.q_norm_w = (const float*)args.in[7]; F.k_norm_w = (const float*)args.in[8]; F.sinks = (const float*)args.in[9];
    F.conv_w = (const float*)args.in[10]; F.a_log = (const float*)args.in[11]; F.dt_bias = (const float*)args.in[12]; F.dn_norm_w = (const float*)args.in[13];
    F.w_o_swa = (const float*)args.in[14]; F.w_o_dn = (const float*)args.in[15]; F.w_out = (const float*)args.in[16]; F.out = args.out;
    F.modacc = (float*)(ws + WS_MODACC); F.WTIN = (bf16*)(ws + WS_WTIN); F.WOCAT = (bf16*)(ws + WS_WOCAT); F.WOUT = (bf16*)(ws + WS_WOUT); F.H = (bf16*)(ws + WS_H);
    F.PROJ = (bf16*)(ws + WS_PROJ); F.A2 = (bf16*)(ws + WS_A2); F.Y = (bf16*)(ws + WS_Y); F.ROPE = (float*)(ws + WS_ROPE); F.DBA = (float*)(ws + WS_DBA); F.KQ = (unsigned char*)args.out; F.ws = ws;
    for (int u = F.tid; u < (LDS_BYTES - LDSCTL_OFF) / 4; u += NWAVES * 64) ((LAS unsigned*)(F.lds + LDSCTL_OFF))[u] = 0u;
    __syncthreads();
    XcdBarrier bar; bar.bar = (unsigned*)(F.ctl + CW_BAR) + args.li * XCD_BAR_WORDS; bar.x = 0; bar.st = nullptr;
    if (N_LAUNCHES != PER_PHASE) bar = xcd_barrier_post((unsigned*)(F.ctl + CW_BAR) + args.li * XCD_BAR_WORDS, F.MISC + 8);
#define GRID_BAR() do { if (N_LAUNCHES != PER_PHASE) xcd_barrier(bar); } while (0)
    const int lo = args.ph_lo, hi = args.ph_hi;
#define IN(k) (lo <= (k) && (k) < hi)
#define BOTH(k) (IN(k) && IN((k) + 1))

    static_assert(N_LAUNCHES == 1, "the team pipeline of phases 0-2 has no launch seams");
    const int bx = (int)blockIdx.x, tx = bx & 7, tp = (bx >> 3) & 3, tj = bx >> 5;
    if (IN(0)) {
        p0_prologue(F);
        if (tp >= 2) { const int q = tx * 16 + (tp - 2) * 8 + tj;
            p0_win_convert_teamB(F, q, 0, 3); __syncthreads();
            p1_hrows(F, 4 * tx + tp, tj); __syncthreads();
            p3_outw_convert(F, q, 128); __syncthreads(); }
        else p1_hrows(F, 4 * tx + tp, tj);
        pg8::Gemm g{F.H, F.WTIN, MTOK, NP, DM, DM, DM};
        pg8::TeamOrder S{tx, tp, tj, (const unsigned*)(F.ctl + CW_HCNT), (const unsigned*)(F.ctl + CW_WCNT), (unsigned*)(F.ctl + CW_BAR) + XB_TMO};
        pg8::EpiProj E{F.PROJ, NP, F.DBA, PN_DBA, F.dn_norm_w};
        pg8::gemm_phase<pg8::EpiProj, pg8::TeamOrder, true, true>(F.lds, g, S, E);
        if (tp < 2) { __syncthreads(); p0_win_convert_teamB(F, tx * 16 + tp * 8 + tj, 3, 4); }
        GRID_BAR();
    }
    if (IN(3)) {
        p3a_phase(F, bx, F.G);
        if (bx < 64) { const int it = (bx & 7) * 8 + (bx >> 3); p3b_scan(F, it >> 5, it & 31); }
        else {
            const int k = (bx >> 3) - 8;
            int ae0, an, ge0, gn;
            if (k < 12) { ae0 = k; an = 1; gn = 3; ge0 = k < 4 ? 3 * k : (k < 8 ? 14 + 3 * (k - 4) : 28 + 3 * (k - 8)); }
            else { if (k < 20) { ae0 = 12 + 2 * (k - 12); an = 2; } else { ae0 = 28 + (k - 20); an = 1; }
                   gn = 2; ge0 = k == 12 ? 12 : (k == 13 ? 26 : (k < 16 ? 40 + 2 * (k - 14) : 44 + 2 * (k - 16))); }
            const bool gemm_first = true;
            if (!gemm_first) { for (int i = 0; i < an; ++i) { const int a = tx * 32 + ae0 + i; p3_attn_item(F, a >> 7, (a >> 2) & 31, a & 3); } __syncthreads(); }
            { pg8::Gemm g{F.H, F.WTIN, MTOK, NP, DM, DM, DM}; pg8::EpiProj E{F.PROJ, NP, F.DBA, PN_DBA, F.dn_norm_w};
              pg8::P3List S{tx, ge0, gn}; pg8::gemm_phase<pg8::EpiProj, pg8::P3List, true, true>(F.lds, g, S, E); }
            if (gemm_first) { __syncthreads(); for (int i = 0; i < an; ++i) { const int a = tx * 32 + ae0 + i; p3_attn_item(F, a >> 7, (a >> 2) & 31, a & 3); } }
        }
        if (BOTH(3)) GRID_BAR();
    }
    if (IN(4)) {
        pg8::Gemm g{F.A2, F.WOCAT, MTOK, DM, KCAT, KCAT, KCAT}; pg8::StaticOrder S; S.init(MTOK, DM, F.G, (int)blockIdx.x);
        pg8::EpiMerge E{F.Y, DM, F.PROJ + C_MGA, F.PROJ + C_MGB, NP};
        pg8::gemm_phase<pg8::EpiMerge, pg8::StaticOrder, true, true>(F.lds, g, S, E);
        if (BOTH(4)) GRID_BAR();
    }
    if (IN(5)) {
        pg8::Gemm g{F.Y, F.WOUT, MTOK, DM, DM, DM, DM}; pg8::StaticOrder S; S.init(MTOK, DM, F.G, (int)blockIdx.x);
        pg8::EpiResid E{F.out, F.x, DM, F.modacc, F.b_ada, 2 * DM, 6144, SEQ};
        pg8::gemm_phase<pg8::EpiResid, pg8::StaticOrder, true, true>(F.lds, g, S, E);
    }
#undef IN
#undef BOTH
}

extern "C" void kernel_launch(void* const* d_in, const int* in_sizes, int n_in, void* d_out, int out_size, void* d_ws, size_t ws_size, hipStream_t stream) {
    static int grid = 0;
    if (grid == 0) {
        if (n_in != 17 || in_sizes[0] != MTOK * DM || out_size != MTOK * DM || ws_size < WS_END) { fprintf(stderr, "kernel_launch: unexpected shapes / workspace (n_in %d, in0 %d, out %d, ws %zu, need %zu); nothing launched\n", n_in, n_in > 0 ? in_sizes[0] : -1, out_size, ws_size, (size_t)WS_END); grid = -1; return; }
        int dev = 0, cus = 0, per_cu = 0;
        if (hipGetDevice(&dev) != hipSuccess || hipDeviceGetAttribute(&cus, hipDeviceAttributeMultiprocessorCount, dev) != hipSuccess) { grid = -1; return; }
        if (hipFuncSetAttribute((const void*)skel_fwd, hipFuncAttributeMaxDynamicSharedMemorySize, LDS_BYTES) != hipSuccess) { fprintf(stderr, "kernel_launch: hipFuncSetAttribute failed\n"); grid = -1; return; }
        if (hipOccupancyMaxActiveBlocksPerMultiprocessor(&per_cu, (const void*)skel_fwd, NWAVES * 64, LDS_BYTES) != hipSuccess || per_cu < 1) { fprintf(stderr, "kernel_launch: occupancy query says %d blocks per CU\n", per_cu); per_cu = 1; }
        (void)hipGetLastError();
        grid = cus;
    }
    if (grid < 0) return;
    (void)hipMemsetAsync((char*)d_ws + WS_CTL, 0, CTL_ZERO_BYTES, stream);
    Args a{};
    for (int i = 0; i < 17; ++i) a.in[i] = d_in[i];
    a.out = (float*)d_out; a.ws = (unsigned char*)d_ws;
    for (int li = 0; li < N_LAUNCHES; ++li) {
        a.ph_lo = (N_LAUNCHES == PER_PHASE) ? li : 0; a.ph_hi = (N_LAUNCHES == PER_PHASE) ? li + 1 : PER_PHASE; a.li = (N_LAUNCHES == PER_PHASE) ? 0 : li;
        hipLaunchKernelGGL(skel_fwd, dim3(grid), dim3(NWAVES * 64), LDS_BYTES, stream, a);
    }
}
```
